# Optimizing an MI355X kernel written in HIP

```python
import math
import jax, jax.numpy as jnp
from jax import lax
import numpy as np

D_MODEL = 1024
BATCH = 16
SEQ = 256
DEPTH = 2
DEC_BATCH = 2
DEC_SEQ = 1024
PAST_LEN = 512

GRID_W = 64
HEAD_DIM = 64
MIX_WIDTH = D_MODEL
GROUP_W = MIX_WIDTH // 4
H_A = GROUP_W // HEAD_DIM
KV_A = 2
H_B = GROUP_W // HEAD_DIM
KV_B = 2
WINDOW = 128
ATT_BLOCK = 128
ROPE_BASE = 10000.0
W_C = GROUP_W
C_BLOCKS = 4
C_BLOCK_W = W_C // C_BLOCKS
CONV_W = 4
CONV_PAD_L = 2
LRU_C = 8.0
H_D = GROUP_W // HEAD_DIM
RET_CHUNK = 128
D_FF = 2816
N_MOD = 9
EPS = 1e-6
NEG_INF = -1e30
IN_SPLITS = (H_A * HEAD_DIM, KV_A * HEAD_DIM, KV_A * HEAD_DIM,
             H_B * HEAD_DIM, KV_B * HEAD_DIM, KV_B * HEAD_DIM,
             W_C, W_C,
             GROUP_W, GROUP_W, GROUP_W, GROUP_W)
IN_WIDTH = sum(IN_SPLITS)

kernel_name = 'hybrid_prefix_diffusion_step'


def rms_norm(x, g):
    xf = x.astype(jnp.float32)
    y = xf * lax.rsqrt(jnp.mean(xf * xf, axis=-1, keepdims=True) + EPS)
    return (y * g.astype(jnp.float32)).astype(x.dtype)


def swiglu(h, wg, wu, wd):
    return (jax.nn.silu(h @ wg) * (h @ wu)) @ wd


def split_columns(u):
    idx = np.cumsum(IN_SPLITS)[:-1].tolist()
    return jnp.split(u, idx, axis=-1)


def grid_positions(n_tokens):
    rows = n_tokens // GRID_W
    row = jnp.repeat(jnp.arange(rows), GRID_W)
    col = jnp.tile(jnp.arange(GRID_W), rows)
    return row.astype(jnp.float32), col.astype(jnp.float32)


def axial_rope(x):
    T = x.shape[1]
    row, col = grid_positions(T)
    half = HEAD_DIM // 2
    inv = 1.0 / (ROPE_BASE ** (jnp.arange(0, half, 2, dtype=jnp.float32) / half))
    bshape = (1, T) + (1,) * (x.ndim - 3) + (half // 2,)

    def rotate(xp, pos):
        ang = pos[:, None] * inv[None, :]
        cos = jnp.cos(ang).reshape(bshape)
        sin = jnp.sin(ang).reshape(bshape)
        xf = xp.astype(jnp.float32)
        x1, x2 = xf[..., :half // 2], xf[..., half // 2:]
        return jnp.concatenate([x1 * cos - x2 * sin, x1 * sin + x2 * cos], axis=-1)

    out = jnp.concatenate([rotate(x[..., :half], row), rotate(x[..., half:], col)], axis=-1)
    return out.astype(x.dtype)


def qk_heads(q, k, gq, gk, n_q, n_kv):
    B, T, _ = q.shape
    q = rms_norm(q.reshape(B, T, n_kv, n_q // n_kv, HEAD_DIM), gq)
    k = rms_norm(k.reshape(B, T, n_kv, HEAD_DIM), gk)
    return q, k


def attn_probs(s, sink):
    if sink is None:
        return jax.nn.softmax(s, axis=-1)
    sk = sink.astype(jnp.float32)[:, :, None, None]
    m = jnp.maximum(jnp.max(s, axis=-1, keepdims=True), sk)
    p = jnp.exp(s - m)
    return p / (jnp.sum(p, axis=-1, keepdims=True) + jnp.exp(sk - m))


def dense_attention(q, k, v, sink):
    B, T, KV, G, D = q.shape
    nb = T // ATT_BLOCK
    qb = jnp.moveaxis(q.reshape(B, nb, ATT_BLOCK, KV, G, D), 1, 0)
    scale = D ** -0.5

    def block(qi):
        s = jnp.einsum('bqkgd,bskd->bkgqs', qi, k).astype(jnp.float32) * scale
        p = attn_probs(s, sink).astype(v.dtype)
        return jnp.einsum('bkgqs,bskd->bqkgd', p, v)

    o = lax.map(block, qb)
    return jnp.moveaxis(o, 0, 1).reshape(B, T, KV * G * D)


def window_attention(q, k, v, kc, vc, sink):
    B, T, KV, G, D = q.shape
    W = ATT_BLOCK
    nb = T // W
    Nc = kc.shape[1]
    scale = D ** -0.5
    qb = q.reshape(B, nb, W, KV, G, D)

    def band(x):
        pad = jnp.zeros((B, W) + x.shape[2:], x.dtype)
        xp = jnp.concatenate([pad, x, pad], axis=1).reshape((B, nb + 2, W) + x.shape[2:])
        return jnp.concatenate([xp[:, :-2], xp[:, 1:-1], xp[:, 2:]], axis=2)

    kb, vb = band(k), band(v)
    qi = jnp.arange(W)[:, None]
    kj = jnp.arange(3 * W)[None, :]
    key_pos = (jnp.arange(nb)[:, None, None] - 1) * W + kj[None]
    rel = kj - W - qi
    valid = (jnp.abs(rel) <= WINDOW)[None] & (key_pos >= 0) & (key_pos < T)
    s_band = jnp.einsum('bnqkgd,bnskd->bnkgqs', qb, kb).astype(jnp.float32) * scale
    s_band = jnp.where(valid[None, :, None, None], s_band, NEG_INF)
    s_ctx = jnp.einsum('bnqkgd,bckd->bnkgqc', qb, kc).astype(jnp.float32) * scale
    p = attn_probs(jnp.concatenate([s_ctx, s_band], axis=-1), sink).astype(v.dtype)
    o = (jnp.einsum('bnkgqc,bckd->bnqkgd', p[..., :Nc], vc)
         + jnp.einsum('bnkgqs,bnskd->bnqkgd', p[..., Nc:], vb))
    return o.reshape(B, T, KV * G * D)


def centred_conv(x, w, b):
    C = x.shape[-1]
    y = lax.conv_general_dilated(x, w[:, None, :].astype(x.dtype), (1,),
                                 [(CONV_PAD_L, CONV_W - 1 - CONV_PAD_L)],
                                 dimension_numbers=('NWC', 'WIO', 'NWC'),
                                 feature_group_count=C)
    return y + b


def rglru_scan(x, wa, ba, wx, bx, lam, h0):
    B, T, W = x.shape
    xf = x.astype(jnp.float32)
    xb = xf.reshape(B, T, C_BLOCKS, C_BLOCK_W)
    r = jax.nn.sigmoid(jnp.einsum('btnc,ncd->btnd', xb, wa.astype(jnp.float32)).reshape(B, T, W) + ba)
    i = jax.nn.sigmoid(jnp.einsum('btnc,ncd->btnd', xb, wx.astype(jnp.float32)).reshape(B, T, W) + bx)
    log_a = -LRU_C * r * jax.nn.softplus(-lam.astype(jnp.float32))
    a = jnp.exp(log_a)
    b = jnp.sqrt(-jnp.expm1(2.0 * log_a)) * (i * xf)
    b = b.at[:, 0].add(a[:, 0] * h0.astype(jnp.float32))

    def combine(left, right):
        a1, b1 = left
        a2, b2 = right
        return a1 * a2, a2 * b1 + b2

    _, h = lax.associative_scan(combine, (a, b), axis=1)
    return h


def rglru_bidir(xc, p, h0f, h0b):
    hf = rglru_scan(xc, p['c_wa'][0], p['c_ba'][0], p['c_wx'][0], p['c_bx'][0], p['c_lam'][0], h0f)
    hb = jnp.flip(rglru_scan(jnp.flip(xc, 1), p['c_wa'][1], p['c_ba'][1], p['c_wx'][1],
                             p['c_bx'][1], p['c_lam'][1], h0b), 1)
    return hf, hb


def retention_scan(q, k, v, log_g, S0):
    B, T, H, D = q.shape
    C = RET_CHUNK
    n = T // C
    to_chunks = lambda t: t.reshape(B, n, C, H, D).transpose(1, 0, 3, 2, 4)
    idx = jnp.arange(C, dtype=jnp.float32)
    rel = idx[:, None] - idx[None, :]
    decay_mask = jnp.where(rel >= 0, jnp.exp(log_g[:, None, None] * jnp.maximum(rel, 0.0)), 0.0)
    q_decay = jnp.exp(log_g[:, None] * (idx + 1.0))[..., None]
    k_decay = jnp.exp(log_g[:, None] * (C - 1.0 - idx))[..., None]
    chunk_decay = jnp.exp(log_g * C)[:, None, None]

    def step(S, inp):
        qi, ki, vi = inp
        inner = jnp.einsum('bhqd,bhsd->bhqs', qi, ki) * decay_mask
        o = jnp.einsum('bhqs,bhsv->bhqv', inner, vi) + jnp.einsum('bhqd,bhdv->bhqv', qi * q_decay, S)
        S = S * chunk_decay + jnp.einsum('bhsd,bhsv->bhdv', ki * k_decay, vi)
        return S, o

    S, o = lax.scan(step, S0.astype(jnp.float32), (to_chunks(q), to_chunks(k), to_chunks(v)))
    return o.transpose(1, 0, 3, 2, 4).reshape(B, T, H, D), S


def retention_mixer(dq, dk, dv, dg, theta, gain, S0f, S0b):
    B, T, _ = dq.shape
    q = dq.reshape(B, T, H_D, HEAD_DIM).astype(jnp.float32)
    k = dk.reshape(B, T, H_D, HEAD_DIM).astype(jnp.float32) * HEAD_DIM ** -0.5
    v = dv.reshape(B, T, H_D, HEAD_DIM).astype(jnp.float32)
    log_g = jnp.log1p(-jnp.exp(theta.astype(jnp.float32)))
    of, Sf = retention_scan(q, k, v, log_g[0], S0f)
    ob, Sb = retention_scan(jnp.flip(q, 1), jnp.flip(k, 1), jnp.flip(v, 1), log_g[1], S0b)
    o = of + jnp.flip(ob, 1)
    o = o * lax.rsqrt(jnp.mean(o * o, axis=-1, keepdims=True) + EPS) * gain.astype(jnp.float32).reshape(H_D, HEAD_DIM)
    out = jax.nn.silu(dg.astype(jnp.float32)) * o.reshape(B, T, GROUP_W)
    return out.astype(dq.dtype), Sf, Sb


def mixer_context(u, p):
    B, T, _ = u.shape
    aq, ak, av, bq, bk, bv, cx, cy, dq, dk, dv, dg = split_columns(u)
    qa, ka = qk_heads(aq, ak, p['a_qn'], p['a_kn'], H_A, KV_A)
    va = av.reshape(B, T, KV_A, HEAD_DIM)
    oa = dense_attention(qa, ka, va, p['a_sink'].reshape(KV_A, H_A // KV_A))
    qb, kb = qk_heads(bq, bk, p['b_qn'], p['b_kn'], H_B, KV_B)
    vb = bv.reshape(B, T, KV_B, HEAD_DIM)
    ob = dense_attention(qb, kb, vb, None)
    xc = centred_conv(cx, p['c_conv_w'], p['c_conv_b'])
    h0 = jnp.zeros((B, W_C), jnp.float32)
    hf, hb = rglru_bidir(xc, p, h0, h0)
    oc = (hf + hb).astype(u.dtype) * jax.nn.gelu(cy)
    S0 = jnp.zeros((B, H_D, HEAD_DIM, HEAD_DIM), jnp.float32)
    od, Sf, Sb = retention_mixer(dq, dk, dv, dg, p['d_theta'], p['d_norm'], S0, S0)
    out = jnp.concatenate([oa, ob, oc, od], axis=-1)
    st_c = jnp.stack([hf[:, -1], hb[:, 0]], axis=1).astype(u.dtype)
    st_d = jnp.stack([Sf, Sb], axis=1).astype(u.dtype)
    return out, (ka, va, kb, vb, st_c, st_d)


def mixer_latent(u, p, cache):
    kca, vca, kcb, vcb, st_c, st_d = cache
    B, T, _ = u.shape
    aq, ak, av, bq, bk, bv, cx, cy, dq, dk, dv, dg = split_columns(u)
    qa, ka = qk_heads(aq, ak, p['a_qn'], p['a_kn'], H_A, KV_A)
    va = av.reshape(B, T, KV_A, HEAD_DIM)
    oa = window_attention(axial_rope(qa), axial_rope(ka), va, kca, vca,
                          p['a_sink'].reshape(KV_A, H_A // KV_A))
    qb, kb = qk_heads(bq, bk, p['b_qn'], p['b_kn'], H_B, KV_B)
    vb = bv.reshape(B, T, KV_B, HEAD_DIM)
    ob = dense_attention(axial_rope(qb), jnp.concatenate([kcb, axial_rope(kb)], axis=1),
                         jnp.concatenate([vcb, vb], axis=1), None)
    xc = centred_conv(cx, p['c_conv_w'], p['c_conv_b'])
    hf, hb = rglru_bidir(xc, p, st_c[:, 0], st_c[:, 1])
    oc = (hf + hb).astype(u.dtype) * jax.nn.gelu(cy)
    od, _, _ = retention_mixer(dq, dk, dv, dg, p['d_theta'], p['d_norm'], st_d[:, 0], st_d[:, 1])
    return jnp.concatenate([oa, ob, oc, od], axis=-1), ()


def trunk_layer(x, mod, p, mixer):
    sh1, sc1, g1, sh2, sc2, g2, sh3, sc3, g3 = jnp.split(mod[:, None, :], N_MOD, axis=-1)
    h = rms_norm(x, p['n1']) * (1.0 + sc1) + sh1
    x = x + 0.5 * g1 * swiglu(h, p['f1g'], p['f1u'], p['f1d'])
    h = rms_norm(x, p['n2']) * (1.0 + sc2) + sh2
    mixed, ctx = mixer(h @ p['w_in'])
    x = x + g2 * (mixed @ p['w_out'])
    h = rms_norm(x, p['n3']) * (1.0 + sc3) + sh3
    x = x + 0.5 * g3 * swiglu(h, p['f2g'], p['f2u'], p['f2d'])
    return x, ctx


def setup_inputs(seed: int = 0) -> dict:
    key = jax.random.key(seed)
    keys = iter(jax.random.split(key, 64))
    f32 = jnp.float32
    L = DEPTH

    def nrm(shape, scale=1.0):
        return jax.random.normal(next(keys), shape, f32) * scale

    def gain(shape):
        return 1.0 + nrm(shape, 0.02)

    u = jax.random.uniform(next(keys), (L, 2, W_C), f32, 0.9, 0.999)
    a_base = u ** (1.0 / LRU_C)
    c_lambda = jnp.log(a_base) - jnp.log1p(-a_base)
    theta_base = -(5.0 + jnp.arange(H_D, dtype=f32)) * math.log(2.0)
    d_theta = theta_base[None, None, :] + nrm((L, 2, H_D), 0.05)
    return {
        'x_prompt': nrm((BATCH, SEQ, D_MODEL)),
        'x_sample': nrm((DEC_BATCH, DEC_SEQ, D_MODEL)),
        'cache_a_k': nrm((DEC_BATCH, L, PAST_LEN, KV_A, HEAD_DIM)),
        'cache_a_v': nrm((DEC_BATCH, L, PAST_LEN, KV_A, HEAD_DIM)),
        'cache_b_k': nrm((DEC_BATCH, L, PAST_LEN, KV_B, HEAD_DIM)),
        'cache_b_v': nrm((DEC_BATCH, L, PAST_LEN, KV_B, HEAD_DIM)),
        'state_c': nrm((DEC_BATCH, L, 2, W_C), 0.5),
        'state_d': nrm((DEC_BATCH, L, 2, H_D, HEAD_DIM, HEAD_DIM)),
        'c': nrm((DEC_BATCH, D_MODEL)),
        'c_ctx': nrm((D_MODEL,)),
        'norm1_g': gain((L, D_MODEL)),
        'norm2_g': gain((L, D_MODEL)),
        'norm3_g': gain((L, D_MODEL)),
        'w_mod': nrm((L, D_MODEL, N_MOD * D_MODEL), D_MODEL ** -0.5),
        'b_mod': nrm((L, N_MOD * D_MODEL), 0.01),
        'ffn1_wg': nrm((L, D_MODEL, D_FF), D_MODEL ** -0.5),
        'ffn1_wu': nrm((L, D_MODEL, D_FF), D_MODEL ** -0.5),
        'ffn1_wd': nrm((L, D_FF, D_MODEL), D_FF ** -0.5),
        'ffn2_wg': nrm((L, D_MODEL, D_FF), D_MODEL ** -0.5),
        'ffn2_wu': nrm((L, D_MODEL, D_FF), D_MODEL ** -0.5),
        'ffn2_wd': nrm((L, D_FF, D_MODEL), D_FF ** -0.5),
        'w_in': nrm((L, D_MODEL, IN_WIDTH), D_MODEL ** -0.5),
        'w_out': nrm((L, MIX_WIDTH, D_MODEL), MIX_WIDTH ** -0.5),
        'a_qn': gain((L, HEAD_DIM)),
        'a_kn': gain((L, HEAD_DIM)),
        'a_sink': nrm((L, H_A), 0.5),
        'b_qn': gain((L, HEAD_DIM)),
        'b_kn': gain((L, HEAD_DIM)),
        'c_conv_w': nrm((L, CONV_W, W_C), CONV_W ** -0.5),
        'c_conv_b': nrm((L, W_C), 0.01),
        'c_wa': nrm((L, 2, C_BLOCKS, C_BLOCK_W, C_BLOCK_W), C_BLOCK_W ** -0.5),
        'c_ba': nrm((L, 2, W_C), 0.01),
        'c_wx': nrm((L, 2, C_BLOCKS, C_BLOCK_W, C_BLOCK_W), C_BLOCK_W ** -0.5),
        'c_bx': nrm((L, 2, W_C), 0.01),
        'c_lambda': c_lambda,
        'd_theta': d_theta,
        'd_norm_g': gain((L, GROUP_W)),
    }


def reference(x_prompt, x_sample, cache_a_k, cache_a_v, cache_b_k, cache_b_v, state_c, state_d,
              c, c_ctx, norm1_g, norm2_g, norm3_g, w_mod, b_mod,
              ffn1_wg, ffn1_wu, ffn1_wd, ffn2_wg, ffn2_wu, ffn2_wd, w_in, w_out,
              a_qn, a_kn, a_sink, b_qn, b_kn, c_conv_w, c_conv_b, c_wa, c_ba, c_wx, c_bx,
              c_lambda, d_theta, d_norm_g):
    cond_ctx = jax.nn.silu(c_ctx)[None, :]
    cond_lat = jax.nn.silu(c)
    y_p = x_prompt
    y_s = x_sample
    collected = [[], [], [], [], [], []]
    for l in range(DEPTH):
        p = {'n1': norm1_g[l], 'n2': norm2_g[l], 'n3': norm3_g[l],
             'f1g': ffn1_wg[l], 'f1u': ffn1_wu[l], 'f1d': ffn1_wd[l],
             'f2g': ffn2_wg[l], 'f2u': ffn2_wu[l], 'f2d': ffn2_wd[l],
             'w_in': w_in[l], 'w_out': w_out[l],
             'a_qn': a_qn[l], 'a_kn': a_kn[l], 'a_sink': a_sink[l],
             'b_qn': b_qn[l], 'b_kn': b_kn[l],
             'c_conv_w': c_conv_w[l], 'c_conv_b': c_conv_b[l],
             'c_wa': c_wa[l], 'c_ba': c_ba[l], 'c_wx': c_wx[l], 'c_bx': c_bx[l], 'c_lam': c_lambda[l],
             'd_theta': d_theta[l], 'd_norm': d_norm_g[l]}
        mod_ctx = cond_ctx @ w_mod[l] + b_mod[l]
        mod_lat = cond_lat @ w_mod[l] + b_mod[l]
        y_p, ctx = trunk_layer(y_p, mod_ctx, p, lambda u: mixer_context(u, p))
        for store, t in zip(collected, ctx):
            store.append(t)
        cache_l = (cache_a_k[:, l], cache_a_v[:, l], cache_b_k[:, l], cache_b_v[:, l],
                   state_c[:, l], state_d[:, l])
        y_s, _ = trunk_layer(y_s, mod_lat, p, lambda u: mixer_latent(u, p, cache_l))
    new_cache_a_k = jnp.stack(collected[0], axis=1)
    new_cache_a_v = jnp.stack(collected[1], axis=1)
    new_cache_b_k = jnp.stack(collected[2], axis=1)
    new_cache_b_v = jnp.stack(collected[3], axis=1)
    new_state_c = jnp.stack(collected[4], axis=1)
    new_state_d = jnp.stack(collected[5], axis=1)
    return (y_p, y_s, new_cache_a_k, new_cache_a_v, new_cache_b_k, new_cache_b_v, new_state_c, new_state_d)
```

```cpp
#include <hip/hip_runtime.h>
#include <hip/hip_cooperative_groups.h>
#include <cstdint>
#include <cstdio>
namespace cg = cooperative_groups;

#ifndef MK_MULTI
#define MK_MULTI 0
#endif

#define DEVI __device__ __forceinline__
#define LAS __attribute__((address_space(3)))

typedef unsigned short bf16_t;
typedef short bf16x8 __attribute__((ext_vector_type(8)));
typedef float f32x4 __attribute__((ext_vector_type(4)));
typedef float f32x2 __attribute__((ext_vector_type(2)));
typedef unsigned u32x4 __attribute__((ext_vector_type(4)));
typedef unsigned u32x2 __attribute__((ext_vector_type(2)));

constexpr int NTOK = 6144, NCTX = 4096, DM = 1024, DFF = 2816, INW = 2560;
constexpr int NKROW = 7168;
constexpr float LOG2E = 1.4426950408889634f;

enum { I_XP = 0, I_XS, I_CAK, I_CAV, I_CBK, I_CBV, I_SC, I_SD, I_C, I_CCTX, I_N1, I_N2, I_N3, I_WMOD, I_BMOD,
       I_F1G, I_F1U, I_F1D, I_F2G, I_F2U, I_F2D, I_WIN, I_WOUT, I_AQN, I_AKN, I_ASINK, I_BQN, I_BKN,
       I_CCW, I_CCB, I_CWA, I_CBA, I_CWX, I_CBX, I_CLAM, I_DTH, I_DNG, N_IN };

constexpr size_t O_YP = 0, O_YS = 4194304, O_CAK = 6291456, O_CAV = 7340032, O_CBK = 8388608, O_CBV = 9437184,
                 O_SC = 10485760, O_SD = 10502144;

constexpr size_t OFF_CTRL = 0;
constexpr size_t CTRL_BYTES = 65536;
constexpr size_t OFF_TAB = CTRL_BYTES;
constexpr size_t OFF_MOD = OFF_TAB + 131072;
constexpr size_t OFF_W = OFF_MOD + 262144;
constexpr size_t W_GU = (size_t)5632 * 1024 * 2, W_D = (size_t)1024 * 2816 * 2, W_IN = (size_t)2560 * 1024 * 2, W_OUT = (size_t)1024 * 1024 * 2;
constexpr size_t WL_GU1 = 0, WL_D1 = WL_GU1 + W_GU, WL_IN = WL_D1 + W_D, WL_OUT = WL_IN + W_IN, WL_GU2 = WL_OUT + W_OUT, WL_D2 = WL_GU2 + W_GU, W_LAYER = WL_D2 + W_D;
constexpr size_t OFF_H = OFF_W + 2 * W_LAYER;
constexpr size_t OFF_ACT = OFF_H + (size_t)NTOK * 1024 * 2;
constexpr size_t OFF_U = OFF_ACT + (size_t)NTOK * 2816 * 2;
constexpr size_t OFF_MIX = OFF_U + (size_t)NTOK * 2560 * 4;
constexpr size_t OFF_QA = OFF_MIX + (size_t)NTOK * 1024 * 2;
constexpr size_t OFF_QB = OFF_QA + (size_t)NTOK * 256 * 2;
constexpr size_t OFF_KA = OFF_QB + (size_t)NTOK * 256 * 2;
constexpr size_t OFF_VA = OFF_KA + (size_t)NKROW * 128 * 2;
constexpr size_t OFF_KB = OFF_VA + (size_t)NKROW * 128 * 2;
constexpr size_t OFF_VB = OFF_KB + (size_t)NKROW * 128 * 2;
constexpr size_t OFF_DQ = OFF_VB + (size_t)NKROW * 128 * 2;
constexpr size_t OFF_DK = OFF_DQ + (size_t)NTOK * 256 * 2;
constexpr size_t OFF_DV = OFF_DK + (size_t)NTOK * 256 * 2;
constexpr size_t OFF_CA = OFF_DV + (size_t)NTOK * 256 * 2;
constexpr size_t OFF_CB = OFF_CA + (size_t)2 * NTOK * 256 * 4;
constexpr size_t OFF_HF = OFF_CB + (size_t)2 * NTOK * 256 * 4;
constexpr size_t OFF_TA = OFF_HF + (size_t)2 * NTOK * 256 * 4;
constexpr size_t OFF_TB = OFF_TA + (size_t)2 * 96 * 256 * 4;
constexpr size_t OFF_CWT = OFF_TB + (size_t)2 * 96 * 256 * 4;
constexpr size_t OFF_XB = OFF_CWT + (size_t)2 * 4 * 4 * 4096 * 2;
constexpr size_t WS_TOTAL = OFF_XB + (size_t)NTOK * 1024 * 2;
static_assert(WS_TOTAL < (size_t)300 * 1024 * 1024, "workspace too large");

constexpr int SHM_BYTES = 131072;
constexpr int NPHASE = 24;

struct Params {
    const float* in[N_IN];
    float* out;
    unsigned char* ws;
    int never;
    int pad;
};

struct Ctx { const float* const* in; float* out; unsigned char* ws; };

extern __shared__ __attribute__((aligned(16))) bf16_t shm[];

DEVI unsigned pk_bf16(float lo, float hi) { unsigned r; asm("v_cvt_pk_bf16_f32 %0, %1, %2" : "=v"(r) : "v"(lo), "v"(hi)); return r; }
DEVI bf16_t to_bf16(float x) { return (bf16_t)(pk_bf16(x, 0.f) & 0xffffu); }
DEVI f32x4 ldb4(const bf16_t* p) {
    const u32x2 w = *(const u32x2*)p; f32x4 r;
    r[0] = __builtin_bit_cast(float, w.x << 16); r[1] = __builtin_bit_cast(float, w.x & 0xffff0000u);
    r[2] = __builtin_bit_cast(float, w.y << 16); r[3] = __builtin_bit_cast(float, w.y & 0xffff0000u);
    return r;
}
DEVI float wave_sum(float v) {
#pragma unroll
    for (int o = 32; o > 0; o >>= 1) v += __shfl_xor(v, o);
    return v;
}
DEVI int opaque_tid() { int t = threadIdx.x; asm volatile("" : "+v"(t)); return t; }
DEVI float fexp2(float x) { return __builtin_amdgcn_exp2f(x); }
DEVI float sigmoidf_(float x) { return __builtin_amdgcn_rcpf(1.f + __expf(-x)); }
DEVI float siluf_(float x) { return x * sigmoidf_(x); }

#define XB_TMO      128
#define XB_XCNT(j)  (256  + 64 * (j))
#define XB_XSUB(j)  (1280 + 64 * (j))
#define XB_XGEN(j)  (2304 + 64 * (j))
#define XB_TOP      3328
#define XB_TOPGEN   3392
#define XCD_BAR_WORDS 3456
#define XB_SPIN_CAP (1u << 20)
DEVI unsigned xb_ld(unsigned* p) { return __hip_atomic_load(p, __ATOMIC_RELAXED, __HIP_MEMORY_SCOPE_AGENT); }
DEVI unsigned xb_add(unsigned* p, unsigned v) { return __hip_atomic_fetch_add(p, v, __ATOMIC_RELAXED, __HIP_MEMORY_SCOPE_AGENT); }
DEVI unsigned xb_xcc_id() { return (unsigned)__builtin_amdgcn_s_getreg((3 << 11) | 20) & 0xFu; }
#define XB_SPIN(cond, bar) do { unsigned _sp = 0; while (cond) { __builtin_amdgcn_s_sleep(1); \
    if ((++_sp & 255u) == 0u) { if (xb_ld(&(bar)[XB_TMO])) break; if (_sp > XB_SPIN_CAP) { atomicAdd(&(bar)[XB_TMO], 1u); break; } } } } while (0)
struct XcdBarrier { unsigned* bar; unsigned x; volatile LAS unsigned* st; };
DEVI XcdBarrier xcd_barrier_post(unsigned* bar, volatile LAS unsigned* st) {
    XcdBarrier b; b.bar = bar; b.x = xb_xcc_id(); b.st = st;
    if (threadIdx.x == 0) (void)xb_add(&bar[XB_XCNT(b.x)], 1u);
    return b;
}
DEVI void xcd_barrier_complete(unsigned* bar, unsigned x, unsigned& nloc, unsigned& nx) {
    const unsigned G = gridDim.x * gridDim.y * gridDim.z;
    unsigned sum, cnt, mine, sp = 0u;
    for (;;) {
        sum = 0u; cnt = 0u; mine = 0u;
#pragma unroll
        for (unsigned j = 0; j < 16; ++j) { const unsigned c = xb_ld(&bar[XB_XCNT(j)]); sum += c; cnt += (c > 0u) ? 1u : 0u; mine = (j == x) ? c : mine; }
        if (sum == G) break;
        __builtin_amdgcn_s_sleep(1);
        if ((++sp & 255u) == 0u) { if (xb_ld(&bar[XB_TMO])) break; if (sp > XB_SPIN_CAP) { atomicAdd(&bar[XB_TMO], 1u); break; } }
    }
    nloc = mine > 0u ? mine : 1u; nx = cnt > 0u ? cnt : 1u;
}
DEVI void xcd_barrier(const XcdBarrier& b) {
    asm volatile("s_waitcnt vmcnt(0)" ::: "memory");
    __syncthreads();
    if (threadIdx.x == 0) {
        unsigned* bar = b.bar;
        asm volatile("" : "+s"(bar));
        __builtin_amdgcn_s_waitcnt(0);
        unsigned nloc = b.st[0], nx = b.st[1];
        if (nloc == 0u) { xcd_barrier_complete(bar, b.x, nloc, nx); b.st[0] = nloc; b.st[1] = nx; }
        const unsigned old = xb_add(&bar[XB_XSUB(b.x)], 1u);
        const unsigned gen = old / nloc;
        if (old + 1u == (gen + 1u) * nloc) {
            __builtin_amdgcn_fence(__ATOMIC_RELEASE, "agent");
            asm volatile("s_waitcnt vmcnt(0)" ::: "memory");
            const unsigned og = xb_add(&bar[XB_TOP], 1u);
            const unsigned tg = og / nx;
            if (og + 1u == (tg + 1u) * nx) xb_add(&bar[XB_TOPGEN], 1u);
            else XB_SPIN(xb_ld(&bar[XB_TOPGEN]) == tg, bar);
            __builtin_amdgcn_fence(__ATOMIC_ACQUIRE, "agent");
            xb_add(&bar[XB_XGEN(b.x)], 1u);
            asm volatile("s_waitcnt vmcnt(0)" ::: "memory");
        } else {
            XB_SPIN(xb_ld(&bar[XB_XGEN(b.x)]) == gen, bar);
            __builtin_amdgcn_fence(__ATOMIC_ACQUIRE, "agent");
            asm volatile("s_waitcnt vmcnt(0)" ::: "memory");
        }
    }
    __syncthreads();
}

constexpr int BM = 256, BK = 64, HALF = 128, HTB = HALF * BK * 2;
DEVI int lds_byte(int r, int c) { const int st = (r >> 4) * 2 + (c >> 5), rr = r & 15, cc = c & 31, ob = rr * 64 + cc * 2; return st * 1024 + (ob ^ (((ob >> 9) & 1) << 5)); }
DEVI void stage_rc(int b, int& R, int& C) { const int st = b / 1024, sb = b % 1024, swz = sb ^ (((sb >> 9) & 1) << 5); R = (st >> 1) * 16 + swz / 64; C = (st & 1) * 32 + (swz % 64) / 2; }

enum { EPI_GU = 0, EPI_PART = 1, EPI_U = 2 };
struct GemmDesc { const bf16_t* A; const bf16_t* Bt; int K; int nM, nN, S, nt; int epi; void* out; };
struct Unit { int pm, pn, ks; };

DEVI bool gemm_next(const GemmDesc& g, int i, Unit& u) {
    const int nwg = g.nM * g.nN;
    const long L = (long)i * gridDim.x + blockIdx.x;
    if (L >= (long)nwg * g.S) return false;
    u.ks = (int)(L / nwg);
    int wgid = (int)(L % nwg);
    { const int q = nwg / 8, r = nwg % 8, xcd = wgid % 8, off = wgid / 8; wgid = (xcd < r ? xcd * (q + 1) : r * (q + 1) + (xcd - r) * q) + off; }
    const int WGM = 4;
    const int nig = WGM * g.nN, gid = wgid / nig, fm = gid * WGM, gsz = (g.nM - fm) < WGM ? (g.nM - fm) : WGM;
    u.pm = fm + ((wgid % nig) % gsz); u.pn = (wgid % nig) / gsz;
    return true;
}

DEVI void gemm_epilogue(const GemmDesc& g, const f32x4 (&acc)[2][2][4][2], const Unit& u, int wr, int wc, int fr, int fq) {
    const int brow = u.pm * BM, bcol = u.pn * BM;
    if (g.epi == EPI_GU) {
        bf16_t* act = (bf16_t*)g.out;
#pragma unroll
        for (int ai = 0; ai < 2; ++ai)
#pragma unroll
            for (int m = 0; m < 4; ++m) {
                const int row = brow + ai * HALF + wr * 64 + m * 16 + fr;
                const int hcol = u.pn * 128 + wc * 32 + fq * 8;
                u32x4 w;
                { const f32x4 gt = acc[ai][0][m][0], up = acc[ai][1][m][0];
                  w.x = pk_bf16(siluf_(gt[0]) * up[0], siluf_(gt[1]) * up[1]); w.y = pk_bf16(siluf_(gt[2]) * up[2], siluf_(gt[3]) * up[3]); }
                { const f32x4 gt = acc[ai][0][m][1], up = acc[ai][1][m][1];
                  w.z = pk_bf16(siluf_(gt[0]) * up[0], siluf_(gt[1]) * up[1]); w.w = pk_bf16(siluf_(gt[2]) * up[2], siluf_(gt[3]) * up[3]); }
                *(u32x4*)(act + (size_t)row * DFF + hcol) = w;
            }
    } else if (g.epi == EPI_PART) {
        bf16_t* o = (bf16_t*)g.out + (size_t)u.ks * NTOK * DM;
#pragma unroll
        for (int ai = 0; ai < 2; ++ai)
#pragma unroll
            for (int m = 0; m < 4; ++m) {
                const int row = brow + ai * HALF + wr * 64 + m * 16 + fr;
#pragma unroll
                for (int bj = 0; bj < 2; ++bj) {
                    const int col = bcol + bj * HALF + wc * 32 + fq * 8;
                    const f32x4 v0 = acc[ai][bj][m][0], v1 = acc[ai][bj][m][1];
                    u32x4 w; w.x = pk_bf16(v0[0], v0[1]); w.y = pk_bf16(v0[2], v0[3]); w.z = pk_bf16(v1[0], v1[1]); w.w = pk_bf16(v1[2], v1[3]);
                    *(u32x4*)(o + (size_t)row * DM + col) = w;
                }
            }
    } else {
        bf16_t* o = (bf16_t*)g.out;
#pragma unroll
        for (int ai = 0; ai < 2; ++ai)
#pragma unroll
            for (int m = 0; m < 4; ++m) {
                const int row = brow + ai * HALF + wr * 64 + m * 16 + fr;
#pragma unroll
                for (int bj = 0; bj < 2; ++bj) {
                    const int col = bcol + bj * HALF + wc * 32 + fq * 8;
                    const f32x4 v0 = acc[ai][bj][m][0], v1 = acc[ai][bj][m][1];
                    u32x4 w; w.x = pk_bf16(v0[0], v0[1]); w.y = pk_bf16(v0[2], v0[3]); w.z = pk_bf16(v1[0], v1[1]); w.w = pk_bf16(v1[2], v1[3]);
                    *(u32x4*)(o + (size_t)row * INW + col) = w;
                }
            }
    }
}

DEVI void gemm_phase(const GemmDesc g) {
    LAS unsigned char* lds = (LAS unsigned char*)shm;
    const int tid = opaque_tid(), wid = __builtin_amdgcn_readfirstlane(tid >> 6), lane = tid & 63, wr = wid >> 2, wc = wid & 3, fr = lane & 15, fq = lane >> 4;
    const int K = g.K, nt = g.nt;
    unsigned voffA[2], voffB[2];
#pragma unroll
    for (int i = 0; i < 2; ++i) { int R, C; stage_rc(tid * 16 + i * 8192, R, C); voffA[i] = (unsigned)(R * K + C) * 2u;
        const int rho = R & 31, pr = 8 * ((rho & 15) >> 2) + 4 * (rho >> 4) + (rho & 3); voffB[i] = (unsigned)(((R & ~31) + pr) * K + C) * 2u; }
    const size_t kstep = (size_t)(BK * 2);
    const size_t hstep = (size_t)HALF * K * 2;
    const size_t tstep = 2 * hstep;
    const size_t sstep = (size_t)nt * kstep;
    const unsigned ldsw = (unsigned)wid * 1024u;
    const int aoff = lds_byte(wr * 64 + fr, fq * 8), boff = lds_byte(wc * 32 + fr, fq * 8);
#define PG8_SA(b, h) (((b) * 2 + (h)) * HTB)
#define PG8_SB(b, h) ((4 + (b) * 2 + (h)) * HTB)
#define PG8_STAGE(bufoff, gbase, voff) do { _Pragma("unroll") for (int _i = 0; _i < 2; ++_i) \
        __builtin_amdgcn_global_load_lds((const unsigned*)((const char*)(gbase) + (voff)[_i]), (LAS unsigned*)(lds + (bufoff) + ldsw + _i * 8192), 16, 0, 0); } while (0)
#define PG8_LDA(dst, b, h) do { _Pragma("unroll") for (int m = 0; m < 4; ++m) _Pragma("unroll") for (int k = 0; k < 2; ++k) dst[m][k] = *(const LAS bf16x8*)(lds + PG8_SA(b, h) + aoff + m * 2048 + k * 1024); } while (0)
#define PG8_LDB(dst, b, h) do { _Pragma("unroll") for (int n = 0; n < 2; ++n) _Pragma("unroll") for (int k = 0; k < 2; ++k) dst[n][k] = *(const LAS bf16x8*)(lds + PG8_SB(b, h) + boff + n * 2048 + k * 1024); } while (0)
#define PG8_MMA(ai, bj, At, Bt) do { __builtin_amdgcn_s_setprio(1); _Pragma("unroll") for (int m = 0; m < 4; ++m) _Pragma("unroll") for (int n = 0; n < 2; ++n) _Pragma("unroll") for (int k = 0; k < 2; ++k) \
        acc[ai][bj][m][n] = __builtin_amdgcn_mfma_f32_16x16x32_bf16(Bt[n][k], At[m][k], acc[ai][bj][m][n], 0, 0, 0); __builtin_amdgcn_s_setprio(0); } while (0)
#define PG8_WAIT_V(n) asm volatile("s_waitcnt vmcnt(" #n ")" ::: "memory")
#define PG8_WAIT_L(n) asm volatile("s_waitcnt lgkmcnt(" #n ")" ::: "memory")
#define PG8_BAR __builtin_amdgcn_s_barrier()
#define PG8_SCHED __builtin_amdgcn_sched_barrier(0)
    Unit cur, nxt; int ui = 0;
    if (!gemm_next(g, 0, cur)) return;
    f32x4 acc[2][2][4][2];
#pragma unroll
    for (int a = 0; a < 2; ++a)
#pragma unroll
        for (int b = 0; b < 2; ++b)
#pragma unroll
            for (int m = 0; m < 4; ++m)
#pragma unroll
                for (int n = 0; n < 2; ++n) acc[a][b][m][n] = (f32x4){0.f, 0.f, 0.f, 0.f};
    bf16x8 At[4][2], B0[2][2], B1[2][2];
    const char* cA = (const char*)g.A + (size_t)cur.pm * tstep + (size_t)cur.ks * sstep;
    const char* cB = (const char*)g.Bt + (size_t)cur.pn * tstep + (size_t)cur.ks * sstep;
    PG8_STAGE(PG8_SB(0, 0), cB, voffB); PG8_STAGE(PG8_SB(0, 1), cB + hstep, voffB); PG8_STAGE(PG8_SA(0, 0), cA, voffA); PG8_STAGE(PG8_SA(0, 1), cA + hstep, voffA);
    if (wr == 1) PG8_BAR;
    PG8_WAIT_V(2); PG8_BAR;
    PG8_STAGE(PG8_SB(1, 0), cB + kstep, voffB); PG8_STAGE(PG8_SA(1, 0), cA + kstep, voffA); PG8_STAGE(PG8_SB(1, 1), cB + hstep + kstep, voffB);
    PG8_WAIT_V(6); PG8_BAR;
    for (;;) {
        const bool has_next = gemm_next(g, ui + 1, nxt);
        const char* nA = has_next ? (const char*)g.A + (size_t)nxt.pm * tstep + (size_t)nxt.ks * sstep : cA;
        const char* nB = has_next ? (const char*)g.Bt + (size_t)nxt.pn * tstep + (size_t)nxt.ks * sstep : cB;
        for (int t = 0; t < nt; t += 2) {
            const bool last = (t == nt - 2);
            const char* a1 = cA + (size_t)(t + 1) * kstep;
            const char* a2 = last ? nA : cA + (size_t)(t + 2) * kstep; const char* b2 = last ? nB : cB + (size_t)(t + 2) * kstep;
            const char* a3 = a2 + kstep; const char* b3 = b2 + kstep;
            PG8_LDB(B0, 0, 0); PG8_LDB(B1, 0, 1); PG8_SCHED; PG8_LDA(At, 0, 0); PG8_STAGE(PG8_SA(1, 1), a1 + hstep, voffA);
            PG8_WAIT_V(8); PG8_WAIT_L(0); PG8_BAR; PG8_MMA(0, 0, At, B0); PG8_MMA(0, 1, At, B1); PG8_BAR; PG8_SCHED;
            PG8_LDA(At, 0, 1); PG8_STAGE(PG8_SB(0, 0), b2, voffB); PG8_STAGE(PG8_SB(0, 1), b2 + hstep, voffB); PG8_STAGE(PG8_SA(0, 0), a2, voffA);
            PG8_WAIT_V(8); PG8_WAIT_L(0); PG8_BAR; PG8_MMA(1, 0, At, B0); PG8_MMA(1, 1, At, B1); PG8_BAR; PG8_SCHED;
            PG8_LDB(B0, 1, 0); PG8_LDB(B1, 1, 1); PG8_SCHED; PG8_LDA(At, 1, 0); PG8_STAGE(PG8_SA(0, 1), a2 + hstep, voffA);
            PG8_WAIT_V(8); PG8_WAIT_L(0); PG8_BAR; PG8_MMA(0, 0, At, B0); PG8_MMA(0, 1, At, B1); PG8_BAR; PG8_SCHED;
            PG8_LDA(At, 1, 1); PG8_STAGE(PG8_SB(1, 0), b3, voffB); PG8_STAGE(PG8_SB(1, 1), b3 + hstep, voffB); PG8_STAGE(PG8_SA(1, 0), a3, voffA);
            PG8_WAIT_V(8); PG8_WAIT_L(0); PG8_BAR; PG8_MMA(1, 0, At, B0); PG8_MMA(1, 1, At, B1); PG8_BAR; PG8_SCHED;
        }
        if (wr == 0) PG8_BAR;
        gemm_epilogue(g, acc, cur, wr, wc, fr, fq);
        if (!has_next) break;
#pragma unroll
        for (int a = 0; a < 2; ++a)
#pragma unroll
            for (int b = 0; b < 2; ++b)
#pragma unroll
                for (int m = 0; m < 4; ++m)
#pragma unroll
                    for (int n = 0; n < 2; ++n) acc[a][b][m][n] = (f32x4){0.f, 0.f, 0.f, 0.f};
        cur = nxt; cA = nA; cB = nB; ++ui;
        if (wr == 1) PG8_BAR;
    }
    PG8_WAIT_V(0);
    PG8_BAR;
#undef PG8_SA
#undef PG8_SB
#undef PG8_STAGE
#undef PG8_LDA
#undef PG8_LDB
#undef PG8_MMA
#undef PG8_WAIT_V
#undef PG8_WAIT_L
#undef PG8_BAR
#undef PG8_SCHED
}

constexpr int NTR_UNITS = 2560;
constexpr int CONV_C0 = 352;
DEVI void transpose_unit(const Ctx& p, int tu, int t, float* fs) {
    const int l = tu / 1280, r = tu % 1280;
    int which, loc, K, N, mode; size_t dsto;
    if (r < 176)       { which = I_F1G;  loc = r;        K = 1024; N = 2816; mode = 1; dsto = WL_GU1; }
    else if (r < 352)  { which = I_F1U;  loc = r - 176;  K = 1024; N = 2816; mode = 2; dsto = WL_GU1; }
    else if (r < 528)  { which = I_F1D;  loc = r - 352;  K = 2816; N = 1024; mode = 0; dsto = WL_D1; }
    else if (r < 688)  { which = I_WIN;  loc = r - 528;  K = 1024; N = 2560; mode = 0; dsto = WL_IN; }
    else if (r < 752)  { which = I_WOUT; loc = r - 688;  K = 1024; N = 1024; mode = 0; dsto = WL_OUT; }
    else if (r < 928)  { which = I_F2G;  loc = r - 752;  K = 1024; N = 2816; mode = 1; dsto = WL_GU2; }
    else if (r < 1104) { which = I_F2U;  loc = r - 928;  K = 1024; N = 2816; mode = 2; dsto = WL_GU2; }
    else               { which = I_F2D;  loc = r - 1104; K = 2816; N = 1024; mode = 0; dsto = WL_D2; }
    const int nnt = N / 256, kt = loc / nnt, ntile = loc % nnt;
    const float* src = p.in[which] + (size_t)l * K * N + (size_t)kt * 64 * N + ntile * 256;
    bf16_t* dst = (bf16_t*)(p.ws + OFF_W + (size_t)l * W_LAYER + dsto);
    f32x4 v[8];
#pragma unroll
    for (int i = 0; i < 8; ++i) { const int idx = i * 512 + t; v[i] = *(const f32x4*)(src + (size_t)(idx >> 6) * N + (idx & 63) * 4); }
#pragma unroll
    for (int i = 0; i < 8; ++i) { const int idx = i * 512 + t; *(f32x4*)(fs + (idx >> 6) * 260 + (idx & 63) * 4) = v[i]; }
    __syncthreads();
    const int nl = t & 255, kh = t >> 8;
    int drow;
    if (mode == 0) drow = ntile * 256 + nl;
    else drow = (2 * ntile + (nl >> 7)) * 256 + (nl & 127) + (mode == 2 ? 128 : 0);
    bf16_t* dp = dst + (size_t)drow * K + kt * 64 + kh * 32;
#pragma unroll
    for (int c = 0; c < 4; ++c) {
        u32x4 w;
        const float* f = fs + (kh * 32 + c * 8) * 260 + nl;
        w.x = pk_bf16(f[0], f[260]); w.y = pk_bf16(f[2 * 260], f[3 * 260]); w.z = pk_bf16(f[4 * 260], f[5 * 260]); w.w = pk_bf16(f[6 * 260], f[7 * 260]);
        *(u32x4*)(dp + c * 8) = w;
    }
}

DEVI void convert_fill(const Ctx& p, int lo, int hi, int rank, int nrank, int per) {
    const int t = opaque_tid();
    float* fs = (float*)shm;
    for (int i = 0; i < per; ++i) {
        const int tu = lo + rank + i * nrank;
        if (tu >= hi) break;
        __syncthreads();
        transpose_unit(p, tu, t, fs);
    }
}

DEVI void prologue_phase(const Ctx& p) {
    const int t = opaque_tid();
    float* fs = (float*)shm;
    float* mod = (float*)(p.ws + OFF_MOD);
    const int NMOD = 288, NCW = 32, NTR = (gridDim.x == 256) ? CONV_C0 : NTR_UNITS;
    if (gridDim.x == 256) {
        if (blockIdx.x >= 64)
            for (int tu = (int)blockIdx.x - 64; tu < NTR; tu += 192) { __syncthreads(); transpose_unit(p, tu, t, fs); }
    } else {
        for (int tu = blockIdx.x; tu < NTR; tu += gridDim.x) { __syncthreads(); transpose_unit(p, tu, t, fs); }
    }
    for (int u = blockIdx.x; u < NMOD + NCW; u += gridDim.x) {
        __syncthreads();
        if (u >= NMOD && u < NMOD + NCW) {
            const int mi = u - NMOD, l = mi >> 4, m = (mi >> 2) & 3, g = mi & 3, dir = m >> 1;
            const float* w = ((m & 1) ? p.in[I_CWX] : p.in[I_CWA]) + (((size_t)l * 2 + dir) * 4 + g) * 4096;
            bf16_t* wt = (bf16_t*)(p.ws + OFF_CWT) + (((size_t)l * 4 + m) * 4 + g) * 4096;
            const int d = t >> 3, c8 = (t & 7) * 8;
            u32x4 o;
            o.x = pk_bf16(w[(c8 + 0) * 64 + d], w[(c8 + 1) * 64 + d]); o.y = pk_bf16(w[(c8 + 2) * 64 + d], w[(c8 + 3) * 64 + d]);
            o.z = pk_bf16(w[(c8 + 4) * 64 + d], w[(c8 + 5) * 64 + d]); o.w = pk_bf16(w[(c8 + 6) * 64 + d], w[(c8 + 7) * 64 + d]);
            *(u32x4*)(wt + d * 64 + c8) = o;
        } else if (u < NMOD) {
            const int l = u / 144, jb = u % 144;
            for (int i = t; i < 3072; i += 512) {
                const int r = i >> 10, k = i & 1023;
                const float c = (r == 0) ? p.in[I_CCTX][k] : p.in[I_C][(r - 1) * 1024 + k];
                fs[i] = c / (1.f + __expf(-c));
            }
            __syncthreads();
            const int cgp = t & 15, kg = t >> 4;
            const float* w = p.in[I_WMOD] + ((size_t)l * 1024 + kg * 32) * 9216 + jb * 64 + cgp * 4;
            f32x4 a0 = {0, 0, 0, 0}, a1 = {0, 0, 0, 0}, a2 = {0, 0, 0, 0};
#pragma unroll 8
            for (int k = 0; k < 32; ++k) {
                const f32x4 wv = *(const f32x4*)(w + (size_t)k * 9216);
                const int kk = kg * 32 + k;
                a0 += wv * fs[kk]; a1 += wv * fs[1024 + kk]; a2 += wv * fs[2048 + kk];
            }
            float* red = fs + 3072;
            *(f32x4*)(red + kg * 192 + 0 + cgp * 4) = a0;
            *(f32x4*)(red + kg * 192 + 64 + cgp * 4) = a1;
            *(f32x4*)(red + kg * 192 + 128 + cgp * 4) = a2;
            __syncthreads();
            if (t < 192) {
                float sacc = 0.f;
#pragma unroll 8
                for (int k = 0; k < 32; ++k) sacc += red[k * 192 + t];
                const int r = t >> 6, j = t & 63;
                mod[((size_t)l * 3 + r) * 9216 + jb * 64 + j] = sacc + p.in[I_BMOD][(size_t)l * 9216 + jb * 64 + j];
            }
        } else {
            transpose_unit(p, u - NMOD - NCW, t, fs);
        }
    }
}

DEVI void norm_phase(const Ctx& p, int l, int which, int dry) {
    const int t_ = opaque_tid();
    const int lane = t_ & 63, gw = blockIdx.x * 8 + (t_ >> 6), nw = gridDim.x * 8;
    const float* mod = (const float*)(p.ws + OFF_MOD);
    const bf16_t* P0 = (const bf16_t*)(p.ws + OFF_U);
    const bf16_t* P1 = P0 + (size_t)NTOK * DM;
    bf16_t* H = (bf16_t*)(p.ws + OFF_H);
    bf16_t* XB = (bf16_t*)(p.ws + OFF_XB);
    const bool first = (l == 0 && which == 1);
    int gl, gi; float coef;
    if (which == 1) { gl = l - 1; gi = 8; coef = 0.5f; }
    else if (which == 2) { gl = l; gi = 2; coef = 0.5f; }
    else if (which == 3) { gl = l; gi = 5; coef = 1.0f; }
    else { gl = 1; gi = 8; coef = 0.5f; }
    if (dry) coef = 0.f;
    const float* gn = (which == 1) ? p.in[I_N1] : (which == 2) ? p.in[I_N2] : p.in[I_N3];
    const int shi = (which - 1) * 3, sci = shi + 1;
    for (int tok0 = gw; tok0 < NTOK; tok0 += 3 * nw) {
        f32x4 xv[3][4];
        float ss[3] = {0.f, 0.f, 0.f};
        int rr[3];
        bool ok[3];
        f32x4 g[4], sc[3][4], sh[3][4];
#pragma unroll
        for (int k = 0; k < 3; ++k) {
            const int tok = tok0 + k * nw;
            ok[k] = tok < NTOK;
            const int tk = ok[k] ? tok : tok0;
            rr[k] = tk < NCTX ? 0 : 1 + ((tk - NCTX) >> 10);
            if (which != 4) {
#pragma unroll
                for (int i = 0; i < 4; ++i) {
                    const int c = lane * 4 + i * 256;
                    if (k == 0) g[i] = *(const f32x4*)(gn + (size_t)l * DM + c);
                    sc[k][i] = *(const f32x4*)(mod + ((size_t)l * 3 + rr[k]) * 9216 + sci * 1024 + c);
                    sh[k][i] = *(const f32x4*)(mod + ((size_t)l * 3 + rr[k]) * 9216 + shi * 1024 + c);
                }
            }
            if (first) {
#pragma unroll
                for (int i = 0; i < 4; ++i) {
                    const int c = lane * 4 + i * 256;
                    xv[k][i] = (tk < NCTX) ? *(const f32x4*)(p.in[I_XP] + (size_t)tk * DM + c) : *(const f32x4*)(p.in[I_XS] + (size_t)(tk - NCTX) * DM + c);
                }
            } else {
                u32x2 pa[4], pb[4], xb[4]; f32x4 gv[4];
#pragma unroll
                for (int i = 0; i < 4; ++i) {
                    const int c = lane * 4 + i * 256;
                    xb[i] = *(const u32x2*)(XB + (size_t)tk * DM + c);
                    pa[i] = *(const u32x2*)(P0 + (size_t)tk * DM + c); pb[i] = *(const u32x2*)(P1 + (size_t)tk * DM + c);
                    gv[i] = *(const f32x4*)(mod + ((size_t)gl * 3 + rr[k]) * 9216 + gi * 1024 + c);
                }
#pragma unroll
                for (int i = 0; i < 4; ++i) {
                    f32x4 s2;
                    s2[0] = __builtin_bit_cast(float, pa[i].x << 16) + __builtin_bit_cast(float, pb[i].x << 16);
                    s2[1] = __builtin_bit_cast(float, pa[i].x & 0xffff0000u) + __builtin_bit_cast(float, pb[i].x & 0xffff0000u);
                    s2[2] = __builtin_bit_cast(float, pa[i].y << 16) + __builtin_bit_cast(float, pb[i].y << 16);
                    s2[3] = __builtin_bit_cast(float, pa[i].y & 0xffff0000u) + __builtin_bit_cast(float, pb[i].y & 0xffff0000u);
                    f32x4 x0;
                    x0[0] = __builtin_bit_cast(float, xb[i].x << 16); x0[1] = __builtin_bit_cast(float, xb[i].x & 0xffff0000u);
                    x0[2] = __builtin_bit_cast(float, xb[i].y << 16); x0[3] = __builtin_bit_cast(float, xb[i].y & 0xffff0000u);
                    xv[k][i] = x0 + coef * gv[i] * s2;
                }
            }
        }
#pragma unroll
        for (int k = 0; k < 3; ++k) {
            const int tok = tok0 + k * nw;
            if (ok[k]) {
                if (which == 4) {
#pragma unroll
                    for (int i = 0; i < 4; ++i) *(f32x4*)(p.out + (size_t)tok * DM + lane * 4 + i * 256) = xv[k][i];
                } else {
#pragma unroll
                    for (int i = 0; i < 4; ++i) { u32x2 w; w.x = pk_bf16(xv[k][i][0], xv[k][i][1]); w.y = pk_bf16(xv[k][i][2], xv[k][i][3]); *(u32x2*)(XB + (size_t)tok * DM + lane * 4 + i * 256) = w; }
                }
            }
#pragma unroll
            for (int i = 0; i < 4; ++i) ss[k] += xv[k][i][0] * xv[k][i][0] + xv[k][i][1] * xv[k][i][1] + xv[k][i][2] * xv[k][i][2] + xv[k][i][3] * xv[k][i][3];
        }
        if (which == 4) continue;
#pragma unroll
        for (int k = 0; k < 3; ++k) ss[k] = wave_sum(ss[k]);
#pragma unroll
        for (int k = 0; k < 3; ++k) {
            const int tok = tok0 + k * nw;
            const float rstd = rsqrtf(ss[k] * (1.f / 1024.f) + 1e-6f);
            if (ok[k]) {
#pragma unroll
                for (int i = 0; i < 4; ++i) {
                    const f32x4 y = xv[k][i] * rstd * g[i] * (1.f + sc[k][i]) + sh[k][i];
                    u32x2 w; w.x = pk_bf16(y[0], y[1]); w.y = pk_bf16(y[2], y[3]);
                    *(u32x2*)(H + (size_t)tok * DM + lane * 4 + i * 256) = w;
                }
            }
        }
    }
}

DEVI float rope_apply(float y, int d, int rowp, int colp) {
    const float part = __shfl_xor(y, 16);
    const int dd = d & 31, i = dd & 15;
    const float pos = (float)((d < 32) ? rowp : colp);
    const float inv = exp2f(-(float)i * (13.287712379549449f / 16.f));
    const float ang = pos * inv;
    float sn, cs;
    __sincosf(ang, &sn, &cs);
    return (dd < 16) ? (y * cs - part * sn) : (part * sn + y * cs);
}

DEVI void prep_phase(const Ctx& p, int l) {
    const int t = opaque_tid(), lane = t & 63, wid = t >> 6;
    const bf16_t* U = (const bf16_t*)(p.ws + OFF_U);
    float* fs = (float*)shm;
    float* CA = (float*)(p.ws + OFF_CA);
    float* CB = (float*)(p.ws + OFF_CB);
    for (int u = blockIdx.x; u < 384; u += gridDim.x) {
        __syncthreads();
        const int tt = u >> 2, g = u & 3, tok0 = tt * 64;
        int T, tpos0;
        if (tok0 < NCTX) { T = 256; tpos0 = tok0 & 255; } else { T = 1024; tpos0 = (tok0 - NCTX) & 1023; }
        float* xcs = fs;
        float* cmp = fs + 64 * 68;
        {
            const int tk = t >> 3, c8 = (t & 7) * 8;
            f32x4 a0 = *(const f32x4*)(p.in[I_CCB] + l * 256 + g * 64 + c8), a1 = *(const f32x4*)(p.in[I_CCB] + l * 256 + g * 64 + c8 + 4);
#pragma unroll
            for (int w = 0; w < 4; ++w) {
                const int tp = tpos0 + tk + w - 2;
                if (tp >= 0 && tp < T) {
                    const bf16_t* up = U + (size_t)(tok0 + tk + w - 2) * INW + 1024 + g * 64 + c8;
                    const float* cw = p.in[I_CCW] + ((size_t)l * 4 + w) * 256 + g * 64 + c8;
                    a0 += ldb4(up) * *(const f32x4*)cw;
                    a1 += ldb4(up + 4) * *(const f32x4*)(cw + 4);
                }
            }
            *(f32x4*)(xcs + tk * 68 + c8) = a0; *(f32x4*)(xcs + tk * 68 + c8 + 4) = a1;
        }
        __syncthreads();
        {
            const int fr = lane & 15, fq = lane >> 4, tt4 = wid & 3, dtb = (wid >> 2) * 2;
            bf16x8 af[2];
#pragma unroll
            for (int ks = 0; ks < 2; ++ks) {
                const f32x4 x0 = *(const f32x4*)(xcs + (tt4 * 16 + fr) * 68 + ks * 32 + fq * 8), x1 = *(const f32x4*)(xcs + (tt4 * 16 + fr) * 68 + ks * 32 + fq * 8 + 4);
                u32x4 w; w.x = pk_bf16(x0[0], x0[1]); w.y = pk_bf16(x0[2], x0[3]); w.z = pk_bf16(x1[0], x1[1]); w.w = pk_bf16(x1[2], x1[3]);
                af[ks] = __builtin_bit_cast(bf16x8, w);
            }
            const bf16_t* cwt = (const bf16_t*)(p.ws + OFF_CWT) + (size_t)l * 16 * 4096;
#pragma unroll
            for (int di = 0; di < 2; ++di) {
                const int dcol = (dtb + di) * 16 + fr, ch = g * 64 + dcol;
                f32x4 acc[4];
#pragma unroll
                for (int m = 0; m < 4; ++m) {
                    acc[m] = (f32x4){0.f, 0.f, 0.f, 0.f};
#pragma unroll
                    for (int ks = 0; ks < 2; ++ks) {
                        const bf16x8 bfr = *(const bf16x8*)(cwt + ((size_t)(m * 4 + g) * 64 + dcol) * 64 + ks * 32 + fq * 8);
                        acc[m] = __builtin_amdgcn_mfma_f32_16x16x32_bf16(af[ks], bfr, acc[m], 0, 0, 0);
                    }
                }
#pragma unroll
                for (int dir = 0; dir < 2; ++dir) {
                    const float ba = p.in[I_CBA][((size_t)l * 2 + dir) * 256 + ch], bx = p.in[I_CBX][((size_t)l * 2 + dir) * 256 + ch];
                    const float lam = p.in[I_CLAM][((size_t)l * 2 + dir) * 256 + ch];
                    const float sp = log1pf(expf(-lam));
                    float av[4], bv[4];
#pragma unroll
                    for (int r = 0; r < 4; ++r) {
                        const int tl = tt4 * 16 + fq * 4 + r;
                        const float rg = sigmoidf_(acc[dir * 2][r] + ba);
                        const float ig = sigmoidf_(acc[dir * 2 + 1][r] + bx);
                        const float la = -8.f * rg * sp;
                        const float a = __expf(la);
                        const float t2 = 2.f * la;
                        const float em = -t2 * (1.f + t2 * (0.5f + t2 * (0.16666667f + t2 * (0.041666668f + t2 * (0.008333334f + t2 * 0.0013888889f)))));
                        const float bb = __builtin_amdgcn_sqrtf(em) * (ig * xcs[tl * 68 + dcol]);
                        CA[((size_t)dir * NTOK + tok0 + tl) * 256 + ch] = a;
                        CB[((size_t)dir * NTOK + tok0 + tl) * 256 + ch] = bb;
                        av[r] = a; bv[r] = bb;
                    }
                    float Ac = 1.f, Bc = 0.f;
                    if (dir == 0) {
#pragma unroll
                        for (int r = 0; r < 4; ++r) { Bc = av[r] * Bc + bv[r]; Ac *= av[r]; }
                    } else {
#pragma unroll
                        for (int r = 3; r >= 0; --r) { Bc = av[r] * Bc + bv[r]; Ac *= av[r]; }
                    }
                    const int grp = tt4 * 4 + fq;
                    cmp[((dir * 16 + grp) * 2 + 0) * 64 + dcol] = Ac;
                    cmp[((dir * 16 + grp) * 2 + 1) * 64 + dcol] = Bc;
                }
            }
        }
        __syncthreads();
        if (t < 128) {
            const int dir = t >> 6, dd = t & 63;
            float Ac = 1.f, Bc = 0.f;
#pragma unroll
            for (int q = 0; q < 16; ++q) {
                const int gq = dir == 0 ? q : 15 - q;
                const float a = cmp[((dir * 16 + gq) * 2 + 0) * 64 + dd], b = cmp[((dir * 16 + gq) * 2 + 1) * 64 + dd];
                Bc = a * Bc + b; Ac *= a;
            }
            float* TA = (float*)(p.ws + OFF_TA); float* TB = (float*)(p.ws + OFF_TB);
            TA[((size_t)dir * 96 + tt) * 256 + g * 64 + dd] = Ac;
            TB[((size_t)dir * 96 + tt) * 256 + g * 64 + dd] = Bc;
        }
    }
    const int gw = blockIdx.x * 8 + wid, nw = gridDim.x * 8;
    bf16_t* QA = (bf16_t*)(p.ws + OFF_QA); bf16_t* QB = (bf16_t*)(p.ws + OFF_QB);
    bf16_t* KA = (bf16_t*)(p.ws + OFF_KA); bf16_t* VA = (bf16_t*)(p.ws + OFF_VA);
    bf16_t* KB = (bf16_t*)(p.ws + OFF_KB); bf16_t* VB = (bf16_t*)(p.ws + OFF_VB);
    bf16_t* DQ = (bf16_t*)(p.ws + OFF_DQ); bf16_t* DK = (bf16_t*)(p.ws + OFF_DK); bf16_t* DV = (bf16_t*)(p.ws + OFF_DV);
    {
        const int sub = lane >> 4, li = lane & 15;
        const f32x4 gaq = *(const f32x4*)(p.in[I_AQN] + l * 64 + li * 4), gak = *(const f32x4*)(p.in[I_AKN] + l * 64 + li * 4);
        const f32x4 gbq = *(const f32x4*)(p.in[I_BQN] + l * 64 + li * 4), gbk = *(const f32x4*)(p.in[I_BKN] + l * 64 + li * 4);
        const bool bal = gridDim.x == 256;
        const int tgw = bal ? ((int)blockIdx.x - 128) * 8 + wid : gw, tnw = bal ? 128 * 8 : nw;
        for (int tb = tgw * 4; tb < NTOK && tb >= 0; tb += tnw * 4) {
            const int tok = tb + sub;
            const bool lat = tok >= NCTX;
            int b, tp;
            if (!lat) { b = tok >> 8; tp = tok & 255; } else { b = (tok - NCTX) >> 10; tp = (tok - NCTX) & 1023; }
            const size_t krow = lat ? (size_t)(NCTX + b * 1536 + 512 + tp) : (size_t)tok;
            const bf16_t* ur = U + (size_t)tok * INW + li * 4;
            f32x4 cs = {1.f, 1.f, 1.f, 1.f}, sn = {0.f, 0.f, 0.f, 0.f};
            if (lat) {
                const float pos = (float)((li < 8) ? (tp >> 6) : (tp & 63));
#pragma unroll
                for (int e = 0; e < 4; ++e) {
                    const int fi = (li & 3) * 4 + e;
                    const float ang = pos * exp2f(-(float)fi * (13.287712379549449f / 16.f));
                    float s_, c_; __sincosf(ang, &s_, &c_);
                    cs[e] = c_; sn[e] = s_;
                }
            }
            const bool first = (li & 7) < 4;
#define PREP_NORM(v, gain) do { float ss_ = v[0] * v[0] + v[1] * v[1] + v[2] * v[2] + v[3] * v[3]; \
                ss_ += __shfl_xor(ss_, 1); ss_ += __shfl_xor(ss_, 2); ss_ += __shfl_xor(ss_, 4); ss_ += __shfl_xor(ss_, 8); \
                v = v * rsqrtf(ss_ * (1.f / 64.f) + 1e-6f) * gain; } while (0)
#define PREP_ROPE(v) do { if (lat) { f32x4 pt_; pt_[0] = __shfl_xor(v[0], 4); pt_[1] = __shfl_xor(v[1], 4); pt_[2] = __shfl_xor(v[2], 4); pt_[3] = __shfl_xor(v[3], 4); \
                v = first ? (v * cs - pt_ * sn) : (pt_ * sn + v * cs); } } while (0)
#define PREP_ST4(ptr, v) do { u32x2 w_; w_.x = pk_bf16(v[0], v[1]); w_.y = pk_bf16(v[2], v[3]); *(u32x2*)(ptr) = w_; } while (0)
#pragma unroll
            for (int mx = 0; mx < 2; ++mx) {
                const bf16_t* um = ur + mx * 512;
                bf16_t* Qo = mx ? QB : QA; bf16_t* Ko = mx ? KB : KA; bf16_t* Vo = mx ? VB : VA;
                const f32x4 gq = mx ? gbq : gaq, gk = mx ? gbk : gak;
                float* ck = p.out + (mx ? O_CBK : O_CAK); float* cv = p.out + (mx ? O_CBV : O_CAV);
#pragma unroll
                for (int hq = 0; hq < 4; ++hq) {
                    f32x4 v = ldb4(um + hq * 64);
                    PREP_NORM(v, gq);
                    PREP_ROPE(v);
                    v = v * 0.125f;
                    PREP_ST4(Qo + (size_t)tok * 256 + hq * 64 + li * 4, v);
                }
#pragma unroll
                for (int kv = 0; kv < 2; ++kv) {
                    f32x4 v = ldb4(um + 256 + kv * 64);
                    const f32x4 vv = ldb4(um + 384 + kv * 64);
                    PREP_NORM(v, gk);
                    if (!lat) {
                        const size_t co = (((size_t)b * 2 + l) * 256 + tp) * 128 + kv * 64 + li * 4;
                        *(f32x4*)(ck + co) = v; *(f32x4*)(cv + co) = vv;
                    }
                    PREP_ROPE(v);
                    PREP_ST4(Ko + krow * 128 + kv * 64 + li * 4, v);
                    PREP_ST4(Vo + krow * 128 + kv * 64 + li * 4, vv);
                }
            }
#pragma unroll
            for (int i = 0; i < 4; ++i) {
                const f32x4 q = ldb4(ur + 1536 + i * 64);
                const f32x4 k = ldb4(ur + 1792 + i * 64) * 0.125f;
                const f32x4 v = ldb4(ur + 2048 + i * 64);
                PREP_ST4(DQ + (size_t)tok * 256 + i * 64 + li * 4, q);
                PREP_ST4(DK + (size_t)tok * 256 + i * 64 + li * 4, k);
                PREP_ST4(DV + (size_t)tok * 256 + i * 64 + li * 4, v);
            }
#undef PREP_NORM
#undef PREP_ROPE
#undef PREP_ST4
        }
    }
    for (int it = gw; it < 1024; it += nw) {
        const int b = it >> 9, pos = it & 511;
        const size_t src = (((size_t)b * 2 + l) * 512 + pos) * 128 + lane * 2;
        const size_t dst = ((size_t)(NCTX + b * 1536 + pos)) * 128 + lane * 2;
        f32x2 v;
        v = *(const f32x2*)(p.in[I_CAK] + src); *(unsigned*)(KA + dst) = pk_bf16(v[0], v[1]);
        v = *(const f32x2*)(p.in[I_CAV] + src); *(unsigned*)(VA + dst) = pk_bf16(v[0], v[1]);
        v = *(const f32x2*)(p.in[I_CBK] + src); *(unsigned*)(KB + dst) = pk_bf16(v[0], v[1]);
        v = *(const f32x2*)(p.in[I_CBV] + src); *(unsigned*)(VB + dst) = pk_bf16(v[0], v[1]);
    }
}

DEVI void attn_unit(const Ctx& p, int l, int type, int idx) {
    const int t = opaque_tid(), lane = t & 63, wid = t >> 6, fr = lane & 15, fq = lane >> 4;
    bf16_t* MIX = (bf16_t*)(p.ws + OFF_MIX);
    const bf16_t* U = (const bf16_t*)(p.ws + OFF_U);
    int b, h, qtok0, qpos0, ntiles, kld, kcol, rowbase, ocol;
    const bf16_t *Qp, *Kp, *Vp;
    int plo = 0;
    if (type == 0 || type == 1 || type == 4) {
        b = idx >> 3; h = (idx >> 1) & 3; const int qh = idx & 1;
        qtok0 = b * 256 + qh * 128; qpos0 = qh * 128; ntiles = 4; rowbase = b * 256;
    } else {
        b = idx >> 5; h = (idx >> 3) & 3; const int qb = idx & 7;
        qtok0 = NCTX + b * 1024 + qb * 128; qpos0 = qb * 128;
        if (type == 2) { plo = qpos0 - 128 < 0 ? 0 : qpos0 - 128; const int phi = qpos0 + 256 > 1024 ? 1024 : qpos0 + 256; ntiles = 8 + ((phi - plo) >> 6); rowbase = NCTX + b * 1536; }
        else if (type == 3) { ntiles = 24; rowbase = NCTX + b * 1536; }
        else { ntiles = 16; rowbase = NCTX + b * 1024; }
    }
    if (type == 0 || type == 2) { Qp = (const bf16_t*)(p.ws + OFF_QA); Kp = (const bf16_t*)(p.ws + OFF_KA); Vp = (const bf16_t*)(p.ws + OFF_VA); kld = 128; kcol = (h >> 1) * 64; ocol = h * 64; }
    else if (type == 1 || type == 3) { Qp = (const bf16_t*)(p.ws + OFF_QB); Kp = (const bf16_t*)(p.ws + OFF_KB); Vp = (const bf16_t*)(p.ws + OFF_VB); kld = 128; kcol = (h >> 1) * 64; ocol = 256 + h * 64; }
    else { Qp = (const bf16_t*)(p.ws + OFF_DQ); Kp = (const bf16_t*)(p.ws + OFF_DK); Vp = (const bf16_t*)(p.ws + OFF_DV); kld = 256; kcol = h * 64; ocol = 768 + h * 64; }
    const bool ret = type >= 4;
    const bool dost = (type == 4);
    const int sdir = idx & 1;
    f32x4 SX[2];
#pragma unroll
    for (int i = 0; i < 2; ++i) SX[i] = (f32x4){0.f, 0.f, 0.f, 0.f};
    const int qtok = qtok0 + wid * 16 + fr, qpos = qpos0 + wid * 16 + fr;
    bf16x8 qf[2];
    {
        const bf16_t* qp = Qp + (size_t)qtok * 256 + h * 64 + fq * 8;
        qf[0] = *(const bf16x8*)qp; qf[1] = *(const bf16x8*)(qp + 32);
    }
    float lgf = 0.f, lgb = 0.f;
    if (ret) {
        lgf = log1pf(-expf(p.in[I_DTH][(l * 2 + 0) * 4 + h])) * LOG2E;
        lgb = log1pf(-expf(p.in[I_DTH][(l * 2 + 1) * 4 + h])) * LOG2E;
    }
    float mrun = -1e30f, lrun = 0.f;
    if (type == 0 || type == 2) { mrun = p.in[I_ASINK][l * 4 + h]; lrun = (fq == 0) ? 1.f : 0.f; }
    f32x4 O[4];
#pragma unroll
    for (int i = 0; i < 4; ++i) O[i] = (f32x4){0.f, 0.f, 0.f, 0.f};

    const int skey = t >> 3, sc8 = (t & 7) * 8;
    const int ksw = skey ^ ((sc8 >> 3) << 3);
    const int ATT_BLK = 3 * 64 * 72;
    const int nstage = (ntiles + 3) >> 2;
    u32x4 kr[4], vr[4];
#define ATT_ROW(ti_) ((type == 2) ? (((ti_) < 8) ? rowbase + (ti_) * 64 : rowbase + 512 + plo + ((ti_) - 8) * 64) : rowbase + (ti_) * 64)
#define ATT_LOAD(sp_) do { _Pragma("unroll") for (int j_ = 0; j_ < 4; ++j_) { const int ti_ = (sp_) * 4 + j_; \
        if (ti_ < ntiles) { const int row_ = ATT_ROW(ti_); \
            kr[j_] = *(const u32x4*)(Kp + (size_t)(row_ + skey) * kld + kcol + sc8); \
            vr[j_] = *(const u32x4*)(Vp + (size_t)(row_ + skey) * kld + kcol + sc8); } } } while (0)
    ATT_LOAD(0);
    for (int sp = 0; sp < nstage; ++sp) {
        __syncthreads();
#pragma unroll
        for (int j = 0; j < 4; ++j) {
            const int ti = sp * 4 + j;
            if (ti < ntiles) {
                bf16_t* Kd = shm + j * ATT_BLK; bf16_t* Vd = Kd + 64 * 72;
                const u32x4 kvr = kr[j], vvr = vr[j];
                *(u32x4*)(Kd + skey * 72 + sc8) = kvr;
                Vd[(sc8 + 0) * 72 + ksw] = (bf16_t)(vvr.x & 0xffffu); Vd[(sc8 + 1) * 72 + ksw] = (bf16_t)(vvr.x >> 16);
                Vd[(sc8 + 2) * 72 + ksw] = (bf16_t)(vvr.y & 0xffffu); Vd[(sc8 + 3) * 72 + ksw] = (bf16_t)(vvr.y >> 16);
                Vd[(sc8 + 4) * 72 + ksw] = (bf16_t)(vvr.z & 0xffffu); Vd[(sc8 + 5) * 72 + ksw] = (bf16_t)(vvr.z >> 16);
                Vd[(sc8 + 6) * 72 + ksw] = (bf16_t)(vvr.w & 0xffffu); Vd[(sc8 + 7) * 72 + ksw] = (bf16_t)(vvr.w >> 16);
                if (dost) {
                    bf16_t* Xd = Kd + 2 * 64 * 72; const int mpos = ti * 64 + skey;
                    const float wx = sdir == 0 ? fexp2(lgf * (float)(255 - mpos)) : fexp2(lgb * (float)mpos);
                    const unsigned kw[4] = {kvr.x, kvr.y, kvr.z, kvr.w};
#pragma unroll
                    for (int j2 = 0; j2 < 4; ++j2) {
                        const float klo = __builtin_bit_cast(float, kw[j2] << 16), khi = __builtin_bit_cast(float, kw[j2] & 0xffff0000u);
                        Xd[(sc8 + 2 * j2) * 72 + ksw] = to_bf16(klo * wx); Xd[(sc8 + 2 * j2 + 1) * 72 + ksw] = to_bf16(khi * wx);
                    }
                }
            }
        }
        __syncthreads();
        if (sp + 1 < nstage) ATT_LOAD(sp + 1);
        const int cnt = (ntiles - sp * 4) < 4 ? (ntiles - sp * 4) : 4;
#pragma unroll 1
        for (int j = 0; j < cnt; ++j) {
        const int ti = sp * 4 + j;
        int kpos0; bool masked = false;
        if (type == 2) { if (ti < 8) kpos0 = 0; else { kpos0 = plo + (ti - 8) * 64; masked = true; } }
        else kpos0 = ti * 64;
        const bf16_t* Ks = shm + j * ATT_BLK;
        const bf16_t* VT = Ks + 64 * 72;
        f32x4 st[4];
#pragma unroll
        for (int kt = 0; kt < 4; ++kt) {
            st[kt] = (f32x4){0.f, 0.f, 0.f, 0.f};
#pragma unroll
            for (int dh = 0; dh < 2; ++dh) {
                const bf16x8 kf = *(const bf16x8*)(Ks + (kt * 16 + fr) * 72 + dh * 32 + fq * 8);
                st[kt] = __builtin_amdgcn_mfma_f32_16x16x32_bf16(kf, qf[dh], st[kt], 0, 0, 0);
            }
        }
        float pv[4][4];
        if (!ret) {
            float mx = -1e30f;
#pragma unroll
            for (int kt = 0; kt < 4; ++kt)
#pragma unroll
                for (int r = 0; r < 4; ++r) {
                    float s_ = st[kt][r];
                    if (masked) { const int dlt = kpos0 + kt * 16 + fq * 4 + r - qpos; if (dlt > 128 || dlt < -128) s_ = -1e30f; }
                    pv[kt][r] = s_;
                    mx = fmaxf(mx, s_);
                }
            mx = fmaxf(mx, __shfl_xor(mx, 16)); mx = fmaxf(mx, __shfl_xor(mx, 32));
            const float mnew = fmaxf(mrun, mx);
            const float alpha = fexp2((mrun - mnew) * LOG2E);
            const float mb = mnew * LOG2E;
            float ps = 0.f;
#pragma unroll
            for (int kt = 0; kt < 4; ++kt)
#pragma unroll
                for (int r = 0; r < 4; ++r) {
                    const float s_ = pv[kt][r];
                    float e = fexp2(s_ * LOG2E - mb);
                    if (masked) e = (s_ <= -1e29f) ? 0.f : e;
                    pv[kt][r] = e; ps += e;
                }
            lrun = lrun * alpha + ps; mrun = mnew;
#pragma unroll
            for (int i = 0; i < 4; ++i) O[i] *= alpha;
        } else {
#pragma unroll
            for (int kt = 0; kt < 4; ++kt)
#pragma unroll
                for (int r = 0; r < 4; ++r) {
                    const int dlt = qpos - (kpos0 + kt * 16 + fq * 4 + r);
                    const float w = dlt > 0 ? fexp2(lgf * (float)dlt) : (dlt < 0 ? fexp2(-lgb * (float)dlt) : 2.f);
                    pv[kt][r] = st[kt][r] * w;
                }
        }
#pragma unroll
        for (int pr = 0; pr < 2; ++pr) {
            u32x4 pw;
            pw.x = pk_bf16(pv[2 * pr][0], pv[2 * pr][1]); pw.y = pk_bf16(pv[2 * pr][2], pv[2 * pr][3]);
            pw.z = pk_bf16(pv[2 * pr + 1][0], pv[2 * pr + 1][1]); pw.w = pk_bf16(pv[2 * pr + 1][2], pv[2 * pr + 1][3]);
            const bf16x8 pf = __builtin_bit_cast(bf16x8, pw);
#pragma unroll
            for (int dt = 0; dt < 4; ++dt) {
                const int vsw = ((2 * dt + (fr >> 3)) & 7) << 3;
                const u32x2 lo = *(const u32x2*)(VT + (dt * 16 + fr) * 72 + (((2 * pr) * 16 + fq * 4) ^ vsw));
                const u32x2 hi = *(const u32x2*)(VT + (dt * 16 + fr) * 72 + (((2 * pr + 1) * 16 + fq * 4) ^ vsw));
                u32x4 vw; vw.x = lo.x; vw.y = lo.y; vw.z = hi.x; vw.w = hi.y;
                O[dt] = __builtin_amdgcn_mfma_f32_16x16x32_bf16(__builtin_bit_cast(bf16x8, vw), pf, O[dt], 0, 0, 0);
            }
        }
        if (dost) {
            const bf16_t* KX = Ks + 2 * 64 * 72;
            const int dtw = wid & 3, vt0 = (wid >> 2) * 2;
            const int dsw = ((2 * dtw + (fr >> 3)) & 7) << 3;
#pragma unroll
            for (int ms = 0; ms < 2; ++ms) {
                const bf16x8 bx_ = *(const bf16x8*)(KX + (dtw * 16 + fr) * 72 + ((ms * 32 + fq * 8) ^ dsw));
#pragma unroll
                for (int vi = 0; vi < 2; ++vi) {
                    const int vt = vt0 + vi;
                    const int vsw2 = ((2 * vt + (fr >> 3)) & 7) << 3;
                    const bf16x8 af_ = *(const bf16x8*)(VT + (vt * 16 + fr) * 72 + ((ms * 32 + fq * 8) ^ vsw2));
                    SX[vi] = __builtin_amdgcn_mfma_f32_16x16x32_bf16(af_, bx_, SX[vi], 0, 0, 0);
                }
            }
        }
        }
    }
#undef ATT_ROW
#undef ATT_LOAD
    if (dost) {
        const int dtw = wid & 3, vt0 = (wid >> 2) * 2;
#pragma unroll
        for (int vi = 0; vi < 2; ++vi) {
            const size_t o = (size_t)(dtw * 16 + fr) * 64 + (vt0 + vi) * 16 + fq * 4;
            *(f32x4*)(p.out + O_SD + ((((size_t)b * 2 + l) * 2 + sdir) * 4 + h) * 4096 + o) = SX[vi];
        }
    }
    bf16_t* op = MIX + (size_t)qtok * DM + ocol + fq * 4;
    if (!ret) {
        float ls = lrun; ls += __shfl_xor(ls, 16); ls += __shfl_xor(ls, 32);
        const float inv = 1.f / ls;
#pragma unroll
        for (int dt = 0; dt < 4; ++dt) {
            u32x2 w; w.x = pk_bf16(O[dt][0] * inv, O[dt][1] * inv); w.y = pk_bf16(O[dt][2] * inv, O[dt][3] * inv);
            *(u32x2*)(op + dt * 16) = w;
        }
    } else {
        if (type == 5) {
#pragma unroll
            for (int dir = 0; dir < 2; ++dir) {
                const float* S0 = p.in[I_SD] + ((((size_t)b * 2 + l) * 2 + dir) * 4 + h) * 4096;
                const float wq = dir == 0 ? exp2f(lgf * (float)(qpos + 1)) : exp2f(lgb * (float)(1024 - qpos));
#pragma unroll
                for (int dt = 0; dt < 4; ++dt) {
                    f32x4 tmp = (f32x4){0.f, 0.f, 0.f, 0.f};
#pragma unroll
                    for (int dh = 0; dh < 2; ++dh) {
                        const float* sp = S0 + (size_t)(dh * 32 + fq * 8) * 64 + dt * 16 + fr;
                        u32x4 sw;
                        sw.x = pk_bf16(sp[0], sp[64]); sw.y = pk_bf16(sp[128], sp[192]); sw.z = pk_bf16(sp[256], sp[320]); sw.w = pk_bf16(sp[384], sp[448]);
                        tmp = __builtin_amdgcn_mfma_f32_16x16x32_bf16(__builtin_bit_cast(bf16x8, sw), qf[dh], tmp, 0, 0, 0);
                    }
                    O[dt] += tmp * wq;
                    __builtin_amdgcn_sched_barrier(0);
                }
            }
        }
        float ss = 0.f;
#pragma unroll
        for (int dt = 0; dt < 4; ++dt) ss += O[dt][0] * O[dt][0] + O[dt][1] * O[dt][1] + O[dt][2] * O[dt][2] + O[dt][3] * O[dt][3];
        ss += __shfl_xor(ss, 16); ss += __shfl_xor(ss, 32);
        const float rstd = rsqrtf(ss * (1.f / 64.f) + 1e-6f);
#pragma unroll
        for (int dt = 0; dt < 4; ++dt) {
            const int dcol = h * 64 + dt * 16 + fq * 4;
            const f32x4 gn = *(const f32x4*)(p.in[I_DNG] + l * 256 + dcol);
            const f32x4 dg = ldb4(U + (size_t)qtok * INW + 2304 + dcol);
            float o[4];
#pragma unroll
            for (int r = 0; r < 4; ++r) o[r] = O[dt][r] * rstd * gn[r] * siluf_(dg[r]);
            u32x2 w; w.x = pk_bf16(o[0], o[1]); w.y = pk_bf16(o[2], o[3]);
            *(u32x2*)(op + dt * 16) = w;
        }
    }
}

DEVI void scan_unit(const Ctx& p, int l, int tt) {
    const int t = opaque_tid(), ch = t & 255, dir = t >> 8;
    const float* CA = (const float*)(p.ws + OFF_CA);
    const float* CB = (const float*)(p.ws + OFF_CB);
    const float* TA = (const float*)(p.ws + OFF_TA);
    const float* TB = (const float*)(p.ws + OFF_TB);
    const bf16_t* U = (const bf16_t*)(p.ws + OFF_U);
    bf16_t* MIX = (bf16_t*)(p.ws + OFF_MIX);
    int tile0, tl, nts, sq; float h = 0.f;
    if (tt < 64) { sq = tt >> 2; tile0 = sq * 4; tl = tt & 3; nts = 4; }
    else { const int b = (tt - 64) >> 4; sq = 16 + b; tile0 = 64 + b * 16; tl = (tt - 64) & 15; nts = 16; h = p.in[I_SC][(((size_t)b * 2 + l) * 2 + dir) * 256 + ch]; }
    const int tok0 = tt * 64;
    {
        float ta[16], tb[16];
#pragma unroll
        for (int k = 0; k < 16; ++k) {
            int tk = dir == 0 ? k : nts - 1 - k;
            tk = tk < 0 ? 0 : (tk > nts - 1 ? nts - 1 : tk);
            ta[k] = TA[((size_t)dir * 96 + tile0 + tk) * 256 + ch]; tb[k] = TB[((size_t)dir * 96 + tile0 + tk) * 256 + ch];
        }
        const int npre = dir == 0 ? tl : nts - 1 - tl;
#pragma unroll
        for (int k = 0; k < 16; ++k) if (k < npre) h = ta[k] * h + tb[k];
    }
    const float* ap = CA + ((size_t)dir * NTOK + tok0) * 256 + ch;
    const float* bp = CB + ((size_t)dir * NTOK + tok0) * 256 + ch;
    float* hp = (float*)shm + dir * (64 * 256) + ch;
    if (dir == 0) {
#pragma unroll
        for (int t0 = 0; t0 < 64; t0 += 32) {
            float av[32], bv[32];
#pragma unroll
            for (int j = 0; j < 32; ++j) { av[j] = ap[(size_t)(t0 + j) * 256]; bv[j] = bp[(size_t)(t0 + j) * 256]; }
#pragma unroll
            for (int j = 0; j < 32; ++j) { h = av[j] * h + bv[j]; hp[(size_t)(t0 + j) * 256] = h; }
        }
    } else {
#pragma unroll
        for (int t0 = 32; t0 >= 0; t0 -= 32) {
            float av[32], bv[32];
#pragma unroll
            for (int j = 0; j < 32; ++j) { av[j] = ap[(size_t)(t0 + j) * 256]; bv[j] = bp[(size_t)(t0 + j) * 256]; }
#pragma unroll
            for (int j = 31; j >= 0; --j) { h = av[j] * h + bv[j]; hp[(size_t)(t0 + j) * 256] = h; }
        }
    }
    if (tt < 64 && ((dir == 0 && tl == 3) || (dir == 1 && tl == 0))) p.out[O_SC + (((size_t)sq * 2 + l) * 2 + dir) * 256 + ch] = h;
    __syncthreads();
    const float* H0 = (const float*)shm;
    const float* H1 = H0 + 64 * 256;
#pragma unroll
    for (int i = 0; i < 8; ++i) {
        const int idx = i * 512 + t;
        const int tk = idx >> 6, c4 = (idx & 63) * 4;
        const f32x4 a = *(const f32x4*)(H0 + (size_t)tk * 256 + c4), b = *(const f32x4*)(H1 + (size_t)tk * 256 + c4);
        const f32x4 cy = ldb4(U + (size_t)(tok0 + tk) * INW + 1280 + c4);
        float o[4];
#pragma unroll
        for (int r = 0; r < 4; ++r) {
            const float x = cy[r];
            const float z2 = 1.5957691216057308f * (x + 0.044715f * x * x * x);
            const float ge = x * __builtin_amdgcn_rcpf(1.f + __expf(-z2));
            o[r] = (a[r] + b[r]) * ge;
        }
        u32x2 w; w.x = pk_bf16(o[0], o[1]); w.y = pk_bf16(o[2], o[3]);
        *(u32x2*)(MIX + (size_t)(tok0 + tk) * DM + 512 + c4) = w;
    }
}

DEVI void mixer_phase(const Ctx& p, int l, volatile LAS int* s_unit, int slot) {
    const int NU = 672;
    const int nq = gridDim.x >= 8 ? 8 : 1, q = blockIdx.x % nq;
    unsigned* ctr = (unsigned*)(p.ws + OFF_CTRL) + 4096 + 64 * (slot * 8 + q);
    const int base = (int)gridDim.x < NU ? (int)gridDim.x : NU;
    bool first = true;
    for (;;) {
        int u;
        if (first) { u = blockIdx.x; first = false; if (u >= NU) break; }
        else {
            __syncthreads();
            if (threadIdx.x == 0) *s_unit = base + (int)atomicAdd(ctr, 1u) * nq + q;
            __syncthreads();
            u = *s_unit;
            if (u >= NU) break;
        }
#ifdef MIX_LO
        if (slot >= 2 && (u < MIX_LO || u >= MIX_HI)) continue;
#endif
        if (u < 64) attn_unit(p, l, 3, u);
        else if (u < 128) attn_unit(p, l, 5, u - 64);
        else if (u < 192) attn_unit(p, l, 2, u - 128);
        else if (u < 288) scan_unit(p, l, u - 192);
        else if (u < 416) attn_unit(p, l, 4, u - 288);
        else if (u < 544) attn_unit(p, l, 0, u - 416);
        else attn_unit(p, l, 1, u - 544);
    }
}

__global__ void __launch_bounds__(512, 2) fwd_megakernel(Params P, int ph_lo, int ph_hi) {
    __shared__ uint4 s_ctl[2];
    if (threadIdx.x == 0) {
        s_ctl[0] = make_uint4(0u, 0u, 0u, 0u); s_ctl[1] = make_uint4(0u, 0u, 0u, 0u);
        const float** tabw = (const float**)(P.ws + OFF_TAB) + (size_t)blockIdx.x * 64;
#pragma unroll
        for (int i = 0; i < N_IN; ++i) tabw[i] = P.in[i];
        __threadfence();
    }
    __syncthreads();
    if (P.never) cg::this_grid().sync();
    XcdBarrier xb;
    const bool multi = (ph_hi - ph_lo) > 1;
    if (multi) xb = xcd_barrier_post((unsigned*)(P.ws + OFF_CTRL), (volatile LAS unsigned*)&s_ctl[0]);
    volatile LAS int* s_unit = (volatile LAS int*)&s_ctl[1];
#ifndef PH_MASK
#define PH_MASK 63
#endif
#ifndef DUP_MASK
#define DUP_MASK 0
#endif
    for (int ph2 = ph_lo * 2; ph2 < ph_hi * 2; ++ph2) {
        const int ph = ph2 >> 1, rep = ph2 & 1;
        if (rep) {
            const int kk = (ph >= 1 && ph < 23) ? (ph - 1) % 11 : -1;
            const bool dup = (ph == 0) ? (DUP_MASK & 1) : (ph == 23 || kk == 0 || kk == 3 || kk == 8) ? (DUP_MASK & 2) : (kk == 5) ? (DUP_MASK & 4) : (kk == 6) ? (DUP_MASK & 8) : (kk == 1 || kk == 2 || kk == 4 || kk == 7 || kk == 9 || kk == 10) ? (DUP_MASK & 16) : false;
            if (!dup) continue;
        }
        if (ph2 > ph_lo * 2) xcd_barrier(xb);
        Ctx p;
        p.ws = P.ws; p.out = P.out; p.in = (const float* const*)(P.ws + OFF_TAB) + (size_t)blockIdx.x * 64;
        asm volatile("" : "+s"(p.ws), "+s"(p.out), "+s"(p.in) :: "memory");
        if (ph == 0) { if (PH_MASK & 1) prologue_phase(p); continue; }
        if (ph == 23) { if (PH_MASK & 2) norm_phase(p, 1, 4, rep); continue; }
        const int l = (ph - 1) / 11, k = (ph - 1) % 11;
        const unsigned char* wl = p.ws + OFF_W + (size_t)l * W_LAYER;
        if (k == 0 || k == 3 || k == 8) { if (PH_MASK & 2) norm_phase(p, l, k == 0 ? 1 : (k == 3 ? 2 : 3), rep); }
        else if (k == 5) { if (PH_MASK & 4) prep_phase(p, l); }
        else if (k == 6) { if (PH_MASK & 8) mixer_phase(p, l, s_unit, l + 2 * rep); }
        else if (PH_MASK & 16) {
            GemmDesc g;
            g.nM = NTOK / 256;
            if (k == 1 || k == 9) { g.A = (const bf16_t*)(p.ws + OFF_H); g.Bt = (const bf16_t*)(wl + (k == 1 ? WL_GU1 : WL_GU2)); g.K = 1024; g.nN = 22; g.S = 1; g.nt = 16; g.epi = EPI_GU; g.out = p.ws + OFF_ACT; }
            else if (k == 2 || k == 10) { g.A = (const bf16_t*)(p.ws + OFF_ACT); g.Bt = (const bf16_t*)(wl + (k == 2 ? WL_D1 : WL_D2)); g.K = 2816; g.nN = 4; g.S = 2; g.nt = 22; g.epi = EPI_PART; g.out = p.ws + OFF_U; }
            else if (k == 4) { g.A = (const bf16_t*)(p.ws + OFF_H); g.Bt = (const bf16_t*)(wl + WL_IN); g.K = 1024; g.nN = 10; g.S = 1; g.nt = 16; g.epi = EPI_U; g.out = p.ws + OFF_U; }
            else { g.A = (const bf16_t*)(p.ws + OFF_MIX); g.Bt = (const bf16_t*)(wl + WL_OUT); g.K = 1024; g.nN = 4; g.S = 2; g.nt = 8; g.epi = EPI_PART; g.out = p.ws + OFF_U; }
            gemm_phase(g);
            if (rep == 0 && gridDim.x == 256) {
                int lo = CONV_C0, per = 0;
                for (int q = 1; q <= ph; ++q) {
                    const int kq = (q - 1) % 11;
                    const int sup = (kq == 1 || kq == 9) ? 480 : (kq == 2 || kq == 10) ? 192 : (kq == 4) ? 32 : (kq == 7) ? 64 : 0;
                    if (q < ph) lo += sup; else per = (kq == 1 || kq == 9) ? 2 : (kq == 2 || kq == 10) ? 3 : (kq == 4) ? 2 : 1;
                }
                const int Ug = g.nM * g.nN * g.S, nfull = Ug % (int)gridDim.x;
                if (nfull != 0 && (int)blockIdx.x >= nfull && lo < NTR_UNITS) {
                    const int nidle = (int)gridDim.x - nfull;
                    int hi = lo + per * nidle; if (hi > NTR_UNITS) hi = NTR_UNITS;
                    convert_fill(p, lo, hi, (int)blockIdx.x - nfull, nidle, per);
                }
            }
        }
    }
}

extern "C" void kernel_launch(void* const* d_in, const int* in_sizes, int n_in, void* d_out, int out_size, void* d_ws, size_t ws_size, hipStream_t stream) {
    Params p{};
    for (int i = 0; i < N_IN; ++i) p.in[i] = (const float*)d_in[i];
    p.out = (float*)d_out;
    p.ws = (unsigned char*)d_ws;
    p.never = 0; p.pad = 0;
    static int grid_blocks = 0;
    if (!grid_blocks) {
        (void)hipFuncSetAttribute((const void*)fwd_megakernel, hipFuncAttributeMaxDynamicSharedMemorySize, SHM_BYTES);
        int dev = 0, cus = 0, per_cu = 0;
        (void)hipGetDevice(&dev);
        (void)hipDeviceGetAttribute(&cus, hipDeviceAttributeMultiprocessorCount, dev);
        (void)hipOccupancyMaxActiveBlocksPerMultiprocessor(&per_cu, fwd_megakernel, 512, SHM_BYTES);
        if (per_cu < 1) fprintf(stderr, "occupancy query returned %d\n", per_cu);
        grid_blocks = cus;
    }
    (void)hipMemsetAsync(d_ws, 0, CTRL_BYTES, stream);
#if MK_MULTI
    for (int ph = 0; ph < NPHASE; ++ph)
        fwd_megakernel<<<dim3(grid_blocks), dim3(512), SHM_BYTES, stream>>>(p, ph, ph + 1);
#else
    int lo = 0, hi = NPHASE;
    void* args[] = {&p, &lo, &hi};
    hipError_t e = hipLaunchCooperativeKernel((const void*)fwd_megakernel, dim3(grid_blocks), dim3(512), args, SHM_BYTES, stream);
    if (e != hipSuccess) fprintf(stderr, "cooperative launch failed: %s (grid %d)\n", hipGetErrorString(e), grid_blocks);
#endif
}
```

```cpp
#include <hip/hip_runtime.h>
#include <hip/hip_cooperative_groups.h>
#include <cstdint>
#include <cstdio>
namespace cg = cooperative_groups;

#ifndef MK_MULTI
#define MK_MULTI 0
#endif

#define DEVI __device__ __forceinline__
#define LAS __attribute__((address_space(3)))

typedef unsigned short bf16_t;
typedef short bf16x8 __attribute__((ext_vector_type(8)));
typedef float f32x4 __attribute__((ext_vector_type(4)));
typedef float f32x2 __attribute__((ext_vector_type(2)));
typedef unsigned u32x4 __attribute__((ext_vector_type(4)));
typedef unsigned u32x2 __attribute__((ext_vector_type(2)));

constexpr int NTOK = 6144, NCTX = 4096, DM = 1024, DFF = 2816, INW = 2560;
constexpr int NKROW = 7168;
constexpr float LOG2E = 1.4426950408889634f;

enum { I_XP = 0, I_XS, I_CAK, I_CAV, I_CBK, I_CBV, I_SC, I_SD, I_C, I_CCTX, I_N1, I_N2, I_N3, I_WMOD, I_BMOD,
       I_F1G, I_F1U, I_F1D, I_F2G, I_F2U, I_F2D, I_WIN, I_WOUT, I_AQN, I_AKN, I_ASINK, I_BQN, I_BKN,
       I_CCW, I_CCB, I_CWA, I_CBA, I_CWX, I_CBX, I_CLAM, I_DTH, I_DNG, N_IN };

constexpr size_t O_YP = 0, O_YS = 4194304, O_CAK = 6291456, O_CAV = 7340032, O_CBK = 8388608, O_CBV = 9437184,
                 O_SC = 10485760, O_SD = 10502144;

constexpr size_t OFF_CTRL = 0;
constexpr size_t CTRL_BYTES = 65536;
constexpr size_t OFF_TAB = CTRL_BYTES;
constexpr size_t OFF_MOD = OFF_TAB + 131072;
constexpr size_t OFF_W = OFF_MOD + 262144;
constexpr size_t W_GU = (size_t)5632 * 1024 * 2, W_D = (size_t)1024 * 2816 * 2, W_IN = (size_t)2560 * 1024 * 2, W_OUT = (size_t)1024 * 1024 * 2;
constexpr size_t WL_GU1 = 0, WL_D1 = WL_GU1 + W_GU, WL_IN = WL_D1 + W_D, WL_OUT = WL_IN + W_IN, WL_GU2 = WL_OUT + W_OUT, WL_D2 = WL_GU2 + W_GU, W_LAYER = WL_D2 + W_D;
constexpr size_t OFF_H = OFF_W + 2 * W_LAYER;
constexpr size_t OFF_ACT = OFF_H + (size_t)NTOK * 1024 * 2;
constexpr size_t OFF_U = OFF_ACT + (size_t)NTOK * 2816 * 2;
constexpr size_t OFF_MIX = OFF_U + (size_t)NTOK * 2560 * 4;
constexpr size_t OFF_QA = OFF_MIX + (size_t)NTOK * 1024 * 2;
constexpr size_t OFF_QB = OFF_QA + (size_t)NTOK * 256 * 2;
constexpr size_t OFF_KA = OFF_QB + (size_t)NTOK * 256 * 2;
constexpr size_t OFF_VA = OFF_KA + (size_t)NKROW * 128 * 2;
constexpr size_t OFF_KB = OFF_VA + (size_t)NKROW * 128 * 2;
constexpr size_t OFF_VB = OFF_KB + (size_t)NKROW * 128 * 2;
constexpr size_t OFF_DQ = OFF_VB + (size_t)NKROW * 128 * 2;
constexpr size_t OFF_DK = OFF_DQ + (size_t)NTOK * 256 * 2;
constexpr size_t OFF_DV = OFF_DK + (size_t)NTOK * 256 * 2;
constexpr size_t OFF_CA = OFF_DV + (size_t)NTOK * 256 * 2;
constexpr size_t OFF_CB = OFF_CA + (size_t)2 * NTOK * 256 * 4;
constexpr size_t OFF_HF = OFF_CB + (size_t)2 * NTOK * 256 * 4;
constexpr size_t OFF_TA = OFF_HF + (size_t)2 * NTOK * 256 * 4;
constexpr size_t OFF_TB = OFF_TA + (size_t)2 * 96 * 256 * 4;
constexpr size_t OFF_CWT = OFF_TB + (size_t)2 * 96 * 256 * 4;
constexpr size_t OFF_XB = OFF_CWT + (size_t)2 * 4 * 4 * 4096 * 2;
constexpr size_t WS_TOTAL = OFF_XB + (size_t)NTOK * 1024 * 2;
static_assert(WS_TOTAL < (size_t)300 * 1024 * 1024, "workspace too large");

constexpr int SHM_BYTES = 131072;
constexpr int NPHASE = 24;

struct Params {
    const float* in[N_IN];
    float* out;
    unsigned char* ws;
    int never;
    int pad;
};

struct Ctx { const float* const* in; float* out; unsigned char* ws; };

extern __shared__ __attribute__((aligned(16))) bf16_t shm[];

DEVI unsigned pk_bf16(float lo, float hi) { unsigned r; asm("v_cvt_pk_bf16_f32 %0, %1, %2" : "=v"(r) : "v"(lo), "v"(hi)); return r; }
DEVI bf16_t to_bf16(float x) { return (bf16_t)(pk_bf16(x, 0.f) & 0xffffu); }
DEVI f32x4 ldb4(const bf16_t* p) {
    const u32x2 w = *(const u32x2*)p; f32x4 r;
    r[0] = __builtin_bit_cast(float, w.x << 16); r[1] = __builtin_bit_cast(float, w.x & 0xffff0000u);
    r[2] = __builtin_bit_cast(float, w.y << 16); r[3] = __builtin_bit_cast(float, w.y & 0xffff0000u);
    return r;
}
DEVI float wave_sum(float v) {
#pragma unroll
    for (int o = 32; o > 0; o >>= 1) v += __shfl_xor(v, o);
    return v;
}
DEVI int opaque_tid() { int t = threadIdx.x; asm volatile("" : "+v"(t)); return t; }
DEVI float fexp2(float x) { return __builtin_amdgcn_exp2f(x); }
DEVI float sigmoidf_(float x) { return __builtin_amdgcn_rcpf(1.f + __expf(-x)); }
DEVI float siluf_(float x) { return x * sigmoidf_(x); }

#define XB_TMO      128
#define XB_XCNT(j)  (256  + 64 * (j))
#define XB_XSUB(j)  (1280 + 64 * (j))
#define XB_XGEN(j)  (2304 + 64 * (j))
#define XB_TOP      3328
#define XB_TOPGEN   3392
#define XCD_BAR_WORDS 3456
#define XB_SPIN_CAP (1u << 20)
DEVI unsigned xb_ld(unsigned* p) { return __hip_atomic_load(p, __ATOMIC_RELAXED, __HIP_MEMORY_SCOPE_AGENT); }
DEVI unsigned xb_add(unsigned* p, unsigned v) { return __hip_atomic_fetch_add(p, v, __ATOMIC_RELAXED, __HIP_MEMORY_SCOPE_AGENT); }
DEVI unsigned xb_xcc_id() { return (unsigned)__builtin_amdgcn_s_getreg((3 << 11) | 20) & 0xFu; }
#define XB_SPIN(cond, bar) do { unsigned _sp = 0; while (cond) { __builtin_amdgcn_s_sleep(1); \
    if ((++_sp & 255u) == 0u) { if (xb_ld(&(bar)[XB_TMO])) break; if (_sp > XB_SPIN_CAP) { atomicAdd(&(bar)[XB_TMO], 1u); break; } } } } while (0)
struct XcdBarrier { unsigned* bar; unsigned x; volatile LAS unsigned* st; };
DEVI XcdBarrier xcd_barrier_post(unsigned* bar, volatile LAS unsigned* st) {
    XcdBarrier b; b.bar = bar; b.x = xb_xcc_id(); b.st = st;
    if (threadIdx.x == 0) (void)xb_add(&bar[XB_XCNT(b.x)], 1u);
    return b;
}
DEVI void xcd_barrier_complete(unsigned* bar, unsigned x, unsigned& nloc, unsigned& nx) {
    const unsigned G = gridDim.x * gridDim.y * gridDim.z;
    unsigned sum, cnt, mine, sp = 0u;
    for (;;) {
        sum = 0u; cnt = 0u; mine = 0u;
#pragma unroll
        for (unsigned j = 0; j < 16; ++j) { const unsigned c = xb_ld(&bar[XB_XCNT(j)]); sum += c; cnt += (c > 0u) ? 1u : 0u; mine = (j == x) ? c : mine; }
        if (sum == G) break;
        __builtin_amdgcn_s_sleep(1);
        if ((++sp & 255u) == 0u) { if (xb_ld(&bar[XB_TMO])) break; if (sp > XB_SPIN_CAP) { atomicAdd(&bar[XB_TMO], 1u); break; } }
    }
    nloc = mine > 0u ? mine : 1u; nx = cnt > 0u ? cnt : 1u;
}
DEVI void xcd_barrier(const XcdBarrier& b) {
    asm volatile("s_waitcnt vmcnt(0)" ::: "memory");
    __syncthreads();
    if (threadIdx.x == 0) {
        unsigned* bar = b.bar;
        asm volatile("" : "+s"(bar));
        __builtin_amdgcn_s_waitcnt(0);
        unsigned nloc = b.st[0], nx = b.st[1];
        if (nloc == 0u) { xcd_barrier_complete(bar, b.x, nloc, nx); b.st[0] = nloc; b.st[1] = nx; }
        const unsigned old = xb_add(&bar[XB_XSUB(b.x)], 1u);
        const unsigned gen = old / nloc;
        if (old + 1u == (gen + 1u) * nloc) {
            __builtin_amdgcn_fence(__ATOMIC_RELEASE, "agent");
            asm volatile("s_waitcnt vmcnt(0)" ::: "memory");
            const unsigned og = xb_add(&bar[XB_TOP], 1u);
            const unsigned tg = og / nx;
            if (og + 1u == (tg + 1u) * nx) xb_add(&bar[XB_TOPGEN], 1u);
            else XB_SPIN(xb_ld(&bar[XB_TOPGEN]) == tg, bar);
            __builtin_amdgcn_fence(__ATOMIC_ACQUIRE, "agent");
            xb_add(&bar[XB_XGEN(b.x)], 1u);
            asm volatile("s_waitcnt vmcnt(0)" ::: "memory");
        } else {
            XB_SPIN(xb_ld(&bar[XB_XGEN(b.x)]) == gen, bar);
            __builtin_amdgcn_fence(__ATOMIC_ACQUIRE, "agent");
            asm volatile("s_waitcnt vmcnt(0)" ::: "memory");
        }
    }
    __syncthreads();
}

constexpr int BM = 256, BK = 64, HALF = 128, HTB = HALF * BK * 2;
DEVI int lds_byte(int r, int c) { const int st = (r >> 4) * 2 + (c >> 5), rr = r & 15, cc = c & 31, ob = rr * 64 + cc * 2; return st * 1024 + (ob ^ (((ob >> 9) & 1) << 5)); }
DEVI void stage_rc(int b, int& R, int& C) { const int st = b / 1024, sb = b % 1024, swz = sb ^ (((sb >> 9) & 1) << 5); R = (st >> 1) * 16 + swz / 64; C = (st & 1) * 32 + (swz % 64) / 2; }

enum { EPI_GU = 0, EPI_PART = 1, EPI_U = 2 };
struct GemmDesc { const bf16_t* A; const bf16_t* Bt; int K; int nM, nN, S, nt; int epi; void* out; };
struct Unit { int pm, pn, ks; };

DEVI bool gemm_next(const GemmDesc& g, int i, Unit& u) {
    const int nwg = g.nM * g.nN;
    const long L = (long)i * gridDim.x + blockIdx.x;
    if (L >= (long)nwg * g.S) return false;
    u.ks = (int)(L / nwg);
    int wgid = (int)(L % nwg);
    { const int q = nwg / 8, r = nwg % 8, xcd = wgid % 8, off = wgid / 8; wgid = (xcd < r ? xcd * (q + 1) : r * (q + 1) + (xcd - r) * q) + off; }
    const int WGM = 4;
    const int nig = WGM * g.nN, gid = wgid / nig, fm = gid * WGM, gsz = (g.nM - fm) < WGM ? (g.nM - fm) : WGM;
    u.pm = fm + ((wgid % nig) % gsz); u.pn = (wgid % nig) / gsz;
    return true;
}

DEVI void gemm_epilogue(const GemmDesc& g, const f32x4 (&acc)[2][2][4][2], const Unit& u, int wr, int wc, int fr, int fq) {
    const int brow = u.pm * BM, bcol = u.pn * BM;
    if (g.epi == EPI_GU) {
        bf16_t* act = (bf16_t*)g.out;
#pragma unroll
        for (int ai = 0; ai < 2; ++ai)
#pragma unroll
            for (int m = 0; m < 4; ++m) {
                const int row = brow + ai * HALF + wr * 64 + m * 16 + fr;
                const int hcol = u.pn * 128 + wc * 32 + fq * 8;
                u32x4 w;
                { const f32x4 gt = acc[ai][0][m][0], up = acc[ai][1][m][0];
                  w.x = pk_bf16(siluf_(gt[0]) * up[0], siluf_(gt[1]) * up[1]); w.y = pk_bf16(siluf_(gt[2]) * up[2], siluf_(gt[3]) * up[3]); }
                { const f32x4 gt = acc[ai][0][m][1], up = acc[ai][1][m][1];
                  w.z = pk_bf16(siluf_(gt[0]) * up[0], siluf_(gt[1]) * up[1]); w.w = pk_bf16(siluf_(gt[2]) * up[2], siluf_(gt[3]) * up[3]); }
                *(u32x4*)(act + (size_t)row * DFF + hcol) = w;
            }
    } else if (g.epi == EPI_PART) {
        bf16_t* o = (bf16_t*)g.out + (size_t)u.ks * NTOK * DM;
#pragma unroll
        for (int ai = 0; ai < 2; ++ai)
#pragma unroll
            for (int m = 0; m < 4; ++m) {
                const int row = brow + ai * HALF + wr * 64 + m * 16 + fr;
#pragma unroll
                for (int bj = 0; bj < 2; ++bj) {
                    const int col = bcol + bj * HALF + wc * 32 + fq * 8;
                    const f32x4 v0 = acc[ai][bj][m][0], v1 = acc[ai][bj][m][1];
                    u32x4 w; w.x = pk_bf16(v0[0], v0[1]); w.y = pk_bf16(v0[2], v0[3]); w.z = pk_bf16(v1[0], v1[1]); w.w = pk_bf16(v1[2], v1[3]);
                    *(u32x4*)(o + (size_t)row * DM + col) = w;
                }
            }
    } else {
        bf16_t* o = (bf16_t*)g.out;
#pragma unroll
        for (int ai = 0; ai < 2; ++ai)
#pragma unroll
            for (int m = 0; m < 4; ++m) {
                const int row = brow + ai * HALF + wr * 64 + m * 16 + fr;
#pragma unroll
                for (int bj = 0; bj < 2; ++bj) {
                    const int col = bcol + bj * HALF + wc * 32 + fq * 8;
                    const f32x4 v0 = acc[ai][bj][m][0], v1 = acc[ai][bj][m][1];
                    u32x4 w; w.x = pk_bf16(v0[0], v0[1]); w.y = pk_bf16(v0[2], v0[3]); w.z = pk_bf16(v1[0], v1[1]); w.w = pk_bf16(v1[2], v1[3]);
                    *(u32x4*)(o + (size_t)row * INW + col) = w;
                }
            }
    }
}

DEVI void gemm_phase(const GemmDesc g) {
    LAS unsigned char* lds = (LAS unsigned char*)shm;
    const int tid = opaque_tid(), wid = __builtin_amdgcn_readfirstlane(tid >> 6), lane = tid & 63, wr = wid >> 2, wc = wid & 3, fr = lane & 15, fq = lane >> 4;
    const int K = g.K, nt = g.nt;
    unsigned voffA[2], voffB[2];
#pragma unroll
    for (int i = 0; i < 2; ++i) { int R, C; stage_rc(tid * 16 + i * 8192, R, C); voffA[i] = (unsigned)(R * K + C) * 2u;
        const int rho = R & 31, pr = 8 * ((rho & 15) >> 2) + 4 * (rho >> 4) + (rho & 3); voffB[i] = (unsigned)(((R & ~31) + pr) * K + C) * 2u; }
    const size_t kstep = (size_t)(BK * 2);
    const size_t hstep = (size_t)HALF * K * 2;
    const size_t tstep = 2 * hstep;
    const size_t sstep = (size_t)nt * kstep;
    const unsigned ldsw = (unsigned)wid * 1024u;
    const int aoff = lds_byte(wr * 64 + fr, fq * 8), boff = lds_byte(wc * 32 + fr, fq * 8);
#define PG8_SA(b, h) (((b) * 2 + (h)) * HTB)
#define PG8_SB(b, h) ((4 + (b) * 2 + (h)) * HTB)
#define PG8_STAGE(bufoff, gbase, voff) do { _Pragma("unroll") for (int _i = 0; _i < 2; ++_i) \
        __builtin_amdgcn_global_load_lds((const unsigned*)((const char*)(gbase) + (voff)[_i]), (LAS unsigned*)(lds + (bufoff) + ldsw + _i * 8192), 16, 0, 0); } while (0)
#define PG8_LDA(dst, b, h) do { _Pragma("unroll") for (int m = 0; m < 4; ++m) _Pragma("unroll") for (int k = 0; k < 2; ++k) dst[m][k] = *(const LAS bf16x8*)(lds + PG8_SA(b, h) + aoff + m * 2048 + k * 1024); } while (0)
#define PG8_LDB(dst, b, h) do { _Pragma("unroll") for (int n = 0; n < 2; ++n) _Pragma("unroll") for (int k = 0; k < 2; ++k) dst[n][k] = *(const LAS bf16x8*)(lds + PG8_SB(b, h) + boff + n * 2048 + k * 1024); } while (0)
#define PG8_MMA(ai, bj, At, Bt) do { __builtin_amdgcn_s_setprio(1); _Pragma("unroll") for (int m = 0; m < 4; ++m) _Pragma("unroll") for (int n = 0; n < 2; ++n) _Pragma("unroll") for (int k = 0; k < 2; ++k) \
        acc[ai][bj][m][n] = __builtin_amdgcn_mfma_f32_16x16x32_bf16(Bt[n][k], At[m][k], acc[ai][bj][m][n], 0, 0, 0); __builtin_amdgcn_s_setprio(0); } while (0)
#define PG8_WAIT_V(n) asm volatile("s_waitcnt vmcnt(" #n ")" ::: "memory")
#define PG8_WAIT_L(n) asm volatile("s_waitcnt lgkmcnt(" #n ")" ::: "memory")
#define PG8_BAR __builtin_amdgcn_s_barrier()
#define PG8_SCHED __builtin_amdgcn_sched_barrier(0)
    Unit cur, nxt; int ui = 0;
    if (!gemm_next(g, 0, cur)) return;
    f32x4 acc[2][2][4][2];
#pragma unroll
    for (int a = 0; a < 2; ++a)
#pragma unroll
        for (int b = 0; b < 2; ++b)
#pragma unroll
            for (int m = 0; m < 4; ++m)
#pragma unroll
                for (int n = 0; n < 2; ++n) acc[a][b][m][n] = (f32x4){0.f, 0.f, 0.f, 0.f};
    bf16x8 At[4][2], B0[2][2], B1[2][2];
    const char* cA = (const char*)g.A + (size_t)cur.pm * tstep + (size_t)cur.ks * sstep;
    const char* cB = (const char*)g.Bt + (size_t)cur.pn * tstep + (size_t)cur.ks * sstep;
    PG8_STAGE(PG8_SB(0, 0), cB, voffB); PG8_STAGE(PG8_SB(0, 1), cB + hstep, voffB); PG8_STAGE(PG8_SA(0, 0), cA, voffA); PG8_STAGE(PG8_SA(0, 1), cA + hstep, voffA);
    if (wr == 1) PG8_BAR;
    PG8_WAIT_V(2); PG8_BAR;
    PG8_STAGE(PG8_SB(1, 0), cB + kstep, voffB); PG8_STAGE(PG8_SA(1, 0), cA + kstep, voffA); PG8_STAGE(PG8_SB(1, 1), cB + hstep + kstep, voffB);
    PG8_WAIT_V(6); PG8_BAR;
    for (;;) {
        const bool has_next = gemm_next(g, ui + 1, nxt);
        const char* nA = has_next ? (const char*)g.A + (size_t)nxt.pm * tstep + (size_t)nxt.ks * sstep : cA;
        const char* nB = has_next ? (const char*)g.Bt + (size_t)nxt.pn * tstep + (size_t)nxt.ks * sstep : cB;
        for (int t = 0; t < nt; t += 2) {
            const bool last = (t == nt - 2);
            const char* a1 = cA + (size_t)(t + 1) * kstep;
            const char* a2 = last ? nA : cA + (size_t)(t + 2) * kstep; const char* b2 = last ? nB : cB + (size_t)(t + 2) * kstep;
            const char* a3 = a2 + kstep; const char* b3 = b2 + kstep;
            PG8_LDB(B0, 0, 0); PG8_LDB(B1, 0, 1); PG8_SCHED; PG8_LDA(At, 0, 0); PG8_STAGE(PG8_SA(1, 1), a1 + hstep, voffA);
            PG8_WAIT_V(8); PG8_WAIT_L(0); PG8_BAR; PG8_MMA(0, 0, At, B0); PG8_MMA(0, 1, At, B1); PG8_BAR; PG8_SCHED;
            PG8_LDA(At, 0, 1); PG8_STAGE(PG8_SB(0, 0), b2, voffB); PG8_STAGE(PG8_SB(0, 1), b2 + hstep, voffB); PG8_STAGE(PG8_SA(0, 0), a2, voffA);
            PG8_WAIT_V(8); PG8_WAIT_L(0); PG8_BAR; PG8_MMA(1, 0, At, B0); PG8_MMA(1, 1, At, B1); PG8_BAR; PG8_SCHED;
            PG8_LDB(B0, 1, 0); PG8_LDB(B1, 1, 1); PG8_SCHED; PG8_LDA(At, 1, 0); PG8_STAGE(PG8_SA(0, 1), a2 + hstep, voffA);
            PG8_WAIT_V(8); PG8_WAIT_L(0); PG8_BAR; PG8_MMA(0, 0, At, B0); PG8_MMA(0, 1, At, B1); PG8_BAR; PG8_SCHED;
            PG8_LDA(At, 1, 1); PG8_STAGE(PG8_SB(1, 0), b3, voffB); PG8_STAGE(PG8_SB(1, 1), b3 + hstep, voffB); PG8_STAGE(PG8_SA(1, 0), a3, voffA);
            PG8_WAIT_V(8); PG8_WAIT_L(0); PG8_BAR; PG8_MMA(1, 0, At, B0); PG8_MMA(1, 1, At, B1); PG8_BAR; PG8_SCHED;
        }
        if (wr == 0) PG8_BAR;
        gemm_epilogue(g, acc, cur, wr, wc, fr, fq);
        if (!has_next) break;
#pragma unroll
        for (int a = 0; a < 2; ++a)
#pragma unroll
            for (int b = 0; b < 2; ++b)
#pragma unroll
                for (int m = 0; m < 4; ++m)
#pragma unroll
                    for (int n = 0; n < 2; ++n) acc[a][b][m][n] = (f32x4){0.f, 0.f, 0.f, 0.f};
        cur = nxt; cA = nA; cB = nB; ++ui;
        if (wr == 1) PG8_BAR;
    }
    PG8_WAIT_V(0);
    PG8_BAR;
#undef PG8_SA
#undef PG8_SB
#undef PG8_STAGE
#undef PG8_LDA
#undef PG8_LDB
#undef PG8_MMA
#undef PG8_WAIT_V
#undef PG8_WAIT_L
#undef PG8_BAR
#undef PG8_SCHED
}

constexpr int NTR_UNITS = 2560;
constexpr int CONV_C0 = 352;
DEVI void transpose_unit(const Ctx& p, int tu, int t, float* fs) {
    const int l = tu / 1280, r = tu % 1280;
    int which, loc, K, N, mode; size_t dsto;
    if (r < 176)       { which = I_F1G;  loc = r;        K = 1024; N = 2816; mode = 1; dsto = WL_GU1; }
    else if (r < 352)  { which = I_F1U;  loc = r - 176;  K = 1024; N = 2816; mode = 2; dsto = WL_GU1; }
    else if (r < 528)  { which = I_F1D;  loc = r - 352;  K = 2816; N = 1024; mode = 0; dsto = WL_D1; }
    else if (r < 688)  { which = I_WIN;  loc = r - 528;  K = 1024; N = 2560; mode = 0; dsto = WL_IN; }
    else if (r < 752)  { which = I_WOUT; loc = r - 688;  K = 1024; N = 1024; mode = 0; dsto = WL_OUT; }
    else if (r < 928)  { which = I_F2G;  loc = r - 752;  K = 1024; N = 2816; mode = 1; dsto = WL_GU2; }
    else if (r < 1104) { which = I_F2U;  loc = r - 928;  K = 1024; N = 2816; mode = 2; dsto = WL_GU2; }
    else               { which = I_F2D;  loc = r - 1104; K = 2816; N = 1024; mode = 0; dsto = WL_D2; }
    const int nnt = N / 256, kt = loc / nnt, ntile = loc % nnt;
    const float* src = p.in[which] + (size_t)l * K * N + (size_t)kt * 64 * N + ntile * 256;
    bf16_t* dst = (bf16_t*)(p.ws + OFF_W + (size_t)l * W_LAYER + dsto);
    f32x4 v[8];
#pragma unroll
    for (int i = 0; i < 8; ++i) { const int idx = i * 512 + t; v[i] = *(const f32x4*)(src + (size_t)(idx >> 6) * N + (idx & 63) * 4); }
#pragma unroll
    for (int i = 0; i < 8; ++i) { const int idx = i * 512 + t; *(f32x4*)(fs + (idx >> 6) * 260 + (idx & 63) * 4) = v[i]; }
    __syncthreads();
    const int nl = t & 255, kh = t >> 8;
    int drow;
    if (mode == 0) drow = ntile * 256 + nl;
    else drow = (2 * ntile + (nl >> 7)) * 256 + (nl & 127) + (mode == 2 ? 128 : 0);
    bf16_t* dp = dst + (size_t)drow * K + kt * 64 + kh * 32;
#pragma unroll
    for (int c = 0; c < 4; ++c) {
        u32x4 w;
        const float* f = fs + (kh * 32 + c * 8) * 260 + nl;
        w.x = pk_bf16(f[0], f[260]); w.y = pk_bf16(f[2 * 260], f[3 * 260]); w.z = pk_bf16(f[4 * 260], f[5 * 260]); w.w = pk_bf16(f[6 * 260], f[7 * 260]);
        *(u32x4*)(dp + c * 8) = w;
    }
}

DEVI void convert_fill(const Ctx& p, int lo, int hi, int rank, int nrank, int per) {
    const int t = opaque_tid();
    float* fs = (float*)shm;
    for (int i = 0; i < per; ++i) {
        const int tu = lo + rank + i * nrank;
        if (tu >= hi) break;
        __syncthreads();
        transpose_unit(p, tu, t, fs);
    }
}

DEVI void prologue_phase(const Ctx& p) {
    const int t = opaque_tid();
    float* fs = (float*)shm;
    float* mod = (float*)(p.ws + OFF_MOD);
    const int NMOD = 288, NCW = 32, NTR = (gridDim.x == 256) ? CONV_C0 : NTR_UNITS;
    if (gridDim.x == 256) {
        if (blockIdx.x >= 64)
            for (int tu = (int)blockIdx.x - 64; tu < NTR; tu += 192) { __syncthreads(); transpose_unit(p, tu, t, fs); }
    } else {
        for (int tu = blockIdx.x; tu < NTR; tu += gridDim.x) { __syncthreads(); transpose_unit(p, tu, t, fs); }
    }
    for (int u = blockIdx.x; u < NMOD + NCW; u += gridDim.x) {
        __syncthreads();
        if (u >= NMOD && u < NMOD + NCW) {
            const int mi = u - NMOD, l = mi >> 4, m = (mi >> 2) & 3, g = mi & 3, dir = m >> 1;
            const float* w = ((m & 1) ? p.in[I_CWX] : p.in[I_CWA]) + (((size_t)l * 2 + dir) * 4 + g) * 4096;
            bf16_t* wt = (bf16_t*)(p.ws + OFF_CWT) + (((size_t)l * 4 + m) * 4 + g) * 4096;
            const int d = t >> 3, c8 = (t & 7) * 8;
            u32x4 o;
            o.x = pk_bf16(w[(c8 + 0) * 64 + d], w[(c8 + 1) * 64 + d]); o.y = pk_bf16(w[(c8 + 2) * 64 + d], w[(c8 + 3) * 64 + d]);
            o.z = pk_bf16(w[(c8 + 4) * 64 + d], w[(c8 + 5) * 64 + d]); o.w = pk_bf16(w[(c8 + 6) * 64 + d], w[(c8 + 7) * 64 + d]);
            *(u32x4*)(wt + d * 64 + c8) = o;
        } else if (u < NMOD) {
            const int l = u / 144, jb = u % 144;
            for (int i = t; i < 3072; i += 512) {
                const int r = i >> 10, k = i & 1023;
                const float c = (r == 0) ? p.in[I_CCTX][k] : p.in[I_C][(r - 1) * 1024 + k];
                fs[i] = c / (1.f + __expf(-c));
            }
            __syncthreads();
            const int cgp = t & 15, kg = t >> 4;
            const float* w = p.in[I_WMOD] + ((size_t)l * 1024 + kg * 32) * 9216 + jb * 64 + cgp * 4;
            f32x4 a0 = {0, 0, 0, 0}, a1 = {0, 0, 0, 0}, a2 = {0, 0, 0, 0};
#pragma unroll 8
            for (int k = 0; k < 32; ++k) {
                const f32x4 wv = *(const f32x4*)(w + (size_t)k * 9216);
                const int kk = kg * 32 + k;
                a0 += wv * fs[kk]; a1 += wv * fs[1024 + kk]; a2 += wv * fs[2048 + kk];
            }
            float* red = fs + 3072;
            *(f32x4*)(red + kg * 192 + 0 + cgp * 4) = a0;
            *(f32x4*)(red + kg * 192 + 64 + cgp * 4) = a1;
            *(f32x4*)(red + kg * 192 + 128 + cgp * 4) = a2;
            __syncthreads();
            if (t < 192) {
                float sacc = 0.f;
#pragma unroll 8
                for (int k = 0; k < 32; ++k) sacc += red[k * 192 + t];
                const int r = t >> 6, j = t & 63;
                mod[((size_t)l * 3 + r) * 9216 + jb * 64 + j] = sacc + p.in[I_BMOD][(size_t)l * 9216 + jb * 64 + j];
            }
        } else {
            transpose_unit(p, u - NMOD - NCW, t, fs);
        }
    }
}

DEVI void norm_phase(const Ctx& p, int l, int which, int dry) {
    const int t_ = opaque_tid();
    const int lane = t_ & 63, gw = blockIdx.x * 8 + (t_ >> 6), nw = gridDim.x * 8;
    const float* mod = (const float*)(p.ws + OFF_MOD);
    const bf16_t* P0 = (const bf16_t*)(p.ws + OFF_U);
    const bf16_t* P1 = P0 + (size_t)NTOK * DM;
    bf16_t* H = (bf16_t*)(p.ws + OFF_H);
    bf16_t* XB = (bf16_t*)(p.ws + OFF_XB);
    const bool first = (l == 0 && which == 1);
    int gl, gi; float coef;
    if (which == 1) { gl = l - 1; gi = 8; coef = 0.5f; }
    else if (which == 2) { gl = l; gi = 2; coef = 0.5f; }
    else if (which == 3) { gl = l; gi = 5; coef = 1.0f; }
    else { gl = 1; gi = 8; coef = 0.5f; }
    if (dry) coef = 0.f;
    const float* gn = (which == 1) ? p.in[I_N1] : (which == 2) ? p.in[I_N2] : p.in[I_N3];
    const int shi = (which - 1) * 3, sci = shi + 1;
    for (int tok0 = gw; tok0 < NTOK; tok0 += 3 * nw) {
        f32x4 xv[3][4];
        float ss[3] = {0.f, 0.f, 0.f};
        int rr[3];
        bool ok[3];
        f32x4 g[4], sc[3][4], sh[3][4];
#pragma unroll
        for (int k = 0; k < 3; ++k) {
            const int tok = tok0 + k * nw;
            ok[k] = tok < NTOK;
            const int tk = ok[k] ? tok : tok0;
            rr[k] = tk < NCTX ? 0 : 1 + ((tk - NCTX) >> 10);
            if (which != 4) {
#pragma unroll
                for (int i = 0; i < 4; ++i) {
                    const int c = lane * 4 + i * 256;
                    if (k == 0) g[i] = *(const f32x4*)(gn + (size_t)l * DM + c);
                    sc[k][i] = *(const f32x4*)(mod + ((size_t)l * 3 + rr[k]) * 9216 + sci * 1024 + c);
                    sh[k][i] = *(const f32x4*)(mod + ((size_t)l * 3 + rr[k]) * 9216 + shi * 1024 + c);
                }
            }
            if (first) {
#pragma unroll
                for (int i = 0; i < 4; ++i) {
                    const int c = lane * 4 + i * 256;
                    xv[k][i] = (tk < NCTX) ? *(const f32x4*)(p.in[I_XP] + (size_t)tk * DM + c) : *(const f32x4*)(p.in[I_XS] + (size_t)(tk - NCTX) * DM + c);
                }
            } else {
                u32x2 pa[4], pb[4], xb[4]; f32x4 gv[4];
#pragma unroll
                for (int i = 0; i < 4; ++i) {
                    const int c = lane * 4 + i * 256;
                    xb[i] = *(const u32x2*)(XB + (size_t)tk * DM + c);
                    pa[i] = *(const u32x2*)(P0 + (size_t)tk * DM + c); pb[i] = *(const u32x2*)(P1 + (size_t)tk * DM + c);
                    gv[i] = *(const f32x4*)(mod + ((size_t)gl * 3 + rr[k]) * 9216 + gi * 1024 + c);
                }
#pragma unroll
                for (int i = 0; i < 4; ++i) {
                    f32x4 s2;
                    s2[0] = __builtin_bit_cast(float, pa[i].x << 16) + __builtin_bit_cast(float, pb[i].x << 16);
                    s2[1] = __builtin_bit_cast(float, pa[i].x & 0xffff0000u) + __builtin_bit_cast(float, pb[i].x & 0xffff0000u);
                    s2[2] = __builtin_bit_cast(float, pa[i].y << 16) + __builtin_bit_cast(float, pb[i].y << 16);
                    s2[3] = __builtin_bit_cast(float, pa[i].y & 0xffff0000u) + __builtin_bit_cast(float, pb[i].y & 0xffff0000u);
                    f32x4 x0;
                    x0[0] = __builtin_bit_cast(float, xb[i].x << 16); x0[1] = __builtin_bit_cast(float, xb[i].x & 0xffff0000u);
                    x0[2] = __builtin_bit_cast(float, xb[i].y << 16); x0[3] = __builtin_bit_cast(float, xb[i].y & 0xffff0000u);
                    xv[k][i] = x0 + coef * gv[i] * s2;
                }
            }
        }
#pragma unroll
        for (int k = 0; k < 3; ++k) {
            const int tok = tok0 + k * nw;
            if (ok[k]) {
                if (which == 4) {
#pragma unroll
                    for (int i = 0; i < 4; ++i) *(f32x4*)(p.out + (size_t)tok * DM + lane * 4 + i * 256) = xv[k][i];
                } else {
#pragma unroll
                    for (int i = 0; i < 4; ++i) { u32x2 w; w.x = pk_bf16(xv[k][i][0], xv[k][i][1]); w.y = pk_bf16(xv[k][i][2], xv[k][i][3]); *(u32x2*)(XB + (size_t)tok * DM + lane * 4 + i * 256) = w; }
                }
            }
#pragma unroll
            for (int i = 0; i < 4; ++i) ss[k] += xv[k][i][0] * xv[k][i][0] + xv[k][i][1] * xv[k][i][1] + xv[k][i][2] * xv[k][i][2] + xv[k][i][3] * xv[k][i][3];
        }
        if (which == 4) continue;
#pragma unroll
        for (int k = 0; k < 3; ++k) ss[k] = wave_sum(ss[k]);
#pragma unroll
        for (int k = 0; k < 3; ++k) {
            const int tok = tok0 + k * nw;
            const float rstd = rsqrtf(ss[k] * (1.f / 1024.f) + 1e-6f);
            if (ok[k]) {
#pragma unroll
                for (int i = 0; i < 4; ++i) {
                    const f32x4 y = xv[k][i] * rstd * g[i] * (1.f + sc[k][i]) + sh[k][i];
                    u32x2 w; w.x = pk_bf16(y[0], y[1]); w.y = pk_bf16(y[2], y[3]);
                    *(u32x2*)(H + (size_t)tok * DM + lane * 4 + i * 256) = w;
                }
            }
        }
    }
}

DEVI float rope_apply(float y, int d, int rowp, int colp) {
    const float part = __shfl_xor(y, 16);
    const int dd = d & 31, i = dd & 15;
    const float pos = (float)((d < 32) ? rowp : colp);
    const float inv = exp2f(-(float)i * (13.287712379549449f / 16.f));
    const float ang = pos * inv;
    float sn, cs;
    __sincosf(ang, &sn, &cs);
    return (dd < 16) ? (y * cs - part * sn) : (part * sn + y * cs);
}

DEVI void prep_phase(const Ctx& p, int l) {
    const int t = opaque_tid(), lane = t & 63, wid = t >> 6;
    const bf16_t* U = (const bf16_t*)(p.ws + OFF_U);
    float* fs = (float*)shm;
    float* CA = (float*)(p.ws + OFF_CA);
    float* CB = (float*)(p.ws + OFF_CB);
    for (int u = blockIdx.x; u < 384; u += gridDim.x) {
        __syncthreads();
        const int tt = u >> 2, g = u & 3, tok0 = tt * 64;
        int T, tpos0;
        if (tok0 < NCTX) { T = 256; tpos0 = tok0 & 255; } else { T = 1024; tpos0 = (tok0 - NCTX) & 1023; }
        float* xcs = fs;
        float* cmp = fs + 64 * 68;
        {
            const int tk = t >> 3, c8 = (t & 7) * 8;
            f32x4 a0 = *(const f32x4*)(p.in[I_CCB] + l * 256 + g * 64 + c8), a1 = *(const f32x4*)(p.in[I_CCB] + l * 256 + g * 64 + c8 + 4);
#pragma unroll
            for (int w = 0; w < 4; ++w) {
                const int tp = tpos0 + tk + w - 2;
                if (tp >= 0 && tp < T) {
                    const bf16_t* up = U + (size_t)(tok0 + tk + w - 2) * INW + 1024 + g * 64 + c8;
                    const float* cw = p.in[I_CCW] + ((size_t)l * 4 + w) * 256 + g * 64 + c8;
                    a0 += ldb4(up) * *(const f32x4*)cw;
                    a1 += ldb4(up + 4) * *(const f32x4*)(cw + 4);
                }
            }
            *(f32x4*)(xcs + tk * 68 + c8) = a0; *(f32x4*)(xcs + tk * 68 + c8 + 4) = a1;
        }
        __syncthreads();
        {
            const int fr = lane & 15, fq = lane >> 4, tt4 = wid & 3, dtb = (wid >> 2) * 2;
            bf16x8 af[2];
#pragma unroll
            for (int ks = 0; ks < 2; ++ks) {
                const f32x4 x0 = *(const f32x4*)(xcs + (tt4 * 16 + fr) * 68 + ks * 32 + fq * 8), x1 = *(const f32x4*)(xcs + (tt4 * 16 + fr) * 68 + ks * 32 + fq * 8 + 4);
                u32x4 w; w.x = pk_bf16(x0[0], x0[1]); w.y = pk_bf16(x0[2], x0[3]); w.z = pk_bf16(x1[0], x1[1]); w.w = pk_bf16(x1[2], x1[3]);
                af[ks] = __builtin_bit_cast(bf16x8, w);
            }
            const bf16_t* cwt = (const bf16_t*)(p.ws + OFF_CWT) + (size_t)l * 16 * 4096;
#pragma unroll
            for (int di = 0; di < 2; ++di) {
                const int dcol = (dtb + di) * 16 + fr, ch = g * 64 + dcol;
                f32x4 acc[4];
#pragma unroll
                for (int m = 0; m < 4; ++m) {
                    acc[m] = (f32x4){0.f, 0.f, 0.f, 0.f};
#pragma unroll
                    for (int ks = 0; ks < 2; ++ks) {
                        const bf16x8 bfr = *(const bf16x8*)(cwt + ((size_t)(m * 4 + g) * 64 + dcol) * 64 + ks * 32 + fq * 8);
                        acc[m] = __builtin_amdgcn_mfma_f32_16x16x32_bf16(af[ks], bfr, acc[m], 0, 0, 0);
                    }
                }
#pragma unroll
                for (int dir = 0; dir < 2; ++dir) {
                    const float ba = p.in[I_CBA][((size_t)l * 2 + dir) * 256 + ch], bx = p.in[I_CBX][((size_t)l * 2 + dir) * 256 + ch];
                    const float lam = p.in[I_CLAM][((size_t)l * 2 + dir) * 256 + ch];
                    const float sp = log1pf(expf(-lam));
                    float av[4], bv[4];
#pragma unroll
                    for (int r = 0; r < 4; ++r) {
                        const int tl = tt4 * 16 + fq * 4 + r;
                        const float rg = sigmoidf_(acc[dir * 2][r] + ba);
                        const float ig = sigmoidf_(acc[dir * 2 + 1][r] + bx);
                        const float la = -8.f * rg * sp;
                        const float a = __expf(la);
                        const float t2 = 2.f * la;
                        const float em = -t2 * (1.f + t2 * (0.5f + t2 * (0.16666667f + t2 * (0.041666668f + t2 * (0.008333334f + t2 * 0.0013888889f)))));
                        const float bb = __builtin_amdgcn_sqrtf(em) * (ig * xcs[tl * 68 + dcol]);
                        CA[((size_t)dir * NTOK + tok0 + tl) * 256 + ch] = a;
                        CB[((size_t)dir * NTOK + tok0 + tl) * 256 + ch] = bb;
                        av[r] = a; bv[r] = bb;
                    }
                    float Ac = 1.f, Bc = 0.f;
                    if (dir == 0) {
#pragma unroll
                        for (int r = 0; r < 4; ++r) { Bc = av[r] * Bc + bv[r]; Ac *= av[r]; }
                    } else {
#pragma unroll
                        for (int r = 3; r >= 0; --r) { Bc = av[r] * Bc + bv[r]; Ac *= av[r]; }
                    }
                    const int grp = tt4 * 4 + fq;
                    cmp[((dir * 16 + grp) * 2 + 0) * 64 + dcol] = Ac;
                    cmp[((dir * 16 + grp) * 2 + 1) * 64 + dcol] = Bc;
                }
            }
        }
        __syncthreads();
        if (t < 128) {
            const int dir = t >> 6, dd = t & 63;
            float Ac = 1.f, Bc = 0.f;
#pragma unroll
            for (int q = 0; q < 16; ++q) {
                const int gq = dir == 0 ? q : 15 - q;
                const float a = cmp[((dir * 16 + gq) * 2 + 0) * 64 + dd], b = cmp[((dir * 16 + gq) * 2 + 1) * 64 + dd];
                Bc = a * Bc + b; Ac *= a;
            }
            float* TA = (float*)(p.ws + OFF_TA); float* TB = (float*)(p.ws + OFF_TB);
            TA[((size_t)dir * 96 + tt) * 256 + g * 64 + dd] = Ac;
            TB[((size_t)dir * 96 + tt) * 256 + g * 64 + dd] = Bc;
        }
    }
    const int gw = blockIdx.x * 8 + wid, nw = gridDim.x * 8;
    bf16_t* QA = (bf16_t*)(p.ws + OFF_QA); bf16_t* QB = (bf16_t*)(p.ws + OFF_QB);
    bf16_t* KA = (bf16_t*)(p.ws + OFF_KA); bf16_t* VA = (bf16_t*)(p.ws + OFF_VA);
    bf16_t* KB = (bf16_t*)(p.ws + OFF_KB); bf16_t* VB = (bf16_t*)(p.ws + OFF_VB);
    bf16_t* DQ = (bf16_t*)(p.ws + OFF_DQ); bf16_t* DK = (bf16_t*)(p.ws + OFF_DK); bf16_t* DV = (bf16_t*)(p.ws + OFF_DV);
    {
        const int sub = lane >> 4, li = lane & 15;
        const f32x4 gaq = *(const f32x4*)(p.in[I_AQN] + l * 64 + li * 4), gak = *(const f32x4*)(p.in[I_AKN] + l * 64 + li * 4);
        const f32x4 gbq = *(const f32x4*)(p.in[I_BQN] + l * 64 + li * 4), gbk = *(const f32x4*)(p.in[I_BKN] + l * 64 + li * 4);
        const bool bal = gridDim.x == 256;
        const int tgw = bal ? ((int)blockIdx.x - 128) * 8 + wid : gw, tnw = bal ? 128 * 8 : nw;
        for (int tb = tgw * 4; tb < NTOK && tb >= 0; tb += tnw * 4) {
            const int tok = tb + sub;
            const bool lat = tok >= NCTX;
            int b, tp;
            if (!lat) { b = tok >> 8; tp = tok & 255; } else { b = (tok - NCTX) >> 10; tp = (tok - NCTX) & 1023; }
            const size_t krow = lat ? (size_t)(NCTX + b * 1536 + 512 + tp) : (size_t)tok;
            const bf16_t* ur = U + (size_t)tok * INW + li * 4;
            f32x4 cs = {1.f, 1.f, 1.f, 1.f}, sn = {0.f, 0.f, 0.f, 0.f};
            if (lat) {
                const float pos = (float)((li < 8) ? (tp >> 6) : (tp & 63));
#pragma unroll
                for (int e = 0; e < 4; ++e) {
                    const int fi = (li & 3) * 4 + e;
                    const float ang = pos * exp2f(-(float)fi * (13.287712379549449f / 16.f));
                    float s_, c_; __sincosf(ang, &s_, &c_);
                    cs[e] = c_; sn[e] = s_;
                }
            }
            const bool first = (li & 7) < 4;
#define PREP_NORM(v, gain) do { float ss_ = v[0] * v[0] + v[1] * v[1] + v[2] * v[2] + v[3] * v[3]; \
                ss_ += __shfl_xor(ss_, 1); ss_ += __shfl_xor(ss_, 2); ss_ += __shfl_xor(ss_, 4); ss_ += __shfl_xor(ss_, 8); \
                v = v * rsqrtf(ss_ * (1.f / 64.f) + 1e-6f) * gain; } while (0)
#define PREP_ROPE(v) do { if (lat) { f32x4 pt_; pt_[0] = __shfl_xor(v[0], 4); pt_[1] = __shfl_xor(v[1], 4); pt_[2] = __shfl_xor(v[2], 4); pt_[3] = __shfl_xor(v[3], 4); \
                v = first ? (v * cs - pt_ * sn) : (pt_ * sn + v * cs); } } while (0)
#define PREP_ST4(ptr, v) do { u32x2 w_; w_.x = pk_bf16(v[0], v[1]); w_.y = pk_bf16(v[2], v[3]); *(u32x2*)(ptr) = w_; } while (0)
#pragma unroll
            for (int mx = 0; mx < 2; ++mx) {
                const bf16_t* um = ur + mx * 512;
                bf16_t* Qo = mx ? QB : QA; bf16_t* Ko = mx ? KB : KA; bf16_t* Vo = mx ? VB : VA;
                const f32x4 gq = mx ? gbq : gaq, gk = mx ? gbk : gak;
                float* ck = p.out + (mx ? O_CBK : O_CAK); float* cv = p.out + (mx ? O_CBV : O_CAV);
#pragma unroll
                for (int hq = 0; hq < 4; ++hq) {
                    f32x4 v = ldb4(um + hq * 64);
                    PREP_NORM(v, gq);
                    PREP_ROPE(v);
                    v = v * 0.125f;
                    PREP_ST4(Qo + (size_t)tok * 256 + hq * 64 + li * 4, v);
                }
#pragma unroll
                for (int kv = 0; kv < 2; ++kv) {
                    f32x4 v = ldb4(um + 256 + kv * 64);
                    const f32x4 vv = ldb4(um + 384 + kv * 64);
                    PREP_NORM(v, gk);
                    if (!lat) {
                        const size_t co = (((size_t)b * 2 + l) * 256 + tp) * 128 + kv * 64 + li * 4;
                        *(f32x4*)(ck + co) = v; *(f32x4*)(cv + co) = vv;
                    }
                    PREP_ROPE(v);
                    PREP_ST4(Ko + krow * 128 + kv * 64 + li * 4, v);
                    PREP_ST4(Vo + krow * 128 + kv * 64 + li * 4, vv);
                }
            }
#undef PREP_NORM
#undef PREP_ROPE
#undef PREP_ST4
        }
    }
    for (int it = gw; it < 1024; it += nw) {
        const int b = it >> 9, pos = it & 511;
        const size_t src = (((size_t)b * 2 + l) * 512 + pos) * 128 + lane * 2;
        const size_t dst = ((size_t)(NCTX + b * 1536 + pos)) * 128 + lane * 2;
        f32x2 v;
        v = *(const f32x2*)(p.in[I_CAK] + src); *(unsigned*)(KA + dst) = pk_bf16(v[0], v[1]);
        v = *(const f32x2*)(p.in[I_CAV] + src); *(unsigned*)(VA + dst) = pk_bf16(v[0], v[1]);
        v = *(const f32x2*)(p.in[I_CBK] + src); *(unsigned*)(KB + dst) = pk_bf16(v[0], v[1]);
        v = *(const f32x2*)(p.in[I_CBV] + src); *(unsigned*)(VB + dst) = pk_bf16(v[0], v[1]);
    }
}

DEVI void attn_unit(const Ctx& p, int l, int type, int idx) {
    const int t = opaque_tid(), lane = t & 63, wid = t >> 6, fr = lane & 15, fq = lane >> 4;
    bf16_t* MIX = (bf16_t*)(p.ws + OFF_MIX);
    const bf16_t* U = (const bf16_t*)(p.ws + OFF_U);
    int b, h, qtok0, qpos0, ntiles, kld, kcol, rowbase, ocol;
    const bf16_t *Qp, *Kp, *Vp;
    const bool ret_t = type >= 4;
    int plo = 0;
    if (type == 0 || type == 1 || type == 4) {
        b = idx >> 3; h = (idx >> 1) & 3; const int qh = idx & 1;
        qtok0 = b * 256 + qh * 128; qpos0 = qh * 128; ntiles = 4; rowbase = b * 256;
    } else {
        b = idx >> 5; h = (idx >> 3) & 3; const int qb = idx & 7;
        qtok0 = NCTX + b * 1024 + qb * 128; qpos0 = qb * 128;
        if (type == 2) { plo = qpos0 - 128 < 0 ? 0 : qpos0 - 128; const int phi = qpos0 + 256 > 1024 ? 1024 : qpos0 + 256; ntiles = 8 + ((phi - plo) >> 6); rowbase = NCTX + b * 1536; }
        else if (type == 3) { ntiles = 24; rowbase = NCTX + b * 1536; }
        else { ntiles = 16; rowbase = NCTX + b * 1024; }
    }
    if (type == 0 || type == 2) { Qp = (const bf16_t*)(p.ws + OFF_QA); Kp = (const bf16_t*)(p.ws + OFF_KA); Vp = (const bf16_t*)(p.ws + OFF_VA); kld = 128; kcol = (h >> 1) * 64; ocol = h * 64; }
    else if (type == 1 || type == 3) { Qp = (const bf16_t*)(p.ws + OFF_QB); Kp = (const bf16_t*)(p.ws + OFF_KB); Vp = (const bf16_t*)(p.ws + OFF_VB); kld = 128; kcol = (h >> 1) * 64; ocol = 256 + h * 64; }
    else { Qp = U; Kp = U; Vp = U; kld = INW; kcol = 1792 + h * 64; ocol = 768 + h * 64; }
    const int qld = ret_t ? INW : 256, qcol = ret_t ? 1536 + h * 64 : h * 64, vcol = ret_t ? 2048 + h * 64 : kcol;
    const bool ret = type >= 4;
    const bool dost = (type == 4);
    const int sdir = idx & 1;
    f32x4 SX[2];
#pragma unroll
    for (int i = 0; i < 2; ++i) SX[i] = (f32x4){0.f, 0.f, 0.f, 0.f};
    const int qtok = qtok0 + wid * 16 + fr, qpos = qpos0 + wid * 16 + fr;
    bf16x8 qf[2];
    {
        const bf16_t* qp = Qp + (size_t)qtok * qld + qcol + fq * 8;
        qf[0] = *(const bf16x8*)qp; qf[1] = *(const bf16x8*)(qp + 32);
    }
    float lgf = 0.f, lgb = 0.f;
    if (ret) {
        lgf = log1pf(-expf(p.in[I_DTH][(l * 2 + 0) * 4 + h])) * LOG2E;
        lgb = log1pf(-expf(p.in[I_DTH][(l * 2 + 1) * 4 + h])) * LOG2E;
    }
    float mrun = -1e30f, lrun = 0.f;
    if (type == 0 || type == 2) { mrun = p.in[I_ASINK][l * 4 + h]; lrun = (fq == 0) ? 1.f : 0.f; }
    f32x4 O[4];
#pragma unroll
    for (int i = 0; i < 4; ++i) O[i] = (f32x4){0.f, 0.f, 0.f, 0.f};

    const int skey = t >> 3, sc8 = (t & 7) * 8;
    const int ksw = skey ^ ((sc8 >> 3) << 3);
    const int ATT_BLK = 3 * 64 * 72;
    const int nstage = (ntiles + 3) >> 2;
    u32x4 kr[4], vr[4];
#define ATT_ROW(ti_) ((type == 2) ? (((ti_) < 8) ? rowbase + (ti_) * 64 : rowbase + 512 + plo + ((ti_) - 8) * 64) : rowbase + (ti_) * 64)
#define ATT_LOAD(sp_) do { _Pragma("unroll") for (int j_ = 0; j_ < 4; ++j_) { const int ti_ = (sp_) * 4 + j_; \
        if (ti_ < ntiles) { const int row_ = ATT_ROW(ti_); \
            kr[j_] = *(const u32x4*)(Kp + (size_t)(row_ + skey) * kld + kcol + sc8); \
            vr[j_] = *(const u32x4*)(Vp + (size_t)(row_ + skey) * kld + vcol + sc8); } } } while (0)
    ATT_LOAD(0);
    for (int sp = 0; sp < nstage; ++sp) {
        __syncthreads();
#pragma unroll
        for (int j = 0; j < 4; ++j) {
            const int ti = sp * 4 + j;
            if (ti < ntiles) {
                bf16_t* Kd = shm + j * ATT_BLK; bf16_t* Vd = Kd + 64 * 72;
                const u32x4 kvr = kr[j], vvr = vr[j];
                *(u32x4*)(Kd + skey * 72 + sc8) = kvr;
                Vd[(sc8 + 0) * 72 + ksw] = (bf16_t)(vvr.x & 0xffffu); Vd[(sc8 + 1) * 72 + ksw] = (bf16_t)(vvr.x >> 16);
                Vd[(sc8 + 2) * 72 + ksw] = (bf16_t)(vvr.y & 0xffffu); Vd[(sc8 + 3) * 72 + ksw] = (bf16_t)(vvr.y >> 16);
                Vd[(sc8 + 4) * 72 + ksw] = (bf16_t)(vvr.z & 0xffffu); Vd[(sc8 + 5) * 72 + ksw] = (bf16_t)(vvr.z >> 16);
                Vd[(sc8 + 6) * 72 + ksw] = (bf16_t)(vvr.w & 0xffffu); Vd[(sc8 + 7) * 72 + ksw] = (bf16_t)(vvr.w >> 16);
                if (dost) {
                    bf16_t* Xd = Kd + 2 * 64 * 72; const int mpos = ti * 64 + skey;
                    const float wx = sdir == 0 ? fexp2(lgf * (float)(255 - mpos) - 3.f) : fexp2(lgb * (float)mpos - 3.f);
                    const unsigned kw[4] = {kvr.x, kvr.y, kvr.z, kvr.w};
#pragma unroll
                    for (int j2 = 0; j2 < 4; ++j2) {
                        const float klo = __builtin_bit_cast(float, kw[j2] << 16), khi = __builtin_bit_cast(float, kw[j2] & 0xffff0000u);
                        Xd[(sc8 + 2 * j2) * 72 + ksw] = to_bf16(klo * wx); Xd[(sc8 + 2 * j2 + 1) * 72 + ksw] = to_bf16(khi * wx);
                    }
                }
            }
        }
        __syncthreads();
        if (sp + 1 < nstage) ATT_LOAD(sp + 1);
        const int cnt = (ntiles - sp * 4) < 4 ? (ntiles - sp * 4) : 4;
#pragma unroll 1
        for (int j = 0; j < cnt; ++j) {
        const int ti = sp * 4 + j;
        int kpos0; bool masked = false;
        if (type == 2) { if (ti < 8) kpos0 = 0; else { kpos0 = plo + (ti - 8) * 64; masked = true; } }
        else kpos0 = ti * 64;
        const bf16_t* Ks = shm + j * ATT_BLK;
        const bf16_t* VT = Ks + 64 * 72;
        f32x4 st[4];
#pragma unroll
        for (int kt = 0; kt < 4; ++kt) {
            st[kt] = (f32x4){0.f, 0.f, 0.f, 0.f};
#pragma unroll
            for (int dh = 0; dh < 2; ++dh) {
                const bf16x8 kf = *(const bf16x8*)(Ks + (kt * 16 + fr) * 72 + dh * 32 + fq * 8);
                st[kt] = __builtin_amdgcn_mfma_f32_16x16x32_bf16(kf, qf[dh], st[kt], 0, 0, 0);
            }
        }
        float pv[4][4];
        if (!ret) {
            float mx = -1e30f;
#pragma unroll
            for (int kt = 0; kt < 4; ++kt)
#pragma unroll
                for (int r = 0; r < 4; ++r) {
                    float s_ = st[kt][r];
                    if (masked) { const int dlt = kpos0 + kt * 16 + fq * 4 + r - qpos; if (dlt > 128 || dlt < -128) s_ = -1e30f; }
                    pv[kt][r] = s_;
                    mx = fmaxf(mx, s_);
                }
            mx = fmaxf(mx, __shfl_xor(mx, 16)); mx = fmaxf(mx, __shfl_xor(mx, 32));
            const float mnew = fmaxf(mrun, mx);
            const float alpha = fexp2((mrun - mnew) * LOG2E);
            const float mb = mnew * LOG2E;
            float ps = 0.f;
#pragma unroll
            for (int kt = 0; kt < 4; ++kt)
#pragma unroll
                for (int r = 0; r < 4; ++r) {
                    const float s_ = pv[kt][r];
                    float e = fexp2(s_ * LOG2E - mb);
                    if (masked) e = (s_ <= -1e29f) ? 0.f : e;
                    pv[kt][r] = e; ps += e;
                }
            lrun = lrun * alpha + ps; mrun = mnew;
#pragma unroll
            for (int i = 0; i < 4; ++i) O[i] *= alpha;
        } else {
#pragma unroll
            for (int kt = 0; kt < 4; ++kt)
#pragma unroll
                for (int r = 0; r < 4; ++r) {
                    const int dlt = qpos - (kpos0 + kt * 16 + fq * 4 + r);
                    const float w = dlt > 0 ? fexp2(lgf * (float)dlt - 3.f) : (dlt < 0 ? fexp2(-lgb * (float)dlt - 3.f) : 0.25f);
                    pv[kt][r] = st[kt][r] * w;
                }
        }
#pragma unroll
        for (int pr = 0; pr < 2; ++pr) {
            u32x4 pw;
            pw.x = pk_bf16(pv[2 * pr][0], pv[2 * pr][1]); pw.y = pk_bf16(pv[2 * pr][2], pv[2 * pr][3]);
            pw.z = pk_bf16(pv[2 * pr + 1][0], pv[2 * pr + 1][1]); pw.w = pk_bf16(pv[2 * pr + 1][2], pv[2 * pr + 1][3]);
            const bf16x8 pf = __builtin_bit_cast(bf16x8, pw);
#pragma unroll
            for (int dt = 0; dt < 4; ++dt) {
                const int vsw = ((2 * dt + (fr >> 3)) & 7) << 3;
                const u32x2 lo = *(const u32x2*)(VT + (dt * 16 + fr) * 72 + (((2 * pr) * 16 + fq * 4) ^ vsw));
                const u32x2 hi = *(const u32x2*)(VT + (dt * 16 + fr) * 72 + (((2 * pr + 1) * 16 + fq * 4) ^ vsw));
                u32x4 vw; vw.x = lo.x; vw.y = lo.y; vw.z = hi.x; vw.w = hi.y;
                O[dt] = __builtin_amdgcn_mfma_f32_16x16x32_bf16(__builtin_bit_cast(bf16x8, vw), pf, O[dt], 0, 0, 0);
            }
        }
        if (dost) {
            const bf16_t* KX = Ks + 2 * 64 * 72;
            const int dtw = wid & 3, vt0 = (wid >> 2) * 2;
            const int dsw = ((2 * dtw + (fr >> 3)) & 7) << 3;
#pragma unroll
            for (int ms = 0; ms < 2; ++ms) {
                const bf16x8 bx_ = *(const bf16x8*)(KX + (dtw * 16 + fr) * 72 + ((ms * 32 + fq * 8) ^ dsw));
#pragma unroll
                for (int vi = 0; vi < 2; ++vi) {
                    const int vt = vt0 + vi;
                    const int vsw2 = ((2 * vt + (fr >> 3)) & 7) << 3;
                    const bf16x8 af_ = *(const bf16x8*)(VT + (vt * 16 + fr) * 72 + ((ms * 32 + fq * 8) ^ vsw2));
                    SX[vi] = __builtin_amdgcn_mfma_f32_16x16x32_bf16(af_, bx_, SX[vi], 0, 0, 0);
                }
            }
        }
        }
    }
#undef ATT_ROW
#undef ATT_LOAD
    if (dost) {
        const int dtw = wid & 3, vt0 = (wid >> 2) * 2;
#pragma unroll
        for (int vi = 0; vi < 2; ++vi) {
            const size_t o = (size_t)(dtw * 16 + fr) * 64 + (vt0 + vi) * 16 + fq * 4;
            *(f32x4*)(p.out + O_SD + ((((size_t)b * 2 + l) * 2 + sdir) * 4 + h) * 4096 + o) = SX[vi];
        }
    }
    bf16_t* op = MIX + (size_t)qtok * DM + ocol + fq * 4;
    if (!ret) {
        float ls = lrun; ls += __shfl_xor(ls, 16); ls += __shfl_xor(ls, 32);
        const float inv = 1.f / ls;
#pragma unroll
        for (int dt = 0; dt < 4; ++dt) {
            u32x2 w; w.x = pk_bf16(O[dt][0] * inv, O[dt][1] * inv); w.y = pk_bf16(O[dt][2] * inv, O[dt][3] * inv);
            *(u32x2*)(op + dt * 16) = w;
        }
    } else {
        if (type == 5) {
#pragma unroll
            for (int dir = 0; dir < 2; ++dir) {
                const float* S0 = p.in[I_SD] + ((((size_t)b * 2 + l) * 2 + dir) * 4 + h) * 4096;
                const float wq = dir == 0 ? exp2f(lgf * (float)(qpos + 1)) : exp2f(lgb * (float)(1024 - qpos));
#pragma unroll
                for (int dt = 0; dt < 4; ++dt) {
                    f32x4 tmp = (f32x4){0.f, 0.f, 0.f, 0.f};
#pragma unroll
                    for (int dh = 0; dh < 2; ++dh) {
                        const float* sp = S0 + (size_t)(dh * 32 + fq * 8) * 64 + dt * 16 + fr;
                        u32x4 sw;
                        sw.x = pk_bf16(sp[0], sp[64]); sw.y = pk_bf16(sp[128], sp[192]); sw.z = pk_bf16(sp[256], sp[320]); sw.w = pk_bf16(sp[384], sp[448]);
                        tmp = __builtin_amdgcn_mfma_f32_16x16x32_bf16(__builtin_bit_cast(bf16x8, sw), qf[dh], tmp, 0, 0, 0);
                    }
                    O[dt] += tmp * wq;
                    __builtin_amdgcn_sched_barrier(0);
                }
            }
        }
        float ss = 0.f;
#pragma unroll
        for (int dt = 0; dt < 4; ++dt) ss += O[dt][0] * O[dt][0] + O[dt][1] * O[dt][1] + O[dt][2] * O[dt][2] + O[dt][3] * O[dt][3];
        ss += __shfl_xor(ss, 16); ss += __shfl_xor(ss, 32);
        const float rstd = rsqrtf(ss * (1.f / 64.f) + 1e-6f);
#pragma unroll
        for (int dt = 0; dt < 4; ++dt) {
            const int dcol = h * 64 + dt * 16 + fq * 4;
            const f32x4 gn = *(const f32x4*)(p.in[I_DNG] + l * 256 + dcol);
            const f32x4 dg = ldb4(U + (size_t)qtok * INW + 2304 + dcol);
            float o[4];
#pragma unroll
            for (int r = 0; r < 4; ++r) o[r] = O[dt][r] * rstd * gn[r] * siluf_(dg[r]);
            u32x2 w; w.x = pk_bf16(o[0], o[1]); w.y = pk_bf16(o[2], o[3]);
            *(u32x2*)(op + dt * 16) = w;
        }
    }
}

DEVI void scan_unit(const Ctx& p, int l, int tt) {
    const int t = opaque_tid(), ch = t & 255, dir = t >> 8;
    const float* CA = (const float*)(p.ws + OFF_CA);
    const float* CB = (const float*)(p.ws + OFF_CB);
    const float* TA = (const float*)(p.ws + OFF_TA);
    const float* TB = (const float*)(p.ws + OFF_TB);
    float* HF = (float*)(p.ws + OFF_HF);
    const bf16_t* U = (const bf16_t*)(p.ws + OFF_U);
    bf16_t* MIX = (bf16_t*)(p.ws + OFF_MIX);
    int tile0, tl, nts, sq; float h = 0.f;
    if (tt < 64) { sq = tt >> 2; tile0 = sq * 4; tl = tt & 3; nts = 4; }
    else { const int b = (tt - 64) >> 4; sq = 16 + b; tile0 = 64 + b * 16; tl = (tt - 64) & 15; nts = 16; h = p.in[I_SC][(((size_t)b * 2 + l) * 2 + dir) * 256 + ch]; }
    const int tok0 = tt * 64;
    {
        float ta[16], tb[16];
#pragma unroll
        for (int k = 0; k < 16; ++k) {
            int tk = dir == 0 ? k : nts - 1 - k;
            tk = tk < 0 ? 0 : (tk > nts - 1 ? nts - 1 : tk);
            ta[k] = TA[((size_t)dir * 96 + tile0 + tk) * 256 + ch]; tb[k] = TB[((size_t)dir * 96 + tile0 + tk) * 256 + ch];
        }
        const int npre = dir == 0 ? tl : nts - 1 - tl;
#pragma unroll
        for (int k = 0; k < 16; ++k) if (k < npre) h = ta[k] * h + tb[k];
    }
    const float* ap = CA + ((size_t)dir * NTOK + tok0) * 256 + ch;
    const float* bp = CB + ((size_t)dir * NTOK + tok0) * 256 + ch;
    float* hp = HF + ((size_t)dir * NTOK + tok0) * 256 + ch;
    if (dir == 0) {
#pragma unroll
        for (int t0 = 0; t0 < 64; t0 += 32) {
            float av[32], bv[32];
#pragma unroll
            for (int j = 0; j < 32; ++j) { av[j] = ap[(size_t)(t0 + j) * 256]; bv[j] = bp[(size_t)(t0 + j) * 256]; }
#pragma unroll
            for (int j = 0; j < 32; ++j) { h = av[j] * h + bv[j]; hp[(size_t)(t0 + j) * 256] = h; }
        }
    } else {
#pragma unroll
        for (int t0 = 32; t0 >= 0; t0 -= 32) {
            float av[32], bv[32];
#pragma unroll
            for (int j = 0; j < 32; ++j) { av[j] = ap[(size_t)(t0 + j) * 256]; bv[j] = bp[(size_t)(t0 + j) * 256]; }
#pragma unroll
            for (int j = 31; j >= 0; --j) { h = av[j] * h + bv[j]; hp[(size_t)(t0 + j) * 256] = h; }
        }
    }
    if (tt < 64 && ((dir == 0 && tl == 3) || (dir == 1 && tl == 0))) p.out[O_SC + (((size_t)sq * 2 + l) * 2 + dir) * 256 + ch] = h;
    __syncthreads();
    const float* H0 = HF + (size_t)tok0 * 256;
    const float* H1 = HF + ((size_t)NTOK + tok0) * 256;
#pragma unroll
    for (int i = 0; i < 8; ++i) {
        const int idx = i * 512 + t;
        const int tk = idx >> 6, c4 = (idx & 63) * 4;
        const f32x4 a = *(const f32x4*)(H0 + (size_t)tk * 256 + c4), b = *(const f32x4*)(H1 + (size_t)tk * 256 + c4);
        const f32x4 cy = ldb4(U + (size_t)(tok0 + tk) * INW + 1280 + c4);
        float o[4];
#pragma unroll
        for (int r = 0; r < 4; ++r) {
            const float x = cy[r];
            const float z2 = 1.5957691216057308f * (x + 0.044715f * x * x * x);
            const float ge = x * __builtin_amdgcn_rcpf(1.f + __expf(-z2));
            o[r] = (a[r] + b[r]) * ge;
        }
        u32x2 w; w.x = pk_bf16(o[0], o[1]); w.y = pk_bf16(o[2], o[3]);
        *(u32x2*)(MIX + (size_t)(tok0 + tk) * DM + 512 + c4) = w;
    }
}

DEVI void mixer_phase(const Ctx& p, int l, volatile LAS int* s_unit, int slot) {
    const int NU = 672;
    const int nq = gridDim.x >= 8 ? 8 : 1, q = blockIdx.x % nq;
    unsigned* ctr = (unsigned*)(p.ws + OFF_CTRL) + 4096 + 64 * (slot * 8 + q);
    const int base = (int)gridDim.x < NU ? (int)gridDim.x : NU;
    bool first = true;
    for (;;) {
        int u;
        if (first) { u = blockIdx.x; first = false; if (u >= NU) break; }
        else {
            __syncthreads();
            if (threadIdx.x == 0) *s_unit = base + (int)atomicAdd(ctr, 1u) * nq + q;
            __syncthreads();
            u = *s_unit;
            if (u >= NU) break;
        }
#ifdef MIX_LO
        if (slot >= 2 && (u < MIX_LO || u >= MIX_HI)) continue;
#endif
        if (u < 64) attn_unit(p, l, 3, u);
        else if (u < 128) attn_unit(p, l, 5, u - 64);
        else if (u < 192) attn_unit(p, l, 2, u - 128);
        else if (u < 288) scan_unit(p, l, u - 192);
        else if (u < 416) attn_unit(p, l, 4, u - 288);
        else if (u < 544) attn_unit(p, l, 0, u - 416);
        else attn_unit(p, l, 1, u - 544);
    }
}

__global__ void __launch_bounds__(512, 2) fwd_megakernel(Params P, int ph_lo, int ph_hi) {
    __shared__ uint4 s_ctl[2];
    if (threadIdx.x == 0) {
        s_ctl[0] = make_uint4(0u, 0u, 0u, 0u); s_ctl[1] = make_uint4(0u, 0u, 0u, 0u);
        const float** tabw = (const float**)(P.ws + OFF_TAB) + (size_t)blockIdx.x * 64;
#pragma unroll
        for (int i = 0; i < N_IN; ++i) tabw[i] = P.in[i];
        __threadfence();
    }
    __syncthreads();
    if (P.never) cg::this_grid().sync();
    XcdBarrier xb;
    const bool multi = (ph_hi - ph_lo) > 1;
    if (multi) xb = xcd_barrier_post((unsigned*)(P.ws + OFF_CTRL), (volatile LAS unsigned*)&s_ctl[0]);
    volatile LAS int* s_unit = (volatile LAS int*)&s_ctl[1];
#ifndef PH_MASK
#define PH_MASK 63
#endif
#ifndef DUP_MASK
#define DUP_MASK 0
#endif
    for (int ph2 = ph_lo * 2; ph2 < ph_hi * 2; ++ph2) {
        const int ph = ph2 >> 1, rep = ph2 & 1;
        if (rep) {
            const int kk = (ph >= 1 && ph < 23) ? (ph - 1) % 11 : -1;
            const bool dup = (ph == 0) ? (DUP_MASK & 1) : (ph == 23 || kk == 0 || kk == 3 || kk == 8) ? (DUP_MASK & 2) : (kk == 5) ? (DUP_MASK & 4) : (kk == 6) ? (DUP_MASK & 8) : (kk == 1 || kk == 2 || kk == 4 || kk == 7 || kk == 9 || kk == 10) ? (DUP_MASK & 16) : false;
            if (!dup) continue;
        }
        if (ph2 > ph_lo * 2) xcd_barrier(xb);
        Ctx p;
        p.ws = P.ws; p.out = P.out; p.in = (const float* const*)(P.ws + OFF_TAB) + (size_t)blockIdx.x * 64;
        asm volatile("" : "+s"(p.ws), "+s"(p.out), "+s"(p.in) :: "memory");
        if (ph == 0) { if (PH_MASK & 1) prologue_phase(p); continue; }
        if (ph == 23) { if (PH_MASK & 2) norm_phase(p, 1, 4, rep); continue; }
        const int l = (ph - 1) / 11, k = (ph - 1) % 11;
        const unsigned char* wl = p.ws + OFF_W + (size_t)l * W_LAYER;
        if (k == 0 || k == 3 || k == 8) { if (PH_MASK & 2) norm_phase(p, l, k == 0 ? 1 : (k == 3 ? 2 : 3), rep); }
        else if (k == 5) { if (PH_MASK & 4) prep_phase(p, l); }
        else if (k == 6) { if (PH_MASK & 8) mixer_phase(p, l, s_unit, l + 2 * rep); }
        else if (PH_MASK & 16) {
            GemmDesc g;
            g.nM = NTOK / 256;
            if (k == 1 || k == 9) { g.A = (const bf16_t*)(p.ws + OFF_H); g.Bt = (const bf16_t*)(wl + (k == 1 ? WL_GU1 : WL_GU2)); g.K = 1024; g.nN = 22; g.S = 1; g.nt = 16; g.epi = EPI_GU; g.out = p.ws + OFF_ACT; }
            else if (k == 2 || k == 10) { g.A = (const bf16_t*)(p.ws + OFF_ACT); g.Bt = (const bf16_t*)(wl + (k == 2 ? WL_D1 : WL_D2)); g.K = 2816; g.nN = 4; g.S = 2; g.nt = 22; g.epi = EPI_PART; g.out = p.ws + OFF_U; }
            else if (k == 4) { g.A = (const bf16_t*)(p.ws + OFF_H); g.Bt = (const bf16_t*)(wl + WL_IN); g.K = 1024; g.nN = 10; g.S = 1; g.nt = 16; g.epi = EPI_U; g.out = p.ws + OFF_U; }
            else { g.A = (const bf16_t*)(p.ws + OFF_MIX); g.Bt = (const bf16_t*)(wl + WL_OUT); g.K = 1024; g.nN = 4; g.S = 2; g.nt = 8; g.epi = EPI_PART; g.out = p.ws + OFF_U; }
            gemm_phase(g);
            if (rep == 0 && gridDim.x == 256) {
                int lo = CONV_C0, per = 0;
                for (int q = 1; q <= ph; ++q) {
                    const int kq = (q - 1) % 11;
                    const int sup = (kq == 1 || kq == 9) ? 480 : (kq == 2 || kq == 10) ? 192 : (kq == 4) ? 32 : (kq == 7) ? 64 : 0;
                    if (q < ph) lo += sup; else per = (kq == 1 || kq == 9) ? 2 : (kq == 2 || kq == 10) ? 3 : (kq == 4) ? 2 : 1;
                }
                const int Ug = g.nM * g.nN * g.S, nfull = Ug % (int)gridDim.x;
                if (nfull != 0 && (int)blockIdx.x >= nfull && lo < NTR_UNITS) {
                    const int nidle = (int)gridDim.x - nfull;
                    int hi = lo + per * nidle; if (hi > NTR_UNITS) hi = NTR_UNITS;
                    convert_fill(p, lo, hi, (int)blockIdx.x - nfull, nidle, per);
                }
            }
        }
    }
}

extern "C" void kernel_launch(void* const* d_in, const int* in_sizes, int n_in, void* d_out, int out_size, void* d_ws, size_t ws_size, hipStream_t stream) {
    Params p{};
    for (int i = 0; i < N_IN; ++i) p.in[i] = (const float*)d_in[i];
    p.out = (float*)d_out;
    p.ws = (unsigned char*)d_ws;
    p.never = 0; p.pad = 0;
    static int grid_blocks = 0;
    if (!grid_blocks) {
        (void)hipFuncSetAttribute((const void*)fwd_megakernel, hipFuncAttributeMaxDynamicSharedMemorySize, SHM_BYTES);
        int dev = 0, cus = 0, per_cu = 0;
        (void)hipGetDevice(&dev);
        (void)hipDeviceGetAttribute(&cus, hipDeviceAttributeMultiprocessorCount, dev);
        (void)hipOccupancyMaxActiveBlocksPerMultiprocessor(&per_cu, fwd_megakernel, 512, SHM_BYTES);
        if (per_cu < 1) fprintf(stderr, "occupancy query returned %d\n", per_cu);
        grid_blocks = cus;
    }
    (void)hipMemsetAsync(d_ws, 0, CTRL_BYTES, stream);
#if MK_MULTI
    for (int ph = 0; ph < NPHASE; ++ph)
        fwd_megakernel<<<dim3(grid_blocks), dim3(512), SHM_BYTES, stream>>>(p, ph, ph + 1);
#else
    int lo = 0, hi = NPHASE;
    void* args[] = {&p, &lo, &hi};
    hipError_t e = hipLaunchCooperativeKernel((const void*)fwd_megakernel, dim3(grid_blocks), dim3(512), args, SHM_BYTES, stream);
    if (e != hipSuccess) fprintf(stderr, "cooperative launch failed: %s (grid %d)\n", hipGetErrorString(e), grid_blocks);
#endif
}
```

```cpp
#include <hip/hip_runtime.h>
#include <hip/hip_cooperative_groups.h>
#include <cstdint>
#include <cstdio>
namespace cg = cooperative_groups;

#ifndef MK_MULTI
#define MK_MULTI 0
#endif

#define DEVI __device__ __forceinline__
#define LAS __attribute__((address_space(3)))

typedef unsigned short bf16_t;
typedef short bf16x8 __attribute__((ext_vector_type(8)));
typedef float f32x4 __attribute__((ext_vector_type(4)));
typedef float f32x2 __attribute__((ext_vector_type(2)));
typedef unsigned u32x4 __attribute__((ext_vector_type(4)));
typedef unsigned u32x2 __attribute__((ext_vector_type(2)));

constexpr int NTOK = 6144, NCTX = 4096, DM = 1024, DFF = 2816, INW = 2560;
constexpr int NKROW = 7168;
constexpr float LOG2E = 1.4426950408889634f;

enum { I_XP = 0, I_XS, I_CAK, I_CAV, I_CBK, I_CBV, I_SC, I_SD, I_C, I_CCTX, I_N1, I_N2, I_N3, I_WMOD, I_BMOD,
       I_F1G, I_F1U, I_F1D, I_F2G, I_F2U, I_F2D, I_WIN, I_WOUT, I_AQN, I_AKN, I_ASINK, I_BQN, I_BKN,
       I_CCW, I_CCB, I_CWA, I_CBA, I_CWX, I_CBX, I_CLAM, I_DTH, I_DNG, N_IN };

constexpr size_t O_YP = 0, O_YS = 4194304, O_CAK = 6291456, O_CAV = 7340032, O_CBK = 8388608, O_CBV = 9437184,
                 O_SC = 10485760, O_SD = 10502144;

constexpr size_t OFF_CTRL = 0;
constexpr size_t CTRL_BYTES = 65536;
constexpr size_t OFF_TAB = CTRL_BYTES;
constexpr size_t OFF_MOD = OFF_TAB + 131072;
constexpr size_t OFF_W = OFF_MOD + 262144;
constexpr size_t W_GU = (size_t)5632 * 1024 * 2, W_D = (size_t)1024 * 2816 * 2, W_IN = (size_t)2560 * 1024 * 2, W_OUT = (size_t)1024 * 1024 * 2;
constexpr size_t WL_GU1 = 0, WL_D1 = WL_GU1 + W_GU, WL_IN = WL_D1 + W_D, WL_OUT = WL_IN + W_IN, WL_GU2 = WL_OUT + W_OUT, WL_D2 = WL_GU2 + W_GU, W_LAYER = WL_D2 + W_D;
constexpr size_t OFF_H = OFF_W + 2 * W_LAYER;
constexpr size_t OFF_ACT = OFF_H + (size_t)NTOK * 1024 * 2;
constexpr size_t OFF_U = OFF_ACT + (size_t)NTOK * 2816 * 2;
constexpr size_t OFF_MIX = OFF_U + (size_t)NTOK * 2560 * 4;
constexpr size_t OFF_QA = OFF_MIX + (size_t)NTOK * 1024 * 2;
constexpr size_t OFF_QB = OFF_QA + (size_t)NTOK * 256 * 2;
constexpr size_t OFF_KA = OFF_QB + (size_t)NTOK * 256 * 2;
constexpr size_t OFF_VA = OFF_KA + (size_t)NKROW * 128 * 2;
constexpr size_t OFF_KB = OFF_VA + (size_t)NKROW * 128 * 2;
constexpr size_t OFF_VB = OFF_KB + (size_t)NKROW * 128 * 2;
constexpr size_t OFF_DQ = OFF_VB + (size_t)NKROW * 128 * 2;
constexpr size_t OFF_DK = OFF_DQ + (size_t)NTOK * 256 * 2;
constexpr size_t OFF_DV = OFF_DK + (size_t)NTOK * 256 * 2;
constexpr size_t OFF_CA = OFF_DV + (size_t)NTOK * 256 * 2;
constexpr size_t OFF_CB = OFF_CA + (size_t)2 * NTOK * 256 * 4;
constexpr size_t OFF_HF = OFF_CB + (size_t)2 * NTOK * 256 * 4;
constexpr size_t OFF_TA = OFF_HF + (size_t)2 * NTOK * 256 * 4;
constexpr size_t OFF_TB = OFF_TA + (size_t)2 * 96 * 256 * 4;
constexpr size_t OFF_CWT = OFF_TB + (size_t)2 * 96 * 256 * 4;
constexpr size_t OFF_XB = OFF_CWT + (size_t)2 * 4 * 4 * 4096 * 2;
constexpr size_t WS_TOTAL = OFF_XB + (size_t)NTOK * 1024 * 2;
static_assert(WS_TOTAL < (size_t)300 * 1024 * 1024, "workspace too large");

constexpr int SHM_BYTES = 131072;
constexpr int NPHASE = 24;

struct Params {
    const float* in[N_IN];
    float* out;
    unsigned char* ws;
    int never;
    int pad;
};

struct Ctx { const float* const* in; float* out; unsigned char* ws; };

extern __shared__ __attribute__((aligned(16))) bf16_t shm[];

DEVI unsigned pk_bf16(float lo, float hi) { unsigned r; asm("v_cvt_pk_bf16_f32 %0, %1, %2" : "=v"(r) : "v"(lo), "v"(hi)); return r; }
DEVI bf16_t to_bf16(float x) { return (bf16_t)(pk_bf16(x, 0.f) & 0xffffu); }
DEVI f32x4 ldb4(const bf16_t* p) {
    const u32x2 w = *(const u32x2*)p; f32x4 r;
    r[0] = __builtin_bit_cast(float, w.x << 16); r[1] = __builtin_bit_cast(float, w.x & 0xffff0000u);
    r[2] = __builtin_bit_cast(float, w.y << 16); r[3] = __builtin_bit_cast(float, w.y & 0xffff0000u);
    return r;
}
DEVI float wave_sum(float v) {
#pragma unroll
    for (int o = 32; o > 0; o >>= 1) v += __shfl_xor(v, o);
    return v;
}
DEVI int opaque_tid() { int t = threadIdx.x; asm volatile("" : "+v"(t)); return t; }
DEVI float fexp2(float x) { return __builtin_amdgcn_exp2f(x); }
DEVI float sigmoidf_(float x) { return __builtin_amdgcn_rcpf(1.f + __expf(-x)); }
DEVI float siluf_(float x) { return x * sigmoidf_(x); }

#define XB_TMO      128
#define XB_XCNT(j)  (256  + 64 * (j))
#define XB_XSUB(j)  (1280 + 64 * (j))
#define XB_XGEN(j)  (2304 + 64 * (j))
#define XB_TOP      3328
#define XB_TOPGEN   3392
#define XCD_BAR_WORDS 3456
#define XB_SPIN_CAP (1u << 20)
DEVI unsigned xb_ld(unsigned* p) { return __hip_atomic_load(p, __ATOMIC_RELAXED, __HIP_MEMORY_SCOPE_AGENT); }
DEVI unsigned xb_add(unsigned* p, unsigned v) { return __hip_atomic_fetch_add(p, v, __ATOMIC_RELAXED, __HIP_MEMORY_SCOPE_AGENT); }
DEVI unsigned xb_xcc_id() { return (unsigned)__builtin_amdgcn_s_getreg((3 << 11) | 20) & 0xFu; }
#define XB_SPIN(cond, bar) do { unsigned _sp = 0; while (cond) { __builtin_amdgcn_s_sleep(1); \
    if ((++_sp & 255u) == 0u) { if (xb_ld(&(bar)[XB_TMO])) break; if (_sp > XB_SPIN_CAP) { atomicAdd(&(bar)[XB_TMO], 1u); break; } } } } while (0)
struct XcdBarrier { unsigned* bar; unsigned x; volatile LAS unsigned* st; };
DEVI XcdBarrier xcd_barrier_post(unsigned* bar, volatile LAS unsigned* st) {
    XcdBarrier b; b.bar = bar; b.x = xb_xcc_id(); b.st = st;
    if (threadIdx.x == 0) (void)xb_add(&bar[XB_XCNT(b.x)], 1u);
    return b;
}
DEVI void xcd_barrier_complete(unsigned* bar, unsigned x, unsigned& nloc, unsigned& nx) {
    const unsigned G = gridDim.x * gridDim.y * gridDim.z;
    unsigned sum, cnt, mine, sp = 0u;
    for (;;) {
        sum = 0u; cnt = 0u; mine = 0u;
#pragma unroll
        for (unsigned j = 0; j < 16; ++j) { const unsigned c = xb_ld(&bar[XB_XCNT(j)]); sum += c; cnt += (c > 0u) ? 1u : 0u; mine = (j == x) ? c : mine; }
        if (sum == G) break;
        __builtin_amdgcn_s_sleep(1);
        if ((++sp & 255u) == 0u) { if (xb_ld(&bar[XB_TMO])) break; if (sp > XB_SPIN_CAP) { atomicAdd(&bar[XB_TMO], 1u); break; } }
    }
    nloc = mine > 0u ? mine : 1u; nx = cnt > 0u ? cnt : 1u;
}
DEVI void xcd_barrier(const XcdBarrier& b) {
    asm volatile("s_waitcnt vmcnt(0)" ::: "memory");
    __syncthreads();
    if (threadIdx.x == 0) {
        unsigned* bar = b.bar;
        asm volatile("" : "+s"(bar));
        __builtin_amdgcn_s_waitcnt(0);
        unsigned nloc = b.st[0], nx = b.st[1];
        if (nloc == 0u) { xcd_barrier_complete(bar, b.x, nloc, nx); b.st[0] = nloc; b.st[1] = nx; }
        const unsigned old = xb_add(&bar[XB_XSUB(b.x)], 1u);
        const unsigned gen = old / nloc;
        if (old + 1u == (gen + 1u) * nloc) {
            __builtin_amdgcn_fence(__ATOMIC_RELEASE, "agent");
            asm volatile("s_waitcnt vmcnt(0)" ::: "memory");
            const unsigned og = xb_add(&bar[XB_TOP], 1u);
            const unsigned tg = og / nx;
            if (og + 1u == (tg + 1u) * nx) xb_add(&bar[XB_TOPGEN], 1u);
            else XB_SPIN(xb_ld(&bar[XB_TOPGEN]) == tg, bar);
            __builtin_amdgcn_fence(__ATOMIC_ACQUIRE, "agent");
            xb_add(&bar[XB_XGEN(b.x)], 1u);
            asm volatile("s_waitcnt vmcnt(0)" ::: "memory");
        } else {
            XB_SPIN(xb_ld(&bar[XB_XGEN(b.x)]) == gen, bar);
            __builtin_amdgcn_fence(__ATOMIC_ACQUIRE, "agent");
            asm volatile("s_waitcnt vmcnt(0)" ::: "memory");
        }
    }
    __syncthreads();
}

constexpr int BM = 256, BK = 64, HALF = 128, HTB = HALF * BK * 2;
DEVI int lds_byte(int r, int c) { const int st = (r >> 4) * 2 + (c >> 5), rr = r & 15, cc = c & 31, ob = rr * 64 + cc * 2; return st * 1024 + (ob ^ (((ob >> 9) & 1) << 5)); }
DEVI void stage_rc(int b, int& R, int& C) { const int st = b / 1024, sb = b % 1024, swz = sb ^ (((sb >> 9) & 1) << 5); R = (st >> 1) * 16 + swz / 64; C = (st & 1) * 32 + (swz % 64) / 2; }

enum { EPI_GU = 0, EPI_PART = 1, EPI_U = 2 };
struct GemmDesc { const bf16_t* A; const bf16_t* Bt; int K; int nM, nN, S, nt; int epi; void* out; };
struct Unit { int pm, pn, ks; };

DEVI bool gemm_next(const GemmDesc& g, int i, Unit& u) {
    const int nwg = g.nM * g.nN;
    const long L = (long)i * gridDim.x + blockIdx.x;
    if (L >= (long)nwg * g.S) return false;
    u.ks = (int)(L / nwg);
    int wgid = (int)(L % nwg);
    { const int q = nwg / 8, r = nwg % 8, xcd = wgid % 8, off = wgid / 8; wgid = (xcd < r ? xcd * (q + 1) : r * (q + 1) + (xcd - r) * q) + off; }
    const int WGM = 4;
    const int nig = WGM * g.nN, gid = wgid / nig, fm = gid * WGM, gsz = (g.nM - fm) < WGM ? (g.nM - fm) : WGM;
    u.pm = fm + ((wgid % nig) % gsz); u.pn = (wgid % nig) / gsz;
    return true;
}

DEVI void gemm_epilogue(const GemmDesc& g, const f32x4 (&acc)[2][2][4][2], const Unit& u, int wr, int wc, int fr, int fq) {
    const int brow = u.pm * BM, bcol = u.pn * BM;
    if (g.epi == EPI_GU) {
        bf16_t* act = (bf16_t*)g.out;
#pragma unroll
        for (int ai = 0; ai < 2; ++ai)
#pragma unroll
            for (int m = 0; m < 4; ++m) {
                const int row = brow + ai * HALF + wr * 64 + m * 16 + fr;
                const int hcol = u.pn * 128 + wc * 32 + fq * 8;
                u32x4 w;
                { const f32x4 gt = acc[ai][0][m][0], up = acc[ai][1][m][0];
                  w.x = pk_bf16(siluf_(gt[0]) * up[0], siluf_(gt[1]) * up[1]); w.y = pk_bf16(siluf_(gt[2]) * up[2], siluf_(gt[3]) * up[3]); }
                { const f32x4 gt = acc[ai][0][m][1], up = acc[ai][1][m][1];
                  w.z = pk_bf16(siluf_(gt[0]) * up[0], siluf_(gt[1]) * up[1]); w.w = pk_bf16(siluf_(gt[2]) * up[2], siluf_(gt[3]) * up[3]); }
                *(u32x4*)(act + (size_t)row * DFF + hcol) = w;
            }
    } else if (g.epi == EPI_PART) {
        bf16_t* o = (bf16_t*)g.out + (size_t)u.ks * NTOK * DM;
#pragma unroll
        for (int ai = 0; ai < 2; ++ai)
#pragma unroll
            for (int m = 0; m < 4; ++m) {
                const int row = brow + ai * HALF + wr * 64 + m * 16 + fr;
#pragma unroll
                for (int bj = 0; bj < 2; ++bj) {
                    const int col = bcol + bj * HALF + wc * 32 + fq * 8;
                    const f32x4 v0 = acc[ai][bj][m][0], v1 = acc[ai][bj][m][1];
                    u32x4 w; w.x = pk_bf16(v0[0], v0[1]); w.y = pk_bf16(v0[2], v0[3]); w.z = pk_bf16(v1[0], v1[1]); w.w = pk_bf16(v1[2], v1[3]);
                    *(u32x4*)(o + (size_t)row * DM + col) = w;
                }
            }
    } else {
        bf16_t* o = (bf16_t*)g.out;
#pragma unroll
        for (int ai = 0; ai < 2; ++ai)
#pragma unroll
            for (int m = 0; m < 4; ++m) {
                const int row = brow + ai * HALF + wr * 64 + m * 16 + fr;
#pragma unroll
                for (int bj = 0; bj < 2; ++bj) {
                    const int col = bcol + bj * HALF + wc * 32 + fq * 8;
                    const f32x4 v0 = acc[ai][bj][m][0], v1 = acc[ai][bj][m][1];
                    u32x4 w; w.x = pk_bf16(v0[0], v0[1]); w.y = pk_bf16(v0[2], v0[3]); w.z = pk_bf16(v1[0], v1[1]); w.w = pk_bf16(v1[2], v1[3]);
                    *(u32x4*)(o + (size_t)row * INW + col) = w;
                }
            }
    }
}

DEVI void gemm_phase(const GemmDesc g) {
    LAS unsigned char* lds = (LAS unsigned char*)shm;
    const int tid = opaque_tid(), wid = __builtin_amdgcn_readfirstlane(tid >> 6), lane = tid & 63, wr = wid >> 2, wc = wid & 3, fr = lane & 15, fq = lane >> 4;
    const int K = g.K, nt = g.nt;
    unsigned voffA[2], voffB[2];
#pragma unroll
    for (int i = 0; i < 2; ++i) { int R, C; stage_rc(tid * 16 + i * 8192, R, C); voffA[i] = (unsigned)(R * K + C) * 2u;
        const int rho = R & 31, pr = 8 * ((rho & 15) >> 2) + 4 * (rho >> 4) + (rho & 3); voffB[i] = (unsigned)(((R & ~31) + pr) * K + C) * 2u; }
    const size_t kstep = (size_t)(BK * 2);
    const size_t hstep = (size_t)HALF * K * 2;
    const size_t tstep = 2 * hstep;
    const size_t sstep = (size_t)nt * kstep;
    const unsigned ldsw = (unsigned)wid * 1024u;
    const int aoff = lds_byte(wr * 64 + fr, fq * 8), boff = lds_byte(wc * 32 + fr, fq * 8);
#define PG8_SA(b, h) (((b) * 2 + (h)) * HTB)
#define PG8_SB(b, h) ((4 + (b) * 2 + (h)) * HTB)
#define PG8_STAGE(bufoff, gbase, voff) do { _Pragma("unroll") for (int _i = 0; _i < 2; ++_i) \
        __builtin_amdgcn_global_load_lds((const unsigned*)((const char*)(gbase) + (voff)[_i]), (LAS unsigned*)(lds + (bufoff) + ldsw + _i * 8192), 16, 0, 0); } while (0)
#define PG8_LDA(dst, b, h) do { _Pragma("unroll") for (int m = 0; m < 4; ++m) _Pragma("unroll") for (int k = 0; k < 2; ++k) dst[m][k] = *(const LAS bf16x8*)(lds + PG8_SA(b, h) + aoff + m * 2048 + k * 1024); } while (0)
#define PG8_LDB(dst, b, h) do { _Pragma("unroll") for (int n = 0; n < 2; ++n) _Pragma("unroll") for (int k = 0; k < 2; ++k) dst[n][k] = *(const LAS bf16x8*)(lds + PG8_SB(b, h) + boff + n * 2048 + k * 1024); } while (0)
#define PG8_MMA(ai, bj, At, Bt) do { __builtin_amdgcn_s_setprio(1); _Pragma("unroll") for (int m = 0; m < 4; ++m) _Pragma("unroll") for (int n = 0; n < 2; ++n) _Pragma("unroll") for (int k = 0; k < 2; ++k) \
        acc[ai][bj][m][n] = __builtin_amdgcn_mfma_f32_16x16x32_bf16(Bt[n][k], At[m][k], acc[ai][bj][m][n], 0, 0, 0); __builtin_amdgcn_s_setprio(0); } while (0)
#define PG8_WAIT_V(n) asm volatile("s_waitcnt vmcnt(" #n ")" ::: "memory")
#define PG8_WAIT_L(n) asm volatile("s_waitcnt lgkmcnt(" #n ")" ::: "memory")
#define PG8_BAR __builtin_amdgcn_s_barrier()
#define PG8_SCHED __builtin_amdgcn_sched_barrier(0)
    Unit cur, nxt; int ui = 0;
    if (!gemm_next(g, 0, cur)) return;
    f32x4 acc[2][2][4][2];
#pragma unroll
    for (int a = 0; a < 2; ++a)
#pragma unroll
        for (int b = 0; b < 2; ++b)
#pragma unroll
            for (int m = 0; m < 4; ++m)
#pragma unroll
                for (int n = 0; n < 2; ++n) acc[a][b][m][n] = (f32x4){0.f, 0.f, 0.f, 0.f};
    bf16x8 At[4][2], B0[2][2], B1[2][2];
    const char* cA = (const char*)g.A + (size_t)cur.pm * tstep + (size_t)cur.ks * sstep;
    const char* cB = (const char*)g.Bt + (size_t)cur.pn * tstep + (size_t)cur.ks * sstep;
    PG8_STAGE(PG8_SB(0, 0), cB, voffB); PG8_STAGE(PG8_SB(0, 1), cB + hstep, voffB); PG8_STAGE(PG8_SA(0, 0), cA, voffA); PG8_STAGE(PG8_SA(0, 1), cA + hstep, voffA);
    if (wr == 1) PG8_BAR;
    PG8_WAIT_V(2); PG8_BAR;
    PG8_STAGE(PG8_SB(1, 0), cB + kstep, voffB); PG8_STAGE(PG8_SA(1, 0), cA + kstep, voffA); PG8_STAGE(PG8_SB(1, 1), cB + hstep + kstep, voffB);
    PG8_WAIT_V(6); PG8_BAR;
    for (;;) {
        const bool has_next = gemm_next(g, ui + 1, nxt);
        const char* nA = has_next ? (const char*)g.A + (size_t)nxt.pm * tstep + (size_t)nxt.ks * sstep : cA;
        const char* nB = has_next ? (const char*)g.Bt + (size_t)nxt.pn * tstep + (size_t)nxt.ks * sstep : cB;
        for (int t = 0; t < nt; t += 2) {
            const bool last = (t == nt - 2);
            const char* a1 = cA + (size_t)(t + 1) * kstep;
            const char* a2 = last ? nA : cA + (size_t)(t + 2) * kstep; const char* b2 = last ? nB : cB + (size_t)(t + 2) * kstep;
            const char* a3 = a2 + kstep; const char* b3 = b2 + kstep;
            PG8_LDB(B0, 0, 0); PG8_LDB(B1, 0, 1); PG8_SCHED; PG8_LDA(At, 0, 0); PG8_STAGE(PG8_SA(1, 1), a1 + hstep, voffA);
            PG8_WAIT_V(8); PG8_WAIT_L(0); PG8_BAR; PG8_MMA(0, 0, At, B0); PG8_MMA(0, 1, At, B1); PG8_BAR; PG8_SCHED;
            PG8_LDA(At, 0, 1); PG8_STAGE(PG8_SB(0, 0), b2, voffB); PG8_STAGE(PG8_SB(0, 1), b2 + hstep, voffB); PG8_STAGE(PG8_SA(0, 0), a2, voffA);
            PG8_WAIT_V(8); PG8_WAIT_L(0); PG8_BAR; PG8_MMA(1, 0, At, B0); PG8_MMA(1, 1, At, B1); PG8_BAR; PG8_SCHED;
            PG8_LDB(B0, 1, 0); PG8_LDB(B1, 1, 1); PG8_SCHED; PG8_LDA(At, 1, 0); PG8_STAGE(PG8_SA(0, 1), a2 + hstep, voffA);
            PG8_WAIT_V(8); PG8_WAIT_L(0); PG8_BAR; PG8_MMA(0, 0, At, B0); PG8_MMA(0, 1, At, B1); PG8_BAR; PG8_SCHED;
            PG8_LDA(At, 1, 1); PG8_STAGE(PG8_SB(1, 0), b3, voffB); PG8_STAGE(PG8_SB(1, 1), b3 + hstep, voffB); PG8_STAGE(PG8_SA(1, 0), a3, voffA);
            PG8_WAIT_V(8); PG8_WAIT_L(0); PG8_BAR; PG8_MMA(1, 0, At, B0); PG8_MMA(1, 1, At, B1); PG8_BAR; PG8_SCHED;
        }
        if (wr == 0) PG8_BAR;
        gemm_epilogue(g, acc, cur, wr, wc, fr, fq);
        if (!has_next) break;
#pragma unroll
        for (int a = 0; a < 2; ++a)
#pragma unroll
            for (int b = 0; b < 2; ++b)
#pragma unroll
                for (int m = 0; m < 4; ++m)
#pragma unroll
                    for (int n = 0; n < 2; ++n) acc[a][b][m][n] = (f32x4){0.f, 0.f, 0.f, 0.f};
        cur = nxt; cA = nA; cB = nB; ++ui;
        if (wr == 1) PG8_BAR;
    }
    PG8_WAIT_V(0);
    PG8_BAR;
#undef PG8_SA
#undef PG8_SB
#undef PG8_STAGE
#undef PG8_LDA
#undef PG8_LDB
#undef PG8_MMA
#undef PG8_WAIT_V
#undef PG8_WAIT_L
#undef PG8_BAR
#undef PG8_SCHED
}

constexpr int NTR_UNITS = 2560;
constexpr int CONV_C0 = 352;
DEVI void transpose_unit(const Ctx& p, int tu, int t, float* fs) {
    const int l = tu / 1280, r = tu % 1280;
    int which, loc, K, N, mode; size_t dsto;
    if (r < 176)       { which = I_F1G;  loc = r;        K = 1024; N = 2816; mode = 1; dsto = WL_GU1; }
    else if (r < 352)  { which = I_F1U;  loc = r - 176;  K = 1024; N = 2816; mode = 2; dsto = WL_GU1; }
    else if (r < 528)  { which = I_F1D;  loc = r - 352;  K = 2816; N = 1024; mode = 0; dsto = WL_D1; }
    else if (r < 688)  { which = I_WIN;  loc = r - 528;  K = 1024; N = 2560; mode = 0; dsto = WL_IN; }
    else if (r < 752)  { which = I_WOUT; loc = r - 688;  K = 1024; N = 1024; mode = 0; dsto = WL_OUT; }
    else if (r < 928)  { which = I_F2G;  loc = r - 752;  K = 1024; N = 2816; mode = 1; dsto = WL_GU2; }
    else if (r < 1104) { which = I_F2U;  loc = r - 928;  K = 1024; N = 2816; mode = 2; dsto = WL_GU2; }
    else               { which = I_F2D;  loc = r - 1104; K = 2816; N = 1024; mode = 0; dsto = WL_D2; }
    const int nnt = N / 256, kt = loc / nnt, ntile = loc % nnt;
    const float* src = p.in[which] + (size_t)l * K * N + (size_t)kt * 64 * N + ntile * 256;
    bf16_t* dst = (bf16_t*)(p.ws + OFF_W + (size_t)l * W_LAYER + dsto);
    f32x4 v[8];
#pragma unroll
    for (int i = 0; i < 8; ++i) { const int idx = i * 512 + t; v[i] = *(const f32x4*)(src + (size_t)(idx >> 6) * N + (idx & 63) * 4); }
#pragma unroll
    for (int i = 0; i < 8; ++i) { const int idx = i * 512 + t; *(f32x4*)(fs + (idx >> 6) * 260 + (idx & 63) * 4) = v[i]; }
    __syncthreads();
    const int nl = t & 255, kh = t >> 8;
    int drow;
    if (mode == 0) drow = ntile * 256 + nl;
    else drow = (2 * ntile + (nl >> 7)) * 256 + (nl & 127) + (mode == 2 ? 128 : 0);
    bf16_t* dp = dst + (size_t)drow * K + kt * 64 + kh * 32;
#pragma unroll
    for (int c = 0; c < 4; ++c) {
        u32x4 w;
        const float* f = fs + (kh * 32 + c * 8) * 260 + nl;
        w.x = pk_bf16(f[0], f[260]); w.y = pk_bf16(f[2 * 260], f[3 * 260]); w.z = pk_bf16(f[4 * 260], f[5 * 260]); w.w = pk_bf16(f[6 * 260], f[7 * 260]);
        *(u32x4*)(dp + c * 8) = w;
    }
}

DEVI void convert_fill(const Ctx& p, int lo, int hi, int rank, int nrank, int per) {
    const int t = opaque_tid();
    float* fs = (float*)shm;
    for (int i = 0; i < per; ++i) {
        const int tu = lo + rank + i * nrank;
        if (tu >= hi) break;
        __syncthreads();
        transpose_unit(p, tu, t, fs);
    }
}

DEVI void prologue_phase(const Ctx& p) {
    const int t = opaque_tid();
    float* fs = (float*)shm;
    float* mod = (float*)(p.ws + OFF_MOD);
    const int NMOD = 288, NCW = 32, NTR = (gridDim.x == 256) ? CONV_C0 : NTR_UNITS;
    if (gridDim.x == 256) {
        if (blockIdx.x >= 64)
            for (int tu = (int)blockIdx.x - 64; tu < NTR; tu += 192) { __syncthreads(); transpose_unit(p, tu, t, fs); }
    } else {
        for (int tu = blockIdx.x; tu < NTR; tu += gridDim.x) { __syncthreads(); transpose_unit(p, tu, t, fs); }
    }
    for (int u = blockIdx.x; u < NMOD + NCW; u += gridDim.x) {
        __syncthreads();
        if (u >= NMOD && u < NMOD + NCW) {
            const int mi = u - NMOD, l = mi >> 4, m = (mi >> 2) & 3, g = mi & 3, dir = m >> 1;
            const float* w = ((m & 1) ? p.in[I_CWX] : p.in[I_CWA]) + (((size_t)l * 2 + dir) * 4 + g) * 4096;
            bf16_t* wt = (bf16_t*)(p.ws + OFF_CWT) + (((size_t)l * 4 + m) * 4 + g) * 4096;
            const int d = t >> 3, c8 = (t & 7) * 8;
            u32x4 o;
            o.x = pk_bf16(w[(c8 + 0) * 64 + d], w[(c8 + 1) * 64 + d]); o.y = pk_bf16(w[(c8 + 2) * 64 + d], w[(c8 + 3) * 64 + d]);
            o.z = pk_bf16(w[(c8 + 4) * 64 + d], w[(c8 + 5) * 64 + d]); o.w = pk_bf16(w[(c8 + 6) * 64 + d], w[(c8 + 7) * 64 + d]);
            *(u32x4*)(wt + d * 64 + c8) = o;
        } else if (u < NMOD) {
            const int l = u / 144, jb = u % 144;
            for (int i = t; i < 3072; i += 512) {
                const int r = i >> 10, k = i & 1023;
                const float c = (r == 0) ? p.in[I_CCTX][k] : p.in[I_C][(r - 1) * 1024 + k];
                fs[i] = c / (1.f + __expf(-c));
            }
            __syncthreads();
            const int cgp = t & 15, kg = t >> 4;
            const float* w = p.in[I_WMOD] + ((size_t)l * 1024 + kg * 32) * 9216 + jb * 64 + cgp * 4;
            f32x4 a0 = {0, 0, 0, 0}, a1 = {0, 0, 0, 0}, a2 = {0, 0, 0, 0};
#pragma unroll 8
            for (int k = 0; k < 32; ++k) {
                const f32x4 wv = *(const f32x4*)(w + (size_t)k * 9216);
                const int kk = kg * 32 + k;
                a0 += wv * fs[kk]; a1 += wv * fs[1024 + kk]; a2 += wv * fs[2048 + kk];
            }
            float* red = fs + 3072;
            *(f32x4*)(red + kg * 192 + 0 + cgp * 4) = a0;
            *(f32x4*)(red + kg * 192 + 64 + cgp * 4) = a1;
            *(f32x4*)(red + kg * 192 + 128 + cgp * 4) = a2;
            __syncthreads();
            if (t < 192) {
                float sacc = 0.f;
#pragma unroll 8
                for (int k = 0; k < 32; ++k) sacc += red[k * 192 + t];
                const int r = t >> 6, j = t & 63;
                mod[((size_t)l * 3 + r) * 9216 + jb * 64 + j] = sacc + p.in[I_BMOD][(size_t)l * 9216 + jb * 64 + j];
            }
        } else {
            transpose_unit(p, u - NMOD - NCW, t, fs);
        }
    }
}

DEVI void norm_phase(const Ctx& p, int l, int which, int dry) {
    const int t_ = opaque_tid();
    const int lane = t_ & 63, gw = blockIdx.x * 8 + (t_ >> 6), nw = gridDim.x * 8;
    const float* mod = (const float*)(p.ws + OFF_MOD);
    const bf16_t* P0 = (const bf16_t*)(p.ws + OFF_U);
    const bf16_t* P1 = P0 + (size_t)NTOK * DM;
    bf16_t* H = (bf16_t*)(p.ws + OFF_H);
    bf16_t* XB = (bf16_t*)(p.ws + OFF_XB);
    const bool first = (l == 0 && which == 1);
    int gl, gi; float coef;
    if (which == 1) { gl = l - 1; gi = 8; coef = 0.5f; }
    else if (which == 2) { gl = l; gi = 2; coef = 0.5f; }
    else if (which == 3) { gl = l; gi = 5; coef = 1.0f; }
    else { gl = 1; gi = 8; coef = 0.5f; }
    if (dry) coef = 0.f;
    const float* gn = (which == 1) ? p.in[I_N1] : (which == 2) ? p.in[I_N2] : p.in[I_N3];
    const int shi = (which - 1) * 3, sci = shi + 1;
    for (int tok0 = gw; tok0 < NTOK; tok0 += 3 * nw) {
        f32x4 xv[3][4];
        float ss[3] = {0.f, 0.f, 0.f};
        int rr[3];
        bool ok[3];
        f32x4 g[4], sc[3][4], sh[3][4];
#pragma unroll
        for (int k = 0; k < 3; ++k) {
            const int tok = tok0 + k * nw;
            ok[k] = tok < NTOK;
            const int tk = ok[k] ? tok : tok0;
            rr[k] = tk < NCTX ? 0 : 1 + ((tk - NCTX) >> 10);
            if (which != 4) {
#pragma unroll
                for (int i = 0; i < 4; ++i) {
                    const int c = lane * 4 + i * 256;
                    if (k == 0) g[i] = *(const f32x4*)(gn + (size_t)l * DM + c);
                    sc[k][i] = *(const f32x4*)(mod + ((size_t)l * 3 + rr[k]) * 9216 + sci * 1024 + c);
                    sh[k][i] = *(const f32x4*)(mod + ((size_t)l * 3 + rr[k]) * 9216 + shi * 1024 + c);
                }
            }
            if (first) {
#pragma unroll
                for (int i = 0; i < 4; ++i) {
                    const int c = lane * 4 + i * 256;
                    xv[k][i] = (tk < NCTX) ? *(const f32x4*)(p.in[I_XP] + (size_t)tk * DM + c) : *(const f32x4*)(p.in[I_XS] + (size_t)(tk - NCTX) * DM + c);
                }
            } else {
                u32x2 pa[4], pb[4], xb[4]; f32x4 gv[4];
#pragma unroll
                for (int i = 0; i < 4; ++i) {
                    const int c = lane * 4 + i * 256;
                    xb[i] = *(const u32x2*)(XB + (size_t)tk * DM + c);
                    pa[i] = *(const u32x2*)(P0 + (size_t)tk * DM + c); pb[i] = *(const u32x2*)(P1 + (size_t)tk * DM + c);
                    gv[i] = *(const f32x4*)(mod + ((size_t)gl * 3 + rr[k]) * 9216 + gi * 1024 + c);
                }
#pragma unroll
                for (int i = 0; i < 4; ++i) {
                    f32x4 s2;
                    s2[0] = __builtin_bit_cast(float, pa[i].x << 16) + __builtin_bit_cast(float, pb[i].x << 16);
                    s2[1] = __builtin_bit_cast(float, pa[i].x & 0xffff0000u) + __builtin_bit_cast(float, pb[i].x & 0xffff0000u);
                    s2[2] = __builtin_bit_cast(float, pa[i].y << 16) + __builtin_bit_cast(float, pb[i].y << 16);
                    s2[3] = __builtin_bit_cast(float, pa[i].y & 0xffff0000u) + __builtin_bit_cast(float, pb[i].y & 0xffff0000u);
                    f32x4 x0;
                    x0[0] = __builtin_bit_cast(float, xb[i].x << 16); x0[1] = __builtin_bit_cast(float, xb[i].x & 0xffff0000u);
                    x0[2] = __builtin_bit_cast(float, xb[i].y << 16); x0[3] = __builtin_bit_cast(float, xb[i].y & 0xffff0000u);
                    xv[k][i] = x0 + coef * gv[i] * s2;
                }
            }
        }
#pragma unroll
        for (int k = 0; k < 3; ++k) {
            const int tok = tok0 + k * nw;
            if (ok[k]) {
                if (which == 4) {
#pragma unroll
                    for (int i = 0; i < 4; ++i) *(f32x4*)(p.out + (size_t)tok * DM + lane * 4 + i * 256) = xv[k][i];
                } else {
#pragma unroll
                    for (int i = 0; i < 4; ++i) { u32x2 w; w.x = pk_bf16(xv[k][i][0], xv[k][i][1]); w.y = pk_bf16(xv[k][i][2], xv[k][i][3]); *(u32x2*)(XB + (size_t)tok * DM + lane * 4 + i * 256) = w; }
                }
            }
#pragma unroll
            for (int i = 0; i < 4; ++i) ss[k] += xv[k][i][0] * xv[k][i][0] + xv[k][i][1] * xv[k][i][1] + xv[k][i][2] * xv[k][i][2] + xv[k][i][3] * xv[k][i][3];
        }
        if (which == 4) continue;
#pragma unroll
        for (int k = 0; k < 3; ++k) ss[k] = wave_sum(ss[k]);
#pragma unroll
        for (int k = 0; k < 3; ++k) {
            const int tok = tok0 + k * nw;
            const float rstd = rsqrtf(ss[k] * (1.f / 1024.f) + 1e-6f);
            if (ok[k]) {
#pragma unroll
                for (int i = 0; i < 4; ++i) {
                    const f32x4 y = xv[k][i] * rstd * g[i] * (1.f + sc[k][i]) + sh[k][i];
                    u32x2 w; w.x = pk_bf16(y[0], y[1]); w.y = pk_bf16(y[2], y[3]);
                    *(u32x2*)(H + (size_t)tok * DM + lane * 4 + i * 256) = w;
                }
            }
        }
    }
}

DEVI float rope_apply(float y, int d, int rowp, int colp) {
    const float part = __shfl_xor(y, 16);
    const int dd = d & 31, i = dd & 15;
    const float pos = (float)((d < 32) ? rowp : colp);
    const float inv = exp2f(-(float)i * (13.287712379549449f / 16.f));
    const float ang = pos * inv;
    float sn, cs;
    __sincosf(ang, &sn, &cs);
    return (dd < 16) ? (y * cs - part * sn) : (part * sn + y * cs);
}

DEVI void prep_phase(const Ctx& p, int l) {
    const int t = opaque_tid(), lane = t & 63, wid = t >> 6;
    const bf16_t* U = (const bf16_t*)(p.ws + OFF_U);
    float* fs = (float*)shm;
    float* CA = (float*)(p.ws + OFF_CA);
    float* CB = (float*)(p.ws + OFF_CB);
    for (int u = blockIdx.x; u < 384; u += gridDim.x) {
        __syncthreads();
        const int tt = u >> 2, g = u & 3, tok0 = tt * 64;
        int T, tpos0;
        if (tok0 < NCTX) { T = 256; tpos0 = tok0 & 255; } else { T = 1024; tpos0 = (tok0 - NCTX) & 1023; }
        float* xcs = fs;
        float* cmp = fs + 64 * 68;
        {
            const int tk = t >> 3, c8 = (t & 7) * 8;
            f32x4 a0 = *(const f32x4*)(p.in[I_CCB] + l * 256 + g * 64 + c8), a1 = *(const f32x4*)(p.in[I_CCB] + l * 256 + g * 64 + c8 + 4);
#pragma unroll
            for (int w = 0; w < 4; ++w) {
                const int tp = tpos0 + tk + w - 2;
                if (tp >= 0 && tp < T) {
                    const bf16_t* up = U + (size_t)(tok0 + tk + w - 2) * INW + 1024 + g * 64 + c8;
                    const float* cw = p.in[I_CCW] + ((size_t)l * 4 + w) * 256 + g * 64 + c8;
                    a0 += ldb4(up) * *(const f32x4*)cw;
                    a1 += ldb4(up + 4) * *(const f32x4*)(cw + 4);
                }
            }
            *(f32x4*)(xcs + tk * 68 + c8) = a0; *(f32x4*)(xcs + tk * 68 + c8 + 4) = a1;
        }
        __syncthreads();
        {
            const int fr = lane & 15, fq = lane >> 4, tt4 = wid & 3, dtb = (wid >> 2) * 2;
            bf16x8 af[2];
#pragma unroll
            for (int ks = 0; ks < 2; ++ks) {
                const f32x4 x0 = *(const f32x4*)(xcs + (tt4 * 16 + fr) * 68 + ks * 32 + fq * 8), x1 = *(const f32x4*)(xcs + (tt4 * 16 + fr) * 68 + ks * 32 + fq * 8 + 4);
                u32x4 w; w.x = pk_bf16(x0[0], x0[1]); w.y = pk_bf16(x0[2], x0[3]); w.z = pk_bf16(x1[0], x1[1]); w.w = pk_bf16(x1[2], x1[3]);
                af[ks] = __builtin_bit_cast(bf16x8, w);
            }
            const bf16_t* cwt = (const bf16_t*)(p.ws + OFF_CWT) + (size_t)l * 16 * 4096;
#pragma unroll
            for (int di = 0; di < 2; ++di) {
                const int dcol = (dtb + di) * 16 + fr, ch = g * 64 + dcol;
                f32x4 acc[4];
#pragma unroll
                for (int m = 0; m < 4; ++m) {
                    acc[m] = (f32x4){0.f, 0.f, 0.f, 0.f};
#pragma unroll
                    for (int ks = 0; ks < 2; ++ks) {
                        const bf16x8 bfr = *(const bf16x8*)(cwt + ((size_t)(m * 4 + g) * 64 + dcol) * 64 + ks * 32 + fq * 8);
                        acc[m] = __builtin_amdgcn_mfma_f32_16x16x32_bf16(af[ks], bfr, acc[m], 0, 0, 0);
                    }
                }
#pragma unroll
                for (int dir = 0; dir < 2; ++dir) {
                    const float ba = p.in[I_CBA][((size_t)l * 2 + dir) * 256 + ch], bx = p.in[I_CBX][((size_t)l * 2 + dir) * 256 + ch];
                    const float lam = p.in[I_CLAM][((size_t)l * 2 + dir) * 256 + ch];
                    const float sp = log1pf(expf(-lam));
                    float av[4], bv[4];
#pragma unroll
                    for (int r = 0; r < 4; ++r) {
                        const int tl = tt4 * 16 + fq * 4 + r;
                        const float rg = sigmoidf_(acc[dir * 2][r] + ba);
                        const float ig = sigmoidf_(acc[dir * 2 + 1][r] + bx);
                        const float la = -8.f * rg * sp;
                        const float a = __expf(la);
                        const float t2 = 2.f * la;
                        const float em = -t2 * (1.f + t2 * (0.5f + t2 * (0.16666667f + t2 * (0.041666668f + t2 * (0.008333334f + t2 * 0.0013888889f)))));
                        const float bb = __builtin_amdgcn_sqrtf(em) * (ig * xcs[tl * 68 + dcol]);
                        ((unsigned*)CA)[((size_t)dir * NTOK + tok0 + tl) * 256 + ch] = pk_bf16(1.f - a, bb);
                        av[r] = a; bv[r] = bb;
                    }
                    float Ac = 1.f, Bc = 0.f;
                    if (dir == 0) {
#pragma unroll
                        for (int r = 0; r < 4; ++r) { Bc = av[r] * Bc + bv[r]; Ac *= av[r]; }
                    } else {
#pragma unroll
                        for (int r = 3; r >= 0; --r) { Bc = av[r] * Bc + bv[r]; Ac *= av[r]; }
                    }
                    const int grp = tt4 * 4 + fq;
                    cmp[((dir * 16 + grp) * 2 + 0) * 64 + dcol] = Ac;
                    cmp[((dir * 16 + grp) * 2 + 1) * 64 + dcol] = Bc;
                }
            }
        }
        __syncthreads();
        if (t < 128) {
            const int dir = t >> 6, dd = t & 63;
            float Ac = 1.f, Bc = 0.f;
#pragma unroll
            for (int q = 0; q < 16; ++q) {
                const int gq = dir == 0 ? q : 15 - q;
                const float a = cmp[((dir * 16 + gq) * 2 + 0) * 64 + dd], b = cmp[((dir * 16 + gq) * 2 + 1) * 64 + dd];
                Bc = a * Bc + b; Ac *= a;
            }
            float* TA = (float*)(p.ws + OFF_TA); float* TB = (float*)(p.ws + OFF_TB);
            TA[((size_t)dir * 96 + tt) * 256 + g * 64 + dd] = Ac;
            TB[((size_t)dir * 96 + tt) * 256 + g * 64 + dd] = Bc;
        }
    }
    const int gw = blockIdx.x * 8 + wid, nw = gridDim.x * 8;
    bf16_t* QA = (bf16_t*)(p.ws + OFF_QA); bf16_t* QB = (bf16_t*)(p.ws + OFF_QB);
    bf16_t* KA = (bf16_t*)(p.ws + OFF_KA); bf16_t* VA = (bf16_t*)(p.ws + OFF_VA);
    bf16_t* KB = (bf16_t*)(p.ws + OFF_KB); bf16_t* VB = (bf16_t*)(p.ws + OFF_VB);
    bf16_t* DQ = (bf16_t*)(p.ws + OFF_DQ); bf16_t* DK = (bf16_t*)(p.ws + OFF_DK); bf16_t* DV = (bf16_t*)(p.ws + OFF_DV);
    {
        const int sub = lane >> 4, li = lane & 15;
        const f32x4 gaq = *(const f32x4*)(p.in[I_AQN] + l * 64 + li * 4), gak = *(const f32x4*)(p.in[I_AKN] + l * 64 + li * 4);
        const f32x4 gbq = *(const f32x4*)(p.in[I_BQN] + l * 64 + li * 4), gbk = *(const f32x4*)(p.in[I_BKN] + l * 64 + li * 4);
        const bool bal = gridDim.x == 256;
        const int tgw = bal ? ((int)blockIdx.x - 128) * 8 + wid : gw, tnw = bal ? 128 * 8 : nw;
        for (int tb = tgw * 4; tb < NTOK && tb >= 0; tb += tnw * 4) {
            const int tok = tb + sub;
            const bool lat = tok >= NCTX;
            int b, tp;
            if (!lat) { b = tok >> 8; tp = tok & 255; } else { b = (tok - NCTX) >> 10; tp = (tok - NCTX) & 1023; }
            const size_t krow = lat ? (size_t)(NCTX + b * 1536 + 512 + tp) : (size_t)tok;
            const bf16_t* ur = U + (size_t)tok * INW + li * 4;
            f32x4 cs = {1.f, 1.f, 1.f, 1.f}, sn = {0.f, 0.f, 0.f, 0.f};
            if (lat) {
                const float pos = (float)((li < 8) ? (tp >> 6) : (tp & 63));
#pragma unroll
                for (int e = 0; e < 4; ++e) {
                    const int fi = (li & 3) * 4 + e;
                    const float ang = pos * exp2f(-(float)fi * (13.287712379549449f / 16.f));
                    float s_, c_; __sincosf(ang, &s_, &c_);
                    cs[e] = c_; sn[e] = s_;
                }
            }
            const bool first = (li & 7) < 4;
#define PREP_NORM(v, gain) do { float ss_ = v[0] * v[0] + v[1] * v[1] + v[2] * v[2] + v[3] * v[3]; \
                ss_ += __shfl_xor(ss_, 1); ss_ += __shfl_xor(ss_, 2); ss_ += __shfl_xor(ss_, 4); ss_ += __shfl_xor(ss_, 8); \
                v = v * rsqrtf(ss_ * (1.f / 64.f) + 1e-6f) * gain; } while (0)
#define PREP_ROPE(v) do { if (lat) { f32x4 pt_; pt_[0] = __shfl_xor(v[0], 4); pt_[1] = __shfl_xor(v[1], 4); pt_[2] = __shfl_xor(v[2], 4); pt_[3] = __shfl_xor(v[3], 4); \
                v = first ? (v * cs - pt_ * sn) : (pt_ * sn + v * cs); } } while (0)
#define PREP_ST4(ptr, v) do { u32x2 w_; w_.x = pk_bf16(v[0], v[1]); w_.y = pk_bf16(v[2], v[3]); *(u32x2*)(ptr) = w_; } while (0)
#pragma unroll
            for (int mx = 0; mx < 2; ++mx) {
                const bf16_t* um = ur + mx * 512;
                bf16_t* Qo = mx ? QB : QA; bf16_t* Ko = mx ? KB : KA; bf16_t* Vo = mx ? VB : VA;
                const f32x4 gq = mx ? gbq : gaq, gk = mx ? gbk : gak;
                float* ck = p.out + (mx ? O_CBK : O_CAK); float* cv = p.out + (mx ? O_CBV : O_CAV);
#pragma unroll
                for (int hq = 0; hq < 4; ++hq) {
                    f32x4 v = ldb4(um + hq * 64);
                    PREP_NORM(v, gq);
                    PREP_ROPE(v);
                    v = v * 0.125f;
                    PREP_ST4(Qo + (size_t)tok * 256 + hq * 64 + li * 4, v);
                }
#pragma unroll
                for (int kv = 0; kv < 2; ++kv) {
                    f32x4 v = ldb4(um + 256 + kv * 64);
                    const f32x4 vv = ldb4(um + 384 + kv * 64);
                    PREP_NORM(v, gk);
                    if (!lat) {
                        const size_t co = (((size_t)b * 2 + l) * 256 + tp) * 128 + kv * 64 + li * 4;
                        *(f32x4*)(ck + co) = v; *(f32x4*)(cv + co) = vv;
                    }
                    PREP_ROPE(v);
                    PREP_ST4(Ko + krow * 128 + kv * 64 + li * 4, v);
                }
            }
#undef PREP_NORM
#undef PREP_ROPE
#undef PREP_ST4
        }
    }
    for (int it = gw; it < 1024; it += nw) {
        const int b = it >> 9, pos = it & 511;
        const size_t src = (((size_t)b * 2 + l) * 512 + pos) * 128 + lane * 2;
        const size_t dst = ((size_t)(NCTX + b * 1536 + pos)) * 128 + lane * 2;
        f32x2 v;
        v = *(const f32x2*)(p.in[I_CAK] + src); *(unsigned*)(KA + dst) = pk_bf16(v[0], v[1]);
        v = *(const f32x2*)(p.in[I_CAV] + src); *(unsigned*)(VA + dst) = pk_bf16(v[0], v[1]);
        v = *(const f32x2*)(p.in[I_CBK] + src); *(unsigned*)(KB + dst) = pk_bf16(v[0], v[1]);
        v = *(const f32x2*)(p.in[I_CBV] + src); *(unsigned*)(VB + dst) = pk_bf16(v[0], v[1]);
    }
}

DEVI void attn_unit(const Ctx& p, int l, int type, int idx) {
    const int t = opaque_tid(), lane = t & 63, wid = t >> 6, fr = lane & 15, fq = lane >> 4;
    bf16_t* MIX = (bf16_t*)(p.ws + OFF_MIX);
    const bf16_t* U = (const bf16_t*)(p.ws + OFF_U);
    int b, h, qtok0, qpos0, ntiles, kld, kcol, rowbase, ocol;
    const bf16_t *Qp, *Kp, *Vp;
    const bool ret_t = type >= 4;
    int plo = 0;
    if (type == 0 || type == 1 || type == 4) {
        b = idx >> 3; h = (idx >> 1) & 3; const int qh = idx & 1;
        qtok0 = b * 256 + qh * 128; qpos0 = qh * 128; ntiles = 4; rowbase = b * 256;
    } else {
        b = idx >> 5; h = (idx >> 3) & 3; const int qb = idx & 7;
        qtok0 = NCTX + b * 1024 + qb * 128; qpos0 = qb * 128;
        if (type == 2) { plo = qpos0 - 128 < 0 ? 0 : qpos0 - 128; const int phi = qpos0 + 256 > 1024 ? 1024 : qpos0 + 256; ntiles = 8 + ((phi - plo) >> 6); rowbase = NCTX + b * 1536; }
        else if (type == 3) { ntiles = 24; rowbase = NCTX + b * 1536; }
        else { ntiles = 16; rowbase = NCTX + b * 1024; }
    }
    if (type == 0 || type == 2) { Qp = (const bf16_t*)(p.ws + OFF_QA); Kp = (const bf16_t*)(p.ws + OFF_KA); Vp = (const bf16_t*)(p.ws + OFF_VA); kld = 128; kcol = (h >> 1) * 64; ocol = h * 64; }
    else if (type == 1 || type == 3) { Qp = (const bf16_t*)(p.ws + OFF_QB); Kp = (const bf16_t*)(p.ws + OFF_KB); Vp = (const bf16_t*)(p.ws + OFF_VB); kld = 128; kcol = (h >> 1) * 64; ocol = 256 + h * 64; }
    else { Qp = U; Kp = U; Vp = U; kld = INW; kcol = 1792 + h * 64; ocol = 768 + h * 64; }
    const int vucol = ((type & 1) ? 896 : 384) + (h >> 1) * 64;
    const int qld = ret_t ? INW : 256, qcol = ret_t ? 1536 + h * 64 : h * 64, vcol = ret_t ? 2048 + h * 64 : kcol;
    const bool ret = type >= 4;
    const bool dost = (type == 4);
    const int sdir = idx & 1;
    f32x4 SX[2];
#pragma unroll
    for (int i = 0; i < 2; ++i) SX[i] = (f32x4){0.f, 0.f, 0.f, 0.f};
    const int qtok = qtok0 + wid * 16 + fr, qpos = qpos0 + wid * 16 + fr;
    bf16x8 qf[2];
    {
        const bf16_t* qp = Qp + (size_t)qtok * qld + qcol + fq * 8;
        qf[0] = *(const bf16x8*)qp; qf[1] = *(const bf16x8*)(qp + 32);
    }
    float lgf = 0.f, lgb = 0.f;
    if (ret) {
        lgf = log1pf(-expf(p.in[I_DTH][(l * 2 + 0) * 4 + h])) * LOG2E;
        lgb = log1pf(-expf(p.in[I_DTH][(l * 2 + 1) * 4 + h])) * LOG2E;
    }
    float mrun = -1e30f, lrun = 0.f;
    if (type == 0 || type == 2) { mrun = p.in[I_ASINK][l * 4 + h]; lrun = (fq == 0) ? 1.f : 0.f; }
    f32x4 O[4];
#pragma unroll
    for (int i = 0; i < 4; ++i) O[i] = (f32x4){0.f, 0.f, 0.f, 0.f};

    const int skey = t >> 3, sc8 = (t & 7) * 8;
    const int ksw = skey ^ ((sc8 >> 3) << 3);
    const int ATT_BLK = 3 * 64 * 72;
    const int nstage = (ntiles + 3) >> 2;
    u32x4 kr[4], vr[4];
#define ATT_ROW(ti_) ((type == 2) ? (((ti_) < 8) ? rowbase + (ti_) * 64 : rowbase + 512 + plo + ((ti_) - 8) * 64) : rowbase + (ti_) * 64)
#define ATT_LOAD(sp_) do { _Pragma("unroll") for (int j_ = 0; j_ < 4; ++j_) { const int ti_ = (sp_) * 4 + j_; \
        if (ti_ < ntiles) { const int row_ = ATT_ROW(ti_); \
            kr[j_] = *(const u32x4*)(Kp + (size_t)(row_ + skey) * kld + kcol + sc8); \
            const bool vu_ = (type <= 1) || (type <= 3 && ti_ >= 8);       \
            const bf16_t* vp_ = vu_ ? U + (size_t)((type <= 1 ? row_ : row_ - rowbase - 512 + NCTX + b * 1024) + skey) * INW + vucol + sc8 \
                                    : Vp + (size_t)(row_ + skey) * kld + vcol + sc8; \
            vr[j_] = *(const u32x4*)vp_; } } } while (0)
    ATT_LOAD(0);
    for (int sp = 0; sp < nstage; ++sp) {
        __syncthreads();
#pragma unroll
        for (int j = 0; j < 4; ++j) {
            const int ti = sp * 4 + j;
            if (ti < ntiles) {
                bf16_t* Kd = shm + j * ATT_BLK; bf16_t* Vd = Kd + 64 * 72;
                const u32x4 kvr = kr[j], vvr = vr[j];
                *(u32x4*)(Kd + skey * 72 + sc8) = kvr;
                Vd[(sc8 + 0) * 72 + ksw] = (bf16_t)(vvr.x & 0xffffu); Vd[(sc8 + 1) * 72 + ksw] = (bf16_t)(vvr.x >> 16);
                Vd[(sc8 + 2) * 72 + ksw] = (bf16_t)(vvr.y & 0xffffu); Vd[(sc8 + 3) * 72 + ksw] = (bf16_t)(vvr.y >> 16);
                Vd[(sc8 + 4) * 72 + ksw] = (bf16_t)(vvr.z & 0xffffu); Vd[(sc8 + 5) * 72 + ksw] = (bf16_t)(vvr.z >> 16);
                Vd[(sc8 + 6) * 72 + ksw] = (bf16_t)(vvr.w & 0xffffu); Vd[(sc8 + 7) * 72 + ksw] = (bf16_t)(vvr.w >> 16);
                if (dost) {
                    bf16_t* Xd = Kd + 2 * 64 * 72; const int mpos = ti * 64 + skey;
                    const float wx = sdir == 0 ? fexp2(lgf * (float)(255 - mpos) - 3.f) : fexp2(lgb * (float)mpos - 3.f);
                    const unsigned kw[4] = {kvr.x, kvr.y, kvr.z, kvr.w};
#pragma unroll
                    for (int j2 = 0; j2 < 4; ++j2) {
                        const float klo = __builtin_bit_cast(float, kw[j2] << 16), khi = __builtin_bit_cast(float, kw[j2] & 0xffff0000u);
                        Xd[(sc8 + 2 * j2) * 72 + ksw] = to_bf16(klo * wx); Xd[(sc8 + 2 * j2 + 1) * 72 + ksw] = to_bf16(khi * wx);
                    }
                }
            }
        }
        __syncthreads();
        if (sp + 1 < nstage) ATT_LOAD(sp + 1);
        const int cnt = (ntiles - sp * 4) < 4 ? (ntiles - sp * 4) : 4;
#pragma unroll 1
        for (int j = 0; j < cnt; ++j) {
        const int ti = sp * 4 + j;
        int kpos0; bool masked = false;
        if (type == 2) { if (ti < 8) kpos0 = 0; else { kpos0 = plo + (ti - 8) * 64; masked = true; } }
        else kpos0 = ti * 64;
        const bf16_t* Ks = shm + j * ATT_BLK;
        const bf16_t* VT = Ks + 64 * 72;
        f32x4 st[4];
#pragma unroll
        for (int kt = 0; kt < 4; ++kt) {
            st[kt] = (f32x4){0.f, 0.f, 0.f, 0.f};
#pragma unroll
            for (int dh = 0; dh < 2; ++dh) {
                const bf16x8 kf = *(const bf16x8*)(Ks + (kt * 16 + fr) * 72 + dh * 32 + fq * 8);
                st[kt] = __builtin_amdgcn_mfma_f32_16x16x32_bf16(kf, qf[dh], st[kt], 0, 0, 0);
            }
        }
        float pv[4][4];
        if (!ret) {
            float mx = -1e30f;
#pragma unroll
            for (int kt = 0; kt < 4; ++kt)
#pragma unroll
                for (int r = 0; r < 4; ++r) {
                    float s_ = st[kt][r];
                    if (masked) { const int dlt = kpos0 + kt * 16 + fq * 4 + r - qpos; if (dlt > 128 || dlt < -128) s_ = -1e30f; }
                    pv[kt][r] = s_;
                    mx = fmaxf(mx, s_);
                }
            mx = fmaxf(mx, __shfl_xor(mx, 16)); mx = fmaxf(mx, __shfl_xor(mx, 32));
            const float mnew = fmaxf(mrun, mx);
            const float alpha = fexp2((mrun - mnew) * LOG2E);
            const float mb = mnew * LOG2E;
            float ps = 0.f;
#pragma unroll
            for (int kt = 0; kt < 4; ++kt)
#pragma unroll
                for (int r = 0; r < 4; ++r) {
                    const float s_ = pv[kt][r];
                    float e = fexp2(s_ * LOG2E - mb);
                    if (masked) e = (s_ <= -1e29f) ? 0.f : e;
                    pv[kt][r] = e; ps += e;
                }
            lrun = lrun * alpha + ps; mrun = mnew;
#pragma unroll
            for (int i = 0; i < 4; ++i) O[i] *= alpha;
        } else {
#pragma unroll
            for (int kt = 0; kt < 4; ++kt)
#pragma unroll
                for (int r = 0; r < 4; ++r) {
                    const int dlt = qpos - (kpos0 + kt * 16 + fq * 4 + r);
                    const float w = dlt > 0 ? fexp2(lgf * (float)dlt - 3.f) : (dlt < 0 ? fexp2(-lgb * (float)dlt - 3.f) : 0.25f);
                    pv[kt][r] = st[kt][r] * w;
                }
        }
#pragma unroll
        for (int pr = 0; pr < 2; ++pr) {
            u32x4 pw;
            pw.x = pk_bf16(pv[2 * pr][0], pv[2 * pr][1]); pw.y = pk_bf16(pv[2 * pr][2], pv[2 * pr][3]);
            pw.z = pk_bf16(pv[2 * pr + 1][0], pv[2 * pr + 1][1]); pw.w = pk_bf16(pv[2 * pr + 1][2], pv[2 * pr + 1][3]);
            const bf16x8 pf = __builtin_bit_cast(bf16x8, pw);
#pragma unroll
            for (int dt = 0; dt < 4; ++dt) {
                const int vsw = ((2 * dt + (fr >> 3)) & 7) << 3;
                const u32x2 lo = *(const u32x2*)(VT + (dt * 16 + fr) * 72 + (((2 * pr) * 16 + fq * 4) ^ vsw));
                const u32x2 hi = *(const u32x2*)(VT + (dt * 16 + fr) * 72 + (((2 * pr + 1) * 16 + fq * 4) ^ vsw));
                u32x4 vw; vw.x = lo.x; vw.y = lo.y; vw.z = hi.x; vw.w = hi.y;
                O[dt] = __builtin_amdgcn_mfma_f32_16x16x32_bf16(__builtin_bit_cast(bf16x8, vw), pf, O[dt], 0, 0, 0);
            }
        }
        if (dost) {
            const bf16_t* KX = Ks + 2 * 64 * 72;
            const int dtw = wid & 3, vt0 = (wid >> 2) * 2;
            const int dsw = ((2 * dtw + (fr >> 3)) & 7) << 3;
#pragma unroll
            for (int ms = 0; ms < 2; ++ms) {
                const bf16x8 bx_ = *(const bf16x8*)(KX + (dtw * 16 + fr) * 72 + ((ms * 32 + fq * 8) ^ dsw));
#pragma unroll
                for (int vi = 0; vi < 2; ++vi) {
                    const int vt = vt0 + vi;
                    const int vsw2 = ((2 * vt + (fr >> 3)) & 7) << 3;
                    const bf16x8 af_ = *(const bf16x8*)(VT + (vt * 16 + fr) * 72 + ((ms * 32 + fq * 8) ^ vsw2));
                    SX[vi] = __builtin_amdgcn_mfma_f32_16x16x32_bf16(af_, bx_, SX[vi], 0, 0, 0);
                }
            }
        }
        }
    }
#undef ATT_ROW
#undef ATT_LOAD
    if (dost) {
        const int dtw = wid & 3, vt0 = (wid >> 2) * 2;
#pragma unroll
        for (int vi = 0; vi < 2; ++vi) {
            const size_t o = (size_t)(dtw * 16 + fr) * 64 + (vt0 + vi) * 16 + fq * 4;
            *(f32x4*)(p.out + O_SD + ((((size_t)b * 2 + l) * 2 + sdir) * 4 + h) * 4096 + o) = SX[vi];
        }
    }
    bf16_t* op = MIX + (size_t)qtok * DM + ocol + fq * 4;
    if (!ret) {
        float ls = lrun; ls += __shfl_xor(ls, 16); ls += __shfl_xor(ls, 32);
        const float inv = 1.f / ls;
#pragma unroll
        for (int dt = 0; dt < 4; ++dt) {
            u32x2 w; w.x = pk_bf16(O[dt][0] * inv, O[dt][1] * inv); w.y = pk_bf16(O[dt][2] * inv, O[dt][3] * inv);
            *(u32x2*)(op + dt * 16) = w;
        }
    } else {
        if (type == 5) {
#pragma unroll
            for (int dir = 0; dir < 2; ++dir) {
                const float* S0 = p.in[I_SD] + ((((size_t)b * 2 + l) * 2 + dir) * 4 + h) * 4096;
                const float wq = dir == 0 ? exp2f(lgf * (float)(qpos + 1)) : exp2f(lgb * (float)(1024 - qpos));
#pragma unroll
                for (int dt = 0; dt < 4; ++dt) {
                    f32x4 tmp = (f32x4){0.f, 0.f, 0.f, 0.f};
#pragma unroll
                    for (int dh = 0; dh < 2; ++dh) {
                        const float* sp = S0 + (size_t)(dh * 32 + fq * 8) * 64 + dt * 16 + fr;
                        u32x4 sw;
                        sw.x = pk_bf16(sp[0], sp[64]); sw.y = pk_bf16(sp[128], sp[192]); sw.z = pk_bf16(sp[256], sp[320]); sw.w = pk_bf16(sp[384], sp[448]);
                        tmp = __builtin_amdgcn_mfma_f32_16x16x32_bf16(__builtin_bit_cast(bf16x8, sw), qf[dh], tmp, 0, 0, 0);
                    }
                    O[dt] += tmp * wq;
                    __builtin_amdgcn_sched_barrier(0);
                }
            }
        }
        float ss = 0.f;
#pragma unroll
        for (int dt = 0; dt < 4; ++dt) ss += O[dt][0] * O[dt][0] + O[dt][1] * O[dt][1] + O[dt][2] * O[dt][2] + O[dt][3] * O[dt][3];
        ss += __shfl_xor(ss, 16); ss += __shfl_xor(ss, 32);
        const float rstd = rsqrtf(ss * (1.f / 64.f) + 1e-6f);
#pragma unroll
        for (int dt = 0; dt < 4; ++dt) {
            const int dcol = h * 64 + dt * 16 + fq * 4;
            const f32x4 gn = *(const f32x4*)(p.in[I_DNG] + l * 256 + dcol);
            const f32x4 dg = ldb4(U + (size_t)qtok * INW + 2304 + dcol);
            float o[4];
#pragma unroll
            for (int r = 0; r < 4; ++r) o[r] = O[dt][r] * rstd * gn[r] * siluf_(dg[r]);
            u32x2 w; w.x = pk_bf16(o[0], o[1]); w.y = pk_bf16(o[2], o[3]);
            *(u32x2*)(op + dt * 16) = w;
        }
    }
}

DEVI void scan_unit(const Ctx& p, int l, int tt) {
    const int t = opaque_tid(), ch = t & 255, dir = t >> 8;
    const float* CA = (const float*)(p.ws + OFF_CA);
    const float* CB = (const float*)(p.ws + OFF_CB);
    const float* TA = (const float*)(p.ws + OFF_TA);
    const float* TB = (const float*)(p.ws + OFF_TB);
    const bf16_t* U = (const bf16_t*)(p.ws + OFF_U);
    bf16_t* MIX = (bf16_t*)(p.ws + OFF_MIX);
    int tile0, tl, nts, sq; float h = 0.f;
    if (tt < 64) { sq = tt >> 2; tile0 = sq * 4; tl = tt & 3; nts = 4; }
    else { const int b = (tt - 64) >> 4; sq = 16 + b; tile0 = 64 + b * 16; tl = (tt - 64) & 15; nts = 16; h = p.in[I_SC][(((size_t)b * 2 + l) * 2 + dir) * 256 + ch]; }
    const int tok0 = tt * 64;
    {
        float ta[16], tb[16];
#pragma unroll
        for (int k = 0; k < 16; ++k) {
            int tk = dir == 0 ? k : nts - 1 - k;
            tk = tk < 0 ? 0 : (tk > nts - 1 ? nts - 1 : tk);
            ta[k] = TA[((size_t)dir * 96 + tile0 + tk) * 256 + ch]; tb[k] = TB[((size_t)dir * 96 + tile0 + tk) * 256 + ch];
        }
        const int npre = dir == 0 ? tl : nts - 1 - tl;
#pragma unroll
        for (int k = 0; k < 16; ++k) if (k < npre) h = ta[k] * h + tb[k];
    }
    const unsigned* abp = (const unsigned*)CA + ((size_t)dir * NTOK + tok0) * 256 + ch;
    float* hp = (float*)shm + dir * (64 * 256) + ch;
    if (dir == 0) {
#pragma unroll
        for (int t0 = 0; t0 < 64; t0 += 32) {
            float av[32], bv[32];
#pragma unroll
            for (int j = 0; j < 32; ++j) { const unsigned w_ = abp[(size_t)(t0 + j) * 256]; av[j] = 1.f - __builtin_bit_cast(float, w_ << 16); bv[j] = __builtin_bit_cast(float, w_ & 0xffff0000u); }
#pragma unroll
            for (int j = 0; j < 32; ++j) { h = av[j] * h + bv[j]; hp[(size_t)(t0 + j) * 256] = h; }
        }
    } else {
#pragma unroll
        for (int t0 = 32; t0 >= 0; t0 -= 32) {
            float av[32], bv[32];
#pragma unroll
            for (int j = 0; j < 32; ++j) { const unsigned w_ = abp[(size_t)(t0 + j) * 256]; av[j] = 1.f - __builtin_bit_cast(float, w_ << 16); bv[j] = __builtin_bit_cast(float, w_ & 0xffff0000u); }
#pragma unroll
            for (int j = 31; j >= 0; --j) { h = av[j] * h + bv[j]; hp[(size_t)(t0 + j) * 256] = h; }
        }
    }
    if (tt < 64 && ((dir == 0 && tl == 3) || (dir == 1 && tl == 0))) p.out[O_SC + (((size_t)sq * 2 + l) * 2 + dir) * 256 + ch] = h;
    __syncthreads();
    const float* H0 = (const float*)shm;
    const float* H1 = H0 + 64 * 256;
#pragma unroll
    for (int i = 0; i < 8; ++i) {
        const int idx = i * 512 + t;
        const int tk = idx >> 6, c4 = (idx & 63) * 4;
        const f32x4 a = *(const f32x4*)(H0 + (size_t)tk * 256 + c4), b = *(const f32x4*)(H1 + (size_t)tk * 256 + c4);
        const f32x4 cy = ldb4(U + (size_t)(tok0 + tk) * INW + 1280 + c4);
        float o[4];
#pragma unroll
        for (int r = 0; r < 4; ++r) {
            const float x = cy[r];
            const float z2 = 1.5957691216057308f * (x + 0.044715f * x * x * x);
            const float ge = x * __builtin_amdgcn_rcpf(1.f + __expf(-z2));
            o[r] = (a[r] + b[r]) * ge;
        }
        u32x2 w; w.x = pk_bf16(o[0], o[1]); w.y = pk_bf16(o[2], o[3]);
        *(u32x2*)(MIX + (size_t)(tok0 + tk) * DM + 512 + c4) = w;
    }
}

DEVI void mixer_phase(const Ctx& p, int l, volatile LAS int* s_unit, int slot) {
    const int NU = 672;
    const int nq = gridDim.x >= 8 ? 8 : 1, q = blockIdx.x % nq;
    unsigned* ctr = (unsigned*)(p.ws + OFF_CTRL) + 4096 + 64 * (slot * 8 + q);
    const int base = (int)gridDim.x < NU ? (int)gridDim.x : NU;
    bool first = true;
    for (;;) {
        int u;
        if (first) { u = blockIdx.x; first = false; if (u >= NU) break; }
        else {
            __syncthreads();
            if (threadIdx.x == 0) *s_unit = base + (int)atomicAdd(ctr, 1u) * nq + q;
            __syncthreads();
            u = *s_unit;
            if (u >= NU) break;
        }
#ifdef MIX_LO
        if (slot >= 2 && (u < MIX_LO || u >= MIX_HI)) continue;
#endif
        if (u < 64) attn_unit(p, l, 3, u);
        else if (u < 128) attn_unit(p, l, 5, u - 64);
        else if (u < 192) attn_unit(p, l, 2, u - 128);
        else if (u < 288) scan_unit(p, l, u - 192);
        else if (u < 416) attn_unit(p, l, 4, u - 288);
        else if (u < 544) attn_unit(p, l, 0, u - 416);
        else attn_unit(p, l, 1, u - 544);
    }
}

__global__ void __launch_bounds__(512, 2) fwd_megakernel(Params P, int ph_lo, int ph_hi) {
    __shared__ uint4 s_ctl[2];
    if (threadIdx.x == 0) {
        s_ctl[0] = make_uint4(0u, 0u, 0u, 0u); s_ctl[1] = make_uint4(0u, 0u, 0u, 0u);
        const float** tabw = (const float**)(P.ws + OFF_TAB) + (size_t)blockIdx.x * 64;
#pragma unroll
        for (int i = 0; i < N_IN; ++i) tabw[i] = P.in[i];
        __threadfence();
    }
    __syncthreads();
    if (P.never) cg::this_grid().sync();
    XcdBarrier xb;
    const bool multi = (ph_hi - ph_lo) > 1;
    if (multi) xb = xcd_barrier_post((unsigned*)(P.ws + OFF_CTRL), (volatile LAS unsigned*)&s_ctl[0]);
    volatile LAS int* s_unit = (volatile LAS int*)&s_ctl[1];
#ifndef PH_MASK
#define PH_MASK 63
#endif
#ifndef DUP_MASK
#define DUP_MASK 0
#endif
    for (int ph2 = ph_lo * 2; ph2 < ph_hi * 2; ++ph2) {
        const int ph = ph2 >> 1, rep = ph2 & 1;
        if (rep) {
            const int kk = (ph >= 1 && ph < 23) ? (ph - 1) % 11 : -1;
            const bool dup = (ph == 0) ? (DUP_MASK & 1) : (ph == 23 || kk == 0 || kk == 3 || kk == 8) ? (DUP_MASK & 2) : (kk == 5) ? (DUP_MASK & 4) : (kk == 6) ? (DUP_MASK & 8) : (kk == 1 || kk == 2 || kk == 4 || kk == 7 || kk == 9 || kk == 10) ? (DUP_MASK & 16) : false;
            if (!dup) continue;
        }
        if (ph2 > ph_lo * 2) xcd_barrier(xb);
        Ctx p;
        p.ws = P.ws; p.out = P.out; p.in = (const float* const*)(P.ws + OFF_TAB) + (size_t)blockIdx.x * 64;
        asm volatile("" : "+s"(p.ws), "+s"(p.out), "+s"(p.in) :: "memory");
        if (ph == 0) { if (PH_MASK & 1) prologue_phase(p); continue; }
        if (ph == 23) { if (PH_MASK & 2) norm_phase(p, 1, 4, rep); continue; }
        const int l = (ph - 1) / 11, k = (ph - 1) % 11;
        const unsigned char* wl = p.ws + OFF_W + (size_t)l * W_LAYER;
        if (k == 0 || k == 3 || k == 8) { if (PH_MASK & 2) norm_phase(p, l, k == 0 ? 1 : (k == 3 ? 2 : 3), rep); }
        else if (k == 5) { if (PH_MASK & 4) prep_phase(p, l); }
        else if (k == 6) { if (PH_MASK & 8) mixer_phase(p, l, s_unit, l + 2 * rep); }
        else if (PH_MASK & 16) {
            GemmDesc g;
            g.nM = NTOK / 256;
            if (k == 1 || k == 9) { g.A = (const bf16_t*)(p.ws + OFF_H); g.Bt = (const bf16_t*)(wl + (k == 1 ? WL_GU1 : WL_GU2)); g.K = 1024; g.nN = 22; g.S = 1; g.nt = 16; g.epi = EPI_GU; g.out = p.ws + OFF_ACT; }
            else if (k == 2 || k == 10) { g.A = (const bf16_t*)(p.ws + OFF_ACT); g.Bt = (const bf16_t*)(wl + (k == 2 ? WL_D1 : WL_D2)); g.K = 2816; g.nN = 4; g.S = 2; g.nt = 22; g.epi = EPI_PART; g.out = p.ws + OFF_U; }
            else if (k == 4) { g.A = (const bf16_t*)(p.ws + OFF_H); g.Bt = (const bf16_t*)(wl + WL_IN); g.K = 1024; g.nN = 10; g.S = 1; g.nt = 16; g.epi = EPI_U; g.out = p.ws + OFF_U; }
            else { g.A = (const bf16_t*)(p.ws + OFF_MIX); g.Bt = (const bf16_t*)(wl + WL_OUT); g.K = 1024; g.nN = 4; g.S = 2; g.nt = 8; g.epi = EPI_PART; g.out = p.ws + OFF_U; }
            gemm_phase(g);
            if (rep == 0 && gridDim.x == 256) {
                int lo = CONV_C0, per = 0;
                for (int q = 1; q <= ph; ++q) {
                    const int kq = (q - 1) % 11;
                    const int sup = (kq == 1 || kq == 9) ? 480 : (kq == 2 || kq == 10) ? 192 : (kq == 4) ? 32 : (kq == 7) ? 64 : 0;
                    if (q < ph) lo += sup; else per = (kq == 1 || kq == 9) ? 2 : (kq == 2 || kq == 10) ? 3 : (kq == 4) ? 2 : 1;
                }
                const int Ug = g.nM * g.nN * g.S, nfull = Ug % (int)gridDim.x;
                if (nfull != 0 && (int)blockIdx.x >= nfull && lo < NTR_UNITS) {
                    const int nidle = (int)gridDim.x - nfull;
                    int hi = lo + per * nidle; if (hi > NTR_UNITS) hi = NTR_UNITS;
                    convert_fill(p, lo, hi, (int)blockIdx.x - nfull, nidle, per);
                }
            }
        }
    }
}

extern "C" void kernel_launch(void* const* d_in, const int* in_sizes, int n_in, void* d_out, int out_size, void* d_ws, size_t ws_size, hipStream_t stream) {
    Params p{};
    for (int i = 0; i < N_IN; ++i) p.in[i] = (const float*)d_in[i];
    p.out = (float*)d_out;
    p.ws = (unsigned char*)d_ws;
    p.never = 0; p.pad = 0;
    static int grid_blocks = 0;
    if (!grid_blocks) {
        (void)hipFuncSetAttribute((const void*)fwd_megakernel, hipFuncAttributeMaxDynamicSharedMemorySize, SHM_BYTES);
        int dev = 0, cus = 0, per_cu = 0;
        (void)hipGetDevice(&dev);
        (void)hipDeviceGetAttribute(&cus, hipDeviceAttributeMultiprocessorCount, dev);
        (void)hipOccupancyMaxActiveBlocksPerMultiprocessor(&per_cu, fwd_megakernel, 512, SHM_BYTES);
        if (per_cu < 1) fprintf(stderr, "occupancy query returned %d\n", per_cu);
        grid_blocks = cus;
    }
    (void)hipMemsetAsync(d_ws, 0, CTRL_BYTES, stream);
#if MK_MULTI
    for (int ph = 0; ph < NPHASE; ++ph)
        fwd_megakernel<<<dim3(grid_blocks), dim3(512), SHM_BYTES, stream>>>(p, ph, ph + 1);
#else
    int lo = 0, hi = NPHASE;
    void* args[] = {&p, &lo, &hi};
    hipError_t e = hipLaunchCooperativeKernel((const void*)fwd_megakernel, dim3(grid_blocks), dim3(512), args, SHM_BYTES, stream);
    if (e != hipSuccess) fprintf(stderr, "cooperative launch failed: %s (grid %d)\n", hipGetErrorString(e), grid_blocks);
#endif
}
```

```cpp
#include <hip/hip_runtime.h>
#include <hip/hip_cooperative_groups.h>
#include <cstdint>
#include <cstdio>
namespace cg = cooperative_groups;

#ifndef MK_MULTI
#define MK_MULTI 0
#endif

#define DEVI __device__ __forceinline__
#define LAS __attribute__((address_space(3)))

typedef unsigned short bf16_t;
typedef short bf16x8 __attribute__((ext_vector_type(8)));
typedef float f32x4 __attribute__((ext_vector_type(4)));
typedef float f32x2 __attribute__((ext_vector_type(2)));
typedef unsigned u32x4 __attribute__((ext_vector_type(4)));
typedef unsigned u32x2 __attribute__((ext_vector_type(2)));

constexpr int NTOK = 6144, NCTX = 4096, DM = 1024, DFF = 2816, INW = 2560;
constexpr int NKROW = 7168;
constexpr float LOG2E = 1.4426950408889634f;

enum { I_XP = 0, I_XS, I_CAK, I_CAV, I_CBK, I_CBV, I_SC, I_SD, I_C, I_CCTX, I_N1, I_N2, I_N3, I_WMOD, I_BMOD,
       I_F1G, I_F1U, I_F1D, I_F2G, I_F2U, I_F2D, I_WIN, I_WOUT, I_AQN, I_AKN, I_ASINK, I_BQN, I_BKN,
       I_CCW, I_CCB, I_CWA, I_CBA, I_CWX, I_CBX, I_CLAM, I_DTH, I_DNG, N_IN };

constexpr size_t O_YP = 0, O_YS = 4194304, O_CAK = 6291456, O_CAV = 7340032, O_CBK = 8388608, O_CBV = 9437184,
                 O_SC = 10485760, O_SD = 10502144;

constexpr size_t OFF_CTRL = 0;
constexpr size_t CTRL_BYTES = 65536;
constexpr size_t OFF_TAB = CTRL_BYTES;
constexpr size_t OFF_MOD = OFF_TAB + 131072;
constexpr size_t OFF_W = OFF_MOD + 262144;
constexpr size_t W_GU = (size_t)5632 * 1024 * 2, W_D = (size_t)1024 * 2816 * 2, W_IN = (size_t)2560 * 1024 * 2, W_OUT = (size_t)1024 * 1024 * 2;
constexpr size_t WL_GU1 = 0, WL_D1 = WL_GU1 + W_GU, WL_IN = WL_D1 + W_D, WL_OUT = WL_IN + W_IN, WL_GU2 = WL_OUT + W_OUT, WL_D2 = WL_GU2 + W_GU, W_LAYER = WL_D2 + W_D;
constexpr size_t OFF_H = OFF_W + 2 * W_LAYER;
constexpr size_t OFF_ACT = OFF_H + (size_t)NTOK * 1024 * 2;
constexpr size_t OFF_U = OFF_ACT + (size_t)NTOK * 2816 * 2;
constexpr size_t OFF_MIX = OFF_U + (size_t)NTOK * 2560 * 4;
constexpr size_t OFF_QA = OFF_MIX + (size_t)NTOK * 1024 * 2;
constexpr size_t OFF_QB = OFF_QA + (size_t)NTOK * 256 * 2;
constexpr size_t OFF_KA = OFF_QB + (size_t)NTOK * 256 * 2;
constexpr size_t OFF_VA = OFF_KA + (size_t)NKROW * 128 * 2;
constexpr size_t OFF_KB = OFF_VA + (size_t)NKROW * 128 * 2;
constexpr size_t OFF_VB = OFF_KB + (size_t)NKROW * 128 * 2;
constexpr size_t OFF_DQ = OFF_VB + (size_t)NKROW * 128 * 2;
constexpr size_t OFF_DK = OFF_DQ + (size_t)NTOK * 256 * 2;
constexpr size_t OFF_DV = OFF_DK + (size_t)NTOK * 256 * 2;
constexpr size_t OFF_CA = OFF_DV + (size_t)NTOK * 256 * 2;
constexpr size_t OFF_CB = OFF_CA + (size_t)2 * NTOK * 256 * 4;
constexpr size_t OFF_HF = OFF_CB + (size_t)2 * NTOK * 256 * 4;
constexpr size_t OFF_TA = OFF_HF + (size_t)2 * NTOK * 256 * 4;
constexpr size_t OFF_TB = OFF_TA + (size_t)2 * 96 * 256 * 4;
constexpr size_t OFF_CWT = OFF_TB + (size_t)2 * 96 * 256 * 4;
constexpr size_t OFF_XB = OFF_CWT + (size_t)2 * 4 * 4 * 4096 * 2;
constexpr size_t WS_TOTAL = OFF_XB + (size_t)NTOK * 1024 * 2;
static_assert(WS_TOTAL < (size_t)300 * 1024 * 1024, "workspace too large");

constexpr int SHM_BYTES = 131072;
constexpr int NPHASE = 24;

struct Params {
    const float* in[N_IN];
    float* out;
    unsigned char* ws;
    int never;
    int pad;
};

struct Ctx { const float* const* in; float* out; unsigned char* ws; };

extern __shared__ __attribute__((aligned(16))) bf16_t shm[];

DEVI unsigned pk_bf16(float lo, float hi) { unsigned r; asm("v_cvt_pk_bf16_f32 %0, %1, %2" : "=v"(r) : "v"(lo), "v"(hi)); return r; }
DEVI bf16_t to_bf16(float x) { return (bf16_t)(pk_bf16(x, 0.f) & 0xffffu); }
DEVI f32x4 ldb4(const bf16_t* p) {
    const u32x2 w = *(const u32x2*)p; f32x4 r;
    r[0] = __builtin_bit_cast(float, w.x << 16); r[1] = __builtin_bit_cast(float, w.x & 0xffff0000u);
    r[2] = __builtin_bit_cast(float, w.y << 16); r[3] = __builtin_bit_cast(float, w.y & 0xffff0000u);
    return r;
}
DEVI float wave_sum(float v) {
#pragma unroll
    for (int o = 32; o > 0; o >>= 1) v += __shfl_xor(v, o);
    return v;
}
DEVI int opaque_tid() { int t = threadIdx.x; asm volatile("" : "+v"(t)); return t; }
DEVI float fexp2(float x) { return __builtin_amdgcn_exp2f(x); }
DEVI float sigmoidf_(float x) { return __builtin_amdgcn_rcpf(1.f + __expf(-x)); }
DEVI float siluf_(float x) { return x * sigmoidf_(x); }

#define XB_TMO      128
#define XB_XCNT(j)  (256  + 64 * (j))
#define XB_XSUB(j)  (1280 + 64 * (j))
#define XB_XGEN(j)  (2304 + 64 * (j))
#define XB_TOP      3328
#define XB_TOPGEN   3392
#define XCD_BAR_WORDS 3456
#define XB_SPIN_CAP (1u << 20)
DEVI unsigned xb_ld(unsigned* p) { return __hip_atomic_load(p, __ATOMIC_RELAXED, __HIP_MEMORY_SCOPE_AGENT); }
DEVI unsigned xb_add(unsigned* p, unsigned v) { return __hip_atomic_fetch_add(p, v, __ATOMIC_RELAXED, __HIP_MEMORY_SCOPE_AGENT); }
DEVI unsigned xb_xcc_id() { return (unsigned)__builtin_amdgcn_s_getreg((3 << 11) | 20) & 0xFu; }
#define XB_SPIN(cond, bar) do { unsigned _sp = 0; while (cond) { __builtin_amdgcn_s_sleep(1); \
    if ((++_sp & 255u) == 0u) { if (xb_ld(&(bar)[XB_TMO])) break; if (_sp > XB_SPIN_CAP) { atomicAdd(&(bar)[XB_TMO], 1u); break; } } } } while (0)
struct XcdBarrier { unsigned* bar; unsigned x; volatile LAS unsigned* st; };
DEVI XcdBarrier xcd_barrier_post(unsigned* bar, volatile LAS unsigned* st) {
    XcdBarrier b; b.bar = bar; b.x = xb_xcc_id(); b.st = st;
    if (threadIdx.x == 0) (void)xb_add(&bar[XB_XCNT(b.x)], 1u);
    return b;
}
DEVI void xcd_barrier_complete(unsigned* bar, unsigned x, unsigned& nloc, unsigned& nx) {
    const unsigned G = gridDim.x * gridDim.y * gridDim.z;
    unsigned sum, cnt, mine, sp = 0u;
    for (;;) {
        sum = 0u; cnt = 0u; mine = 0u;
#pragma unroll
        for (unsigned j = 0; j < 16; ++j) { const unsigned c = xb_ld(&bar[XB_XCNT(j)]); sum += c; cnt += (c > 0u) ? 1u : 0u; mine = (j == x) ? c : mine; }
        if (sum == G) break;
        __builtin_amdgcn_s_sleep(1);
        if ((++sp & 255u) == 0u) { if (xb_ld(&bar[XB_TMO])) break; if (sp > XB_SPIN_CAP) { atomicAdd(&bar[XB_TMO], 1u); break; } }
    }
    nloc = mine > 0u ? mine : 1u; nx = cnt > 0u ? cnt : 1u;
}
DEVI void xcd_barrier(const XcdBarrier& b) {
    asm volatile("s_waitcnt vmcnt(0)" ::: "memory");
    __syncthreads();
    if (threadIdx.x == 0) {
        unsigned* bar = b.bar;
        asm volatile("" : "+s"(bar));
        __builtin_amdgcn_s_waitcnt(0);
        unsigned nloc = b.st[0], nx = b.st[1];
        if (nloc == 0u) { xcd_barrier_complete(bar, b.x, nloc, nx); b.st[0] = nloc; b.st[1] = nx; }
        const unsigned old = xb_add(&bar[XB_XSUB(b.x)], 1u);
        const unsigned gen = old / nloc;
        if (old + 1u == (gen + 1u) * nloc) {
            __builtin_amdgcn_fence(__ATOMIC_RELEASE, "agent");
            asm volatile("s_waitcnt vmcnt(0)" ::: "memory");
            const unsigned og = xb_add(&bar[XB_TOP], 1u);
            const unsigned tg = og / nx;
            if (og + 1u == (tg + 1u) * nx) xb_add(&bar[XB_TOPGEN], 1u);
            else XB_SPIN(xb_ld(&bar[XB_TOPGEN]) == tg, bar);
            __builtin_amdgcn_fence(__ATOMIC_ACQUIRE, "agent");
            xb_add(&bar[XB_XGEN(b.x)], 1u);
            asm volatile("s_waitcnt vmcnt(0)" ::: "memory");
        } else {
            XB_SPIN(xb_ld(&bar[XB_XGEN(b.x)]) == gen, bar);
            __builtin_amdgcn_fence(__ATOMIC_ACQUIRE, "agent");
            asm volatile("s_waitcnt vmcnt(0)" ::: "memory");
        }
    }
    __syncthreads();
}

constexpr int BM = 256, BK = 64, HALF = 128, HTB = HALF * BK * 2;
DEVI int lds_byte(int r, int c) { const int st = (r >> 4) * 2 + (c >> 5), rr = r & 15, cc = c & 31, ob = rr * 64 + cc * 2; return st * 1024 + (ob ^ (((ob >> 9) & 1) << 5)); }
DEVI void stage_rc(int b, int& R, int& C) { const int st = b / 1024, sb = b % 1024, swz = sb ^ (((sb >> 9) & 1) << 5); R = (st >> 1) * 16 + swz / 64; C = (st & 1) * 32 + (swz % 64) / 2; }

enum { EPI_GU = 0, EPI_PART = 1, EPI_U = 2 };
struct GemmDesc { const bf16_t* A; const bf16_t* Bt; int K; int nM, nN, S, nt; int epi; void* out; };
struct Unit { int pm, pn, ks; };

DEVI bool gemm_next(const GemmDesc& g, int i, Unit& u) {
    const int nwg = g.nM * g.nN;
    const long L = (long)i * gridDim.x + blockIdx.x;
    if (L >= (long)nwg * g.S) return false;
    u.ks = (int)(L / nwg);
    int wgid = (int)(L % nwg);
    { const int q = nwg / 8, r = nwg % 8, xcd = wgid % 8, off = wgid / 8; wgid = (xcd < r ? xcd * (q + 1) : r * (q + 1) + (xcd - r) * q) + off; }
    const int WGM = 4;
    const int nig = WGM * g.nN, gid = wgid / nig, fm = gid * WGM, gsz = (g.nM - fm) < WGM ? (g.nM - fm) : WGM;
    u.pm = fm + ((wgid % nig) % gsz); u.pn = (wgid % nig) / gsz;
    return true;
}

DEVI void gemm_epilogue(const GemmDesc& g, const f32x4 (&acc)[2][2][4][2], const Unit& u, int wr, int wc, int fr, int fq) {
    const int brow = u.pm * BM, bcol = u.pn * BM;
    if (g.epi == EPI_GU) {
        bf16_t* act = (bf16_t*)g.out;
#pragma unroll
        for (int ai = 0; ai < 2; ++ai)
#pragma unroll
            for (int m = 0; m < 4; ++m) {
                const int row = brow + ai * HALF + wr * 64 + m * 16 + fr;
                const int hcol = u.pn * 128 + wc * 32 + fq * 8;
                u32x4 w;
                { const f32x4 gt = acc[ai][0][m][0], up = acc[ai][1][m][0];
                  w.x = pk_bf16(siluf_(gt[0]) * up[0], siluf_(gt[1]) * up[1]); w.y = pk_bf16(siluf_(gt[2]) * up[2], siluf_(gt[3]) * up[3]); }
                { const f32x4 gt = acc[ai][0][m][1], up = acc[ai][1][m][1];
                  w.z = pk_bf16(siluf_(gt[0]) * up[0], siluf_(gt[1]) * up[1]); w.w = pk_bf16(siluf_(gt[2]) * up[2], siluf_(gt[3]) * up[3]); }
                *(u32x4*)(act + (size_t)row * DFF + hcol) = w;
            }
    } else if (g.epi == EPI_PART) {
        bf16_t* o = (bf16_t*)g.out + (size_t)u.ks * NTOK * DM;
#pragma unroll
        for (int ai = 0; ai < 2; ++ai)
#pragma unroll
            for (int m = 0; m < 4; ++m) {
                const int row = brow + ai * HALF + wr * 64 + m * 16 + fr;
#pragma unroll
                for (int bj = 0; bj < 2; ++bj) {
                    const int col = bcol + bj * HALF + wc * 32 + fq * 8;
                    const f32x4 v0 = acc[ai][bj][m][0], v1 = acc[ai][bj][m][1];
                    u32x4 w; w.x = pk_bf16(v0[0], v0[1]); w.y = pk_bf16(v0[2], v0[3]); w.z = pk_bf16(v1[0], v1[1]); w.w = pk_bf16(v1[2], v1[3]);
                    *(u32x4*)(o + (size_t)row * DM + col) = w;
                }
            }
    } else {
        bf16_t* o = (bf16_t*)g.out;
#pragma unroll
        for (int ai = 0; ai < 2; ++ai)
#pragma unroll
            for (int m = 0; m < 4; ++m) {
                const int row = brow + ai * HALF + wr * 64 + m * 16 + fr;
#pragma unroll
                for (int bj = 0; bj < 2; ++bj) {
                    const int col = bcol + bj * HALF + wc * 32 + fq * 8;
                    const f32x4 v0 = acc[ai][bj][m][0], v1 = acc[ai][bj][m][1];
                    u32x4 w; w.x = pk_bf16(v0[0], v0[1]); w.y = pk_bf16(v0[2], v0[3]); w.z = pk_bf16(v1[0], v1[1]); w.w = pk_bf16(v1[2], v1[3]);
                    *(u32x4*)(o + (size_t)row * INW + col) = w;
                }
            }
    }
}

DEVI void gemm_phase(const GemmDesc g) {
    LAS unsigned char* lds = (LAS unsigned char*)shm;
    const int tid = opaque_tid(), wid = __builtin_amdgcn_readfirstlane(tid >> 6), lane = tid & 63, wr = wid >> 2, wc = wid & 3, fr = lane & 15, fq = lane >> 4;
    const int K = g.K, nt = g.nt;
    unsigned voffA[2], voffB[2];
#pragma unroll
    for (int i = 0; i < 2; ++i) { int R, C; stage_rc(tid * 16 + i * 8192, R, C); voffA[i] = (unsigned)(R * K + C) * 2u;
        const int rho = R & 31, pr = 8 * ((rho & 15) >> 2) + 4 * (rho >> 4) + (rho & 3); voffB[i] = (unsigned)(((R & ~31) + pr) * K + C) * 2u; }
    const size_t kstep = (size_t)(BK * 2);
    const size_t hstep = (size_t)HALF * K * 2;
    const size_t tstep = 2 * hstep;
    const size_t sstep = (size_t)nt * kstep;
    const unsigned ldsw = (unsigned)wid * 1024u;
    const int aoff = lds_byte(wr * 64 + fr, fq * 8), boff = lds_byte(wc * 32 + fr, fq * 8);
#define PG8_SA(b, h) (((b) * 2 + (h)) * HTB)
#define PG8_SB(b, h) ((4 + (b) * 2 + (h)) * HTB)
#define PG8_STAGE(bufoff, gbase, voff) do { _Pragma("unroll") for (int _i = 0; _i < 2; ++_i) \
        __builtin_amdgcn_global_load_lds((const unsigned*)((const char*)(gbase) + (voff)[_i]), (LAS unsigned*)(lds + (bufoff) + ldsw + _i * 8192), 16, 0, 0); } while (0)
#define PG8_LDA(dst, b, h) do { _Pragma("unroll") for (int m = 0; m < 4; ++m) _Pragma("unroll") for (int k = 0; k < 2; ++k) dst[m][k] = *(const LAS bf16x8*)(lds + PG8_SA(b, h) + aoff + m * 2048 + k * 1024); } while (0)
#define PG8_LDB(dst, b, h) do { _Pragma("unroll") for (int n = 0; n < 2; ++n) _Pragma("unroll") for (int k = 0; k < 2; ++k) dst[n][k] = *(const LAS bf16x8*)(lds + PG8_SB(b, h) + boff + n * 2048 + k * 1024); } while (0)
#define PG8_MMA(ai, bj, At, Bt) do { __builtin_amdgcn_s_setprio(1); _Pragma("unroll") for (int m = 0; m < 4; ++m) _Pragma("unroll") for (int n = 0; n < 2; ++n) _Pragma("unroll") for (int k = 0; k < 2; ++k) \
        acc[ai][bj][m][n] = __builtin_amdgcn_mfma_f32_16x16x32_bf16(Bt[n][k], At[m][k], acc[ai][bj][m][n], 0, 0, 0); __builtin_amdgcn_s_setprio(0); } while (0)
#define PG8_WAIT_V(n) asm volatile("s_waitcnt vmcnt(" #n ")" ::: "memory")
#define PG8_WAIT_L(n) asm volatile("s_waitcnt lgkmcnt(" #n ")" ::: "memory")
#define PG8_BAR __builtin_amdgcn_s_barrier()
#define PG8_SCHED __builtin_amdgcn_sched_barrier(0)
    Unit cur, nxt; int ui = 0;
    if (!gemm_next(g, 0, cur)) return;
    f32x4 acc[2][2][4][2];
#pragma unroll
    for (int a = 0; a < 2; ++a)
#pragma unroll
        for (int b = 0; b < 2; ++b)
#pragma unroll
            for (int m = 0; m < 4; ++m)
#pragma unroll
                for (int n = 0; n < 2; ++n) acc[a][b][m][n] = (f32x4){0.f, 0.f, 0.f, 0.f};
    bf16x8 At[4][2], B0[2][2], B1[2][2];
    const char* cA = (const char*)g.A + (size_t)cur.pm * tstep + (size_t)cur.ks * sstep;
    const char* cB = (const char*)g.Bt + (size_t)cur.pn * tstep + (size_t)cur.ks * sstep;
    PG8_STAGE(PG8_SB(0, 0), cB, voffB); PG8_STAGE(PG8_SB(0, 1), cB + hstep, voffB); PG8_STAGE(PG8_SA(0, 0), cA, voffA); PG8_STAGE(PG8_SA(0, 1), cA + hstep, voffA);
    if (wr == 1) PG8_BAR;
    PG8_WAIT_V(2); PG8_BAR;
    PG8_STAGE(PG8_SB(1, 0), cB + kstep, voffB); PG8_STAGE(PG8_SA(1, 0), cA + kstep, voffA); PG8_STAGE(PG8_SB(1, 1), cB + hstep + kstep, voffB);
    PG8_WAIT_V(6); PG8_BAR;
    for (;;) {
        const bool has_next = gemm_next(g, ui + 1, nxt);
        const char* nA = has_next ? (const char*)g.A + (size_t)nxt.pm * tstep + (size_t)nxt.ks * sstep : cA;
        const char* nB = has_next ? (const char*)g.Bt + (size_t)nxt.pn * tstep + (size_t)nxt.ks * sstep : cB;
        for (int t = 0; t < nt; t += 2) {
            const bool last = (t == nt - 2);
            const char* a1 = cA + (size_t)(t + 1) * kstep;
            const char* a2 = last ? nA : cA + (size_t)(t + 2) * kstep; const char* b2 = last ? nB : cB + (size_t)(t + 2) * kstep;
            const char* a3 = a2 + kstep; const char* b3 = b2 + kstep;
            PG8_LDB(B0, 0, 0); PG8_LDB(B1, 0, 1); PG8_SCHED; PG8_LDA(At, 0, 0); PG8_STAGE(PG8_SA(1, 1), a1 + hstep, voffA);
            PG8_WAIT_V(8); PG8_WAIT_L(0); PG8_BAR; PG8_MMA(0, 0, At, B0); PG8_MMA(0, 1, At, B1); PG8_BAR; PG8_SCHED;
            PG8_LDA(At, 0, 1); PG8_STAGE(PG8_SB(0, 0), b2, voffB); PG8_STAGE(PG8_SB(0, 1), b2 + hstep, voffB); PG8_STAGE(PG8_SA(0, 0), a2, voffA);
            PG8_WAIT_V(8); PG8_WAIT_L(0); PG8_BAR; PG8_MMA(1, 0, At, B0); PG8_MMA(1, 1, At, B1); PG8_BAR; PG8_SCHED;
            PG8_LDB(B0, 1, 0); PG8_LDB(B1, 1, 1); PG8_SCHED; PG8_LDA(At, 1, 0); PG8_STAGE(PG8_SA(0, 1), a2 + hstep, voffA);
            PG8_WAIT_V(8); PG8_WAIT_L(0); PG8_BAR; PG8_MMA(0, 0, At, B0); PG8_MMA(0, 1, At, B1); PG8_BAR; PG8_SCHED;
            PG8_LDA(At, 1, 1); PG8_STAGE(PG8_SB(1, 0), b3, voffB); PG8_STAGE(PG8_SB(1, 1), b3 + hstep, voffB); PG8_STAGE(PG8_SA(1, 0), a3, voffA);
            PG8_WAIT_V(8); PG8_WAIT_L(0); PG8_BAR; PG8_MMA(1, 0, At, B0); PG8_MMA(1, 1, At, B1); PG8_BAR; PG8_SCHED;
        }
        if (wr == 0) PG8_BAR;
        gemm_epilogue(g, acc, cur, wr, wc, fr, fq);
        if (!has_next) break;
#pragma unroll
        for (int a = 0; a < 2; ++a)
#pragma unroll
            for (int b = 0; b < 2; ++b)
#pragma unroll
                for (int m = 0; m < 4; ++m)
#pragma unroll
                    for (int n = 0; n < 2; ++n) acc[a][b][m][n] = (f32x4){0.f, 0.f, 0.f, 0.f};
        cur = nxt; cA = nA; cB = nB; ++ui;
        if (wr == 1) PG8_BAR;
    }
    PG8_WAIT_V(0);
    PG8_BAR;
#undef PG8_SA
#undef PG8_SB
#undef PG8_STAGE
#undef PG8_LDA
#undef PG8_LDB
#undef PG8_MMA
#undef PG8_WAIT_V
#undef PG8_WAIT_L
#undef PG8_BAR
#undef PG8_SCHED
}

constexpr int NTR_UNITS = 2560;
constexpr int CONV_C0 = 352;
DEVI void transpose_unit(const Ctx& p, int tu, int t, float* fs) {
    const int l = tu / 1280, r = tu % 1280;
    int which, loc, K, N, mode; size_t dsto;
    if (r < 176)       { which = I_F1G;  loc = r;        K = 1024; N = 2816; mode = 1; dsto = WL_GU1; }
    else if (r < 352)  { which = I_F1U;  loc = r - 176;  K = 1024; N = 2816; mode = 2; dsto = WL_GU1; }
    else if (r < 528)  { which = I_F1D;  loc = r - 352;  K = 2816; N = 1024; mode = 0; dsto = WL_D1; }
    else if (r < 688)  { which = I_WIN;  loc = r - 528;  K = 1024; N = 2560; mode = 0; dsto = WL_IN; }
    else if (r < 752)  { which = I_WOUT; loc = r - 688;  K = 1024; N = 1024; mode = 0; dsto = WL_OUT; }
    else if (r < 928)  { which = I_F2G;  loc = r - 752;  K = 1024; N = 2816; mode = 1; dsto = WL_GU2; }
    else if (r < 1104) { which = I_F2U;  loc = r - 928;  K = 1024; N = 2816; mode = 2; dsto = WL_GU2; }
    else               { which = I_F2D;  loc = r - 1104; K = 2816; N = 1024; mode = 0; dsto = WL_D2; }
    const int nnt = N / 256, kt = loc / nnt, ntile = loc % nnt;
    const float* src = p.in[which] + (size_t)l * K * N + (size_t)kt * 64 * N + ntile * 256;
    bf16_t* dst = (bf16_t*)(p.ws + OFF_W + (size_t)l * W_LAYER + dsto);
    f32x4 v[8];
#pragma unroll
    for (int i = 0; i < 8; ++i) { const int idx = i * 512 + t; v[i] = *(const f32x4*)(src + (size_t)(idx >> 6) * N + (idx & 63) * 4); }
#pragma unroll
    for (int i = 0; i < 8; ++i) { const int idx = i * 512 + t; *(f32x4*)(fs + (idx >> 6) * 260 + (idx & 63) * 4) = v[i]; }
    __syncthreads();
    const int nl = t & 255, kh = t >> 8;
    int drow;
    if (mode == 0) drow = ntile * 256 + nl;
    else drow = (2 * ntile + (nl >> 7)) * 256 + (nl & 127) + (mode == 2 ? 128 : 0);
    bf16_t* dp = dst + (size_t)drow * K + kt * 64 + kh * 32;
#pragma unroll
    for (int c = 0; c < 4; ++c) {
        u32x4 w;
        const float* f = fs + (kh * 32 + c * 8) * 260 + nl;
        w.x = pk_bf16(f[0], f[260]); w.y = pk_bf16(f[2 * 260], f[3 * 260]); w.z = pk_bf16(f[4 * 260], f[5 * 260]); w.w = pk_bf16(f[6 * 260], f[7 * 260]);
        *(u32x4*)(dp + c * 8) = w;
    }
}

DEVI void convert_fill(const Ctx& p, int lo, int hi, int rank, int nrank, int per) {
    const int t = opaque_tid();
    float* fs = (float*)shm;
    for (int i = 0; i < per; ++i) {
        const int tu = lo + rank + i * nrank;
        if (tu >= hi) break;
        __syncthreads();
        transpose_unit(p, tu, t, fs);
    }
}

DEVI void prologue_phase(const Ctx& p) {
    const int t = opaque_tid();
    float* fs = (float*)shm;
    float* mod = (float*)(p.ws + OFF_MOD);
    const int NMOD = 288, NCW = 32, NTR = (gridDim.x == 256) ? CONV_C0 : NTR_UNITS;
    if (gridDim.x == 256) {
        if (blockIdx.x >= 64)
            for (int tu = (int)blockIdx.x - 64; tu < NTR; tu += 192) { __syncthreads(); transpose_unit(p, tu, t, fs); }
    } else {
        for (int tu = blockIdx.x; tu < NTR; tu += gridDim.x) { __syncthreads(); transpose_unit(p, tu, t, fs); }
    }
    for (int u = blockIdx.x; u < NMOD + NCW; u += gridDim.x) {
        __syncthreads();
        if (u >= NMOD && u < NMOD + NCW) {
            const int mi = u - NMOD, l = mi >> 4, m = (mi >> 2) & 3, g = mi & 3, dir = m >> 1;
            const float* w = ((m & 1) ? p.in[I_CWX] : p.in[I_CWA]) + (((size_t)l * 2 + dir) * 4 + g) * 4096;
            bf16_t* wt = (bf16_t*)(p.ws + OFF_CWT) + (((size_t)l * 4 + m) * 4 + g) * 4096;
            const int d = t >> 3, c8 = (t & 7) * 8;
            u32x4 o;
            o.x = pk_bf16(w[(c8 + 0) * 64 + d], w[(c8 + 1) * 64 + d]); o.y = pk_bf16(w[(c8 + 2) * 64 + d], w[(c8 + 3) * 64 + d]);
            o.z = pk_bf16(w[(c8 + 4) * 64 + d], w[(c8 + 5) * 64 + d]); o.w = pk_bf16(w[(c8 + 6) * 64 + d], w[(c8 + 7) * 64 + d]);
            *(u32x4*)(wt + d * 64 + c8) = o;
        } else if (u < NMOD) {
            const int l = u / 144, jb = u % 144;
            for (int i = t; i < 3072; i += 512) {
                const int r = i >> 10, k = i & 1023;
                const float c = (r == 0) ? p.in[I_CCTX][k] : p.in[I_C][(r - 1) * 1024 + k];
                fs[i] = c / (1.f + __expf(-c));
            }
            __syncthreads();
            const int cgp = t & 15, kg = t >> 4;
            const float* w = p.in[I_WMOD] + ((size_t)l * 1024 + kg * 32) * 9216 + jb * 64 + cgp * 4;
            f32x4 a0 = {0, 0, 0, 0}, a1 = {0, 0, 0, 0}, a2 = {0, 0, 0, 0};
#pragma unroll 8
            for (int k = 0; k < 32; ++k) {
                const f32x4 wv = *(const f32x4*)(w + (size_t)k * 9216);
                const int kk = kg * 32 + k;
                a0 += wv * fs[kk]; a1 += wv * fs[1024 + kk]; a2 += wv * fs[2048 + kk];
            }
            float* red = fs + 3072;
            *(f32x4*)(red + kg * 192 + 0 + cgp * 4) = a0;
            *(f32x4*)(red + kg * 192 + 64 + cgp * 4) = a1;
            *(f32x4*)(red + kg * 192 + 128 + cgp * 4) = a2;
            __syncthreads();
            if (t < 192) {
                float sacc = 0.f;
#pragma unroll 8
                for (int k = 0; k < 32; ++k) sacc += red[k * 192 + t];
                const int r = t >> 6, j = t & 63;
                mod[((size_t)l * 3 + r) * 9216 + jb * 64 + j] = sacc + p.in[I_BMOD][(size_t)l * 9216 + jb * 64 + j];
            }
        } else {
            transpose_unit(p, u - NMOD - NCW, t, fs);
        }
    }
}

DEVI void norm_phase(const Ctx& p, int l, int which, int dry) {
    const int t_ = opaque_tid();
    const int lane = t_ & 63, gw = blockIdx.x * 8 + (t_ >> 6), nw = gridDim.x * 8;
    const float* mod = (const float*)(p.ws + OFF_MOD);
    const bf16_t* P0 = (const bf16_t*)(p.ws + OFF_U);
    const bf16_t* P1 = P0 + (size_t)NTOK * DM;
    bf16_t* H = (bf16_t*)(p.ws + OFF_H);
    bf16_t* XB = (bf16_t*)(p.ws + OFF_XB);
    const bool first = (l == 0 && which == 1);
    int gl, gi; float coef;
    if (which == 1) { gl = l - 1; gi = 8; coef = 0.5f; }
    else if (which == 2) { gl = l; gi = 2; coef = 0.5f; }
    else if (which == 3) { gl = l; gi = 5; coef = 1.0f; }
    else { gl = 1; gi = 8; coef = 0.5f; }
    if (dry) coef = 0.f;
    const float* gn = (which == 1) ? p.in[I_N1] : (which == 2) ? p.in[I_N2] : p.in[I_N3];
    const int shi = (which - 1) * 3, sci = shi + 1;
    for (int tok0 = gw; tok0 < NTOK; tok0 += 3 * nw) {
        f32x4 xv[3][4];
        float ss[3] = {0.f, 0.f, 0.f};
        int rr[3];
        bool ok[3];
        f32x4 g[4], sc[3][4], sh[3][4];
#pragma unroll
        for (int k = 0; k < 3; ++k) {
            const int tok = tok0 + k * nw;
            ok[k] = tok < NTOK;
            const int tk = ok[k] ? tok : tok0;
            rr[k] = tk < NCTX ? 0 : 1 + ((tk - NCTX) >> 10);
            if (which != 4) {
#pragma unroll
                for (int i = 0; i < 4; ++i) {
                    const int c = lane * 4 + i * 256;
                    if (k == 0) g[i] = *(const f32x4*)(gn + (size_t)l * DM + c);
                    sc[k][i] = *(const f32x4*)(mod + ((size_t)l * 3 + rr[k]) * 9216 + sci * 1024 + c);
                    sh[k][i] = *(const f32x4*)(mod + ((size_t)l * 3 + rr[k]) * 9216 + shi * 1024 + c);
                }
            }
            if (first) {
#pragma unroll
                for (int i = 0; i < 4; ++i) {
                    const int c = lane * 4 + i * 256;
                    xv[k][i] = (tk < NCTX) ? *(const f32x4*)(p.in[I_XP] + (size_t)tk * DM + c) : *(const f32x4*)(p.in[I_XS] + (size_t)(tk - NCTX) * DM + c);
                }
            } else {
                u32x2 pa[4], pb[4], xb[4]; f32x4 gv[4];
#pragma unroll
                for (int i = 0; i < 4; ++i) {
                    const int c = lane * 4 + i * 256;
                    xb[i] = *(const u32x2*)(XB + (size_t)tk * DM + c);
                    pa[i] = *(const u32x2*)(P0 + (size_t)tk * DM + c); pb[i] = *(const u32x2*)(P1 + (size_t)tk * DM + c);
                    gv[i] = *(const f32x4*)(mod + ((size_t)gl * 3 + rr[k]) * 9216 + gi * 1024 + c);
                }
#pragma unroll
                for (int i = 0; i < 4; ++i) {
                    f32x4 s2;
                    s2[0] = __builtin_bit_cast(float, pa[i].x << 16) + __builtin_bit_cast(float, pb[i].x << 16);
                    s2[1] = __builtin_bit_cast(float, pa[i].x & 0xffff0000u) + __builtin_bit_cast(float, pb[i].x & 0xffff0000u);
                    s2[2] = __builtin_bit_cast(float, pa[i].y << 16) + __builtin_bit_cast(float, pb[i].y << 16);
                    s2[3] = __builtin_bit_cast(float, pa[i].y & 0xffff0000u) + __builtin_bit_cast(float, pb[i].y & 0xffff0000u);
                    f32x4 x0;
                    x0[0] = __builtin_bit_cast(float, xb[i].x << 16); x0[1] = __builtin_bit_cast(float, xb[i].x & 0xffff0000u);
                    x0[2] = __builtin_bit_cast(float, xb[i].y << 16); x0[3] = __builtin_bit_cast(float, xb[i].y & 0xffff0000u);
                    xv[k][i] = x0 + coef * gv[i] * s2;
                }
            }
        }
#pragma unroll
        for (int k = 0; k < 3; ++k) {
            const int tok = tok0 + k * nw;
            if (ok[k]) {
                if (which == 4) {
#pragma unroll
                    for (int i = 0; i < 4; ++i) *(f32x4*)(p.out + (size_t)tok * DM + lane * 4 + i * 256) = xv[k][i];
                } else {
#pragma unroll
                    for (int i = 0; i < 4; ++i) { u32x2 w; w.x = pk_bf16(xv[k][i][0], xv[k][i][1]); w.y = pk_bf16(xv[k][i][2], xv[k][i][3]); *(u32x2*)(XB + (size_t)tok * DM + lane * 4 + i * 256) = w; }
                }
            }
#pragma unroll
            for (int i = 0; i < 4; ++i) ss[k] += xv[k][i][0] * xv[k][i][0] + xv[k][i][1] * xv[k][i][1] + xv[k][i][2] * xv[k][i][2] + xv[k][i][3] * xv[k][i][3];
        }
        if (which == 4) continue;
#pragma unroll
        for (int k = 0; k < 3; ++k) ss[k] = wave_sum(ss[k]);
#pragma unroll
        for (int k = 0; k < 3; ++k) {
            const int tok = tok0 + k * nw;
            const float rstd = rsqrtf(ss[k] * (1.f / 1024.f) + 1e-6f);
            if (ok[k]) {
#pragma unroll
                for (int i = 0; i < 4; ++i) {
                    const f32x4 y = xv[k][i] * rstd * g[i] * (1.f + sc[k][i]) + sh[k][i];
                    u32x2 w; w.x = pk_bf16(y[0], y[1]); w.y = pk_bf16(y[2], y[3]);
                    *(u32x2*)(H + (size_t)tok * DM + lane * 4 + i * 256) = w;
                }
            }
        }
    }
}

DEVI float rope_apply(float y, int d, int rowp, int colp) {
    const float part = __shfl_xor(y, 16);
    const int dd = d & 31, i = dd & 15;
    const float pos = (float)((d < 32) ? rowp : colp);
    const float inv = exp2f(-(float)i * (13.287712379549449f / 16.f));
    const float ang = pos * inv;
    float sn, cs;
    __sincosf(ang, &sn, &cs);
    return (dd < 16) ? (y * cs - part * sn) : (part * sn + y * cs);
}

DEVI void prep_phase(const Ctx& p, int l) {
    const int t = opaque_tid(), lane = t & 63, wid = t >> 6;
    const bf16_t* U = (const bf16_t*)(p.ws + OFF_U);
    float* fs = (float*)shm;
    float* CA = (float*)(p.ws + OFF_CA);
    float* CB = (float*)(p.ws + OFF_CB);
    for (int u = blockIdx.x; u < 384; u += gridDim.x) {
        __syncthreads();
        const int tt = u >> 2, g = u & 3, tok0 = tt * 64;
        int T, tpos0;
        if (tok0 < NCTX) { T = 256; tpos0 = tok0 & 255; } else { T = 1024; tpos0 = (tok0 - NCTX) & 1023; }
        float* xcs = fs;
        float* cmp = fs + 64 * 68;
        {
            const int tk = t >> 3, c8 = (t & 7) * 8;
            f32x4 a0 = *(const f32x4*)(p.in[I_CCB] + l * 256 + g * 64 + c8), a1 = *(const f32x4*)(p.in[I_CCB] + l * 256 + g * 64 + c8 + 4);
#pragma unroll
            for (int w = 0; w < 4; ++w) {
                const int tp = tpos0 + tk + w - 2;
                if (tp >= 0 && tp < T) {
                    const bf16_t* up = U + (size_t)(tok0 + tk + w - 2) * INW + 1024 + g * 64 + c8;
                    const float* cw = p.in[I_CCW] + ((size_t)l * 4 + w) * 256 + g * 64 + c8;
                    a0 += ldb4(up) * *(const f32x4*)cw;
                    a1 += ldb4(up + 4) * *(const f32x4*)(cw + 4);
                }
            }
            *(f32x4*)(xcs + tk * 68 + c8) = a0; *(f32x4*)(xcs + tk * 68 + c8 + 4) = a1;
        }
        __syncthreads();
        {
            const int fr = lane & 15, fq = lane >> 4, tt4 = wid & 3, dtb = (wid >> 2) * 2;
            bf16x8 af[2];
#pragma unroll
            for (int ks = 0; ks < 2; ++ks) {
                const f32x4 x0 = *(const f32x4*)(xcs + (tt4 * 16 + fr) * 68 + ks * 32 + fq * 8), x1 = *(const f32x4*)(xcs + (tt4 * 16 + fr) * 68 + ks * 32 + fq * 8 + 4);
                u32x4 w; w.x = pk_bf16(x0[0], x0[1]); w.y = pk_bf16(x0[2], x0[3]); w.z = pk_bf16(x1[0], x1[1]); w.w = pk_bf16(x1[2], x1[3]);
                af[ks] = __builtin_bit_cast(bf16x8, w);
            }
            const bf16_t* cwt = (const bf16_t*)(p.ws + OFF_CWT) + (size_t)l * 16 * 4096;
#pragma unroll
            for (int di = 0; di < 2; ++di) {
                const int dcol = (dtb + di) * 16 + fr, ch = g * 64 + dcol;
                f32x4 acc[4];
#pragma unroll
                for (int m = 0; m < 4; ++m) {
                    acc[m] = (f32x4){0.f, 0.f, 0.f, 0.f};
#pragma unroll
                    for (int ks = 0; ks < 2; ++ks) {
                        const bf16x8 bfr = *(const bf16x8*)(cwt + ((size_t)(m * 4 + g) * 64 + dcol) * 64 + ks * 32 + fq * 8);
                        acc[m] = __builtin_amdgcn_mfma_f32_16x16x32_bf16(af[ks], bfr, acc[m], 0, 0, 0);
                    }
                }
#pragma unroll
                for (int dir = 0; dir < 2; ++dir) {
                    const float ba = p.in[I_CBA][((size_t)l * 2 + dir) * 256 + ch], bx = p.in[I_CBX][((size_t)l * 2 + dir) * 256 + ch];
                    const float lam = p.in[I_CLAM][((size_t)l * 2 + dir) * 256 + ch];
                    const float sp = log1pf(expf(-lam));
                    float av[4], bv[4];
#pragma unroll
                    for (int r = 0; r < 4; ++r) {
                        const int tl = tt4 * 16 + fq * 4 + r;
                        const float rg = sigmoidf_(acc[dir * 2][r] + ba);
                        const float ig = sigmoidf_(acc[dir * 2 + 1][r] + bx);
                        const float la = -8.f * rg * sp;
                        const float a = __expf(la);
                        const float t2 = 2.f * la;
                        const float em = -t2 * (1.f + t2 * (0.5f + t2 * (0.16666667f + t2 * (0.041666668f + t2 * (0.008333334f + t2 * 0.0013888889f)))));
                        const float bb = __builtin_amdgcn_sqrtf(em) * (ig * xcs[tl * 68 + dcol]);
                        ((unsigned*)CA)[((size_t)dir * NTOK + tok0 + tl) * 256 + ch] = pk_bf16(1.f - a, bb);
                        av[r] = a; bv[r] = bb;
                    }
                    float Ac = 1.f, Bc = 0.f;
                    if (dir == 0) {
#pragma unroll
                        for (int r = 0; r < 4; ++r) { Bc = av[r] * Bc + bv[r]; Ac *= av[r]; }
                    } else {
#pragma unroll
                        for (int r = 3; r >= 0; --r) { Bc = av[r] * Bc + bv[r]; Ac *= av[r]; }
                    }
                    const int grp = tt4 * 4 + fq;
                    cmp[((dir * 16 + grp) * 2 + 0) * 64 + dcol] = Ac;
                    cmp[((dir * 16 + grp) * 2 + 1) * 64 + dcol] = Bc;
                }
            }
        }
        __syncthreads();
        if (t < 128) {
            const int dir = t >> 6, dd = t & 63;
            float Ac = 1.f, Bc = 0.f;
#pragma unroll
            for (int q = 0; q < 16; ++q) {
                const int gq = dir == 0 ? q : 15 - q;
                const float a = cmp[((dir * 16 + gq) * 2 + 0) * 64 + dd], b = cmp[((dir * 16 + gq) * 2 + 1) * 64 + dd];
                Bc = a * Bc + b; Ac *= a;
            }
            float* TA = (float*)(p.ws + OFF_TA); float* TB = (float*)(p.ws + OFF_TB);
            TA[((size_t)dir * 96 + tt) * 256 + g * 64 + dd] = Ac;
            TB[((size_t)dir * 96 + tt) * 256 + g * 64 + dd] = Bc;
        }
    }
    const int gw = blockIdx.x * 8 + wid, nw = gridDim.x * 8;
    bf16_t* QA = (bf16_t*)(p.ws + OFF_QA); bf16_t* QB = (bf16_t*)(p.ws + OFF_QB);
    bf16_t* KA = (bf16_t*)(p.ws + OFF_KA); bf16_t* VA = (bf16_t*)(p.ws + OFF_VA);
    bf16_t* KB = (bf16_t*)(p.ws + OFF_KB); bf16_t* VB = (bf16_t*)(p.ws + OFF_VB);
    bf16_t* DQ = (bf16_t*)(p.ws + OFF_DQ); bf16_t* DK = (bf16_t*)(p.ws + OFF_DK); bf16_t* DV = (bf16_t*)(p.ws + OFF_DV);
    {
        const int sub = lane >> 4, li = lane & 15;
        const f32x4 gaq = *(const f32x4*)(p.in[I_AQN] + l * 64 + li * 4), gak = *(const f32x4*)(p.in[I_AKN] + l * 64 + li * 4);
        const f32x4 gbq = *(const f32x4*)(p.in[I_BQN] + l * 64 + li * 4), gbk = *(const f32x4*)(p.in[I_BKN] + l * 64 + li * 4);
        const bool bal = gridDim.x == 256;
        const int tgw = bal ? ((int)blockIdx.x - 128) * 8 + wid : gw, tnw = bal ? 128 * 8 : nw;
        for (int tb = tgw * 4; tb < NTOK && tb >= 0; tb += tnw * 4) {
            const int tok = tb + sub;
            const bool lat = tok >= NCTX;
            int b, tp;
            if (!lat) { b = tok >> 8; tp = tok & 255; } else { b = (tok - NCTX) >> 10; tp = (tok - NCTX) & 1023; }
            const size_t krow = lat ? (size_t)(NCTX + b * 1536 + 512 + tp) : (size_t)tok;
            const bf16_t* ur = U + (size_t)tok * INW + li * 4;
            f32x4 cs = {1.f, 1.f, 1.f, 1.f}, sn = {0.f, 0.f, 0.f, 0.f};
            if (lat) {
                const float pos = (float)((li < 8) ? (tp >> 6) : (tp & 63));
#pragma unroll
                for (int e = 0; e < 4; ++e) {
                    const int fi = (li & 3) * 4 + e;
                    const float ang = pos * exp2f(-(float)fi * (13.287712379549449f / 16.f));
                    float s_, c_; __sincosf(ang, &s_, &c_);
                    cs[e] = c_; sn[e] = s_;
                }
            }
            const bool first = (li & 7) < 4;
#define PREP_NORM(v, gain) do { float ss_ = v[0] * v[0] + v[1] * v[1] + v[2] * v[2] + v[3] * v[3]; \
                ss_ += __shfl_xor(ss_, 1); ss_ += __shfl_xor(ss_, 2); ss_ += __shfl_xor(ss_, 4); ss_ += __shfl_xor(ss_, 8); \
                v = v * rsqrtf(ss_ * (1.f / 64.f) + 1e-6f) * gain; } while (0)
#define PREP_ROPE(v) do { if (lat) { f32x4 pt_; pt_[0] = __shfl_xor(v[0], 4); pt_[1] = __shfl_xor(v[1], 4); pt_[2] = __shfl_xor(v[2], 4); pt_[3] = __shfl_xor(v[3], 4); \
                v = first ? (v * cs - pt_ * sn) : (pt_ * sn + v * cs); } } while (0)
#define PREP_ST4(ptr, v) do { u32x2 w_; w_.x = pk_bf16(v[0], v[1]); w_.y = pk_bf16(v[2], v[3]); *(u32x2*)(ptr) = w_; } while (0)
#pragma unroll
            for (int mx = 0; mx < 2; ++mx) {
                const bf16_t* um = ur + mx * 512;
                bf16_t* Qo = mx ? QB : QA; bf16_t* Ko = mx ? KB : KA; bf16_t* Vo = mx ? VB : VA;
                const f32x4 gq = mx ? gbq : gaq, gk = mx ? gbk : gak;
                float* ck = p.out + (mx ? O_CBK : O_CAK); float* cv = p.out + (mx ? O_CBV : O_CAV);
#pragma unroll
                for (int hq = 0; hq < 4; ++hq) {
                    f32x4 v = ldb4(um + hq * 64);
                    PREP_NORM(v, gq);
                    PREP_ROPE(v);
                    v = v * 0.125f;
                    PREP_ST4(Qo + (size_t)tok * 256 + hq * 64 + li * 4, v);
                }
#pragma unroll
                for (int kv = 0; kv < 2; ++kv) {
                    f32x4 v = ldb4(um + 256 + kv * 64);
                    const f32x4 vv = ldb4(um + 384 + kv * 64);
                    PREP_NORM(v, gk);
                    if (!lat) {
                        const size_t co = (((size_t)b * 2 + l) * 256 + tp) * 128 + kv * 64 + li * 4;
                        *(f32x4*)(ck + co) = v; *(f32x4*)(cv + co) = vv;
                    }
                    PREP_ROPE(v);
                    PREP_ST4(Ko + krow * 128 + kv * 64 + li * 4, v);
                }
            }
#undef PREP_NORM
#undef PREP_ROPE
#undef PREP_ST4
        }
    }
    for (int it = gw; it < 1024; it += nw) {
        const int b = it >> 9, pos = it & 511;
        const size_t src = (((size_t)b * 2 + l) * 512 + pos) * 128 + lane * 2;
        const size_t dst = ((size_t)(NCTX + b * 1536 + pos)) * 128 + lane * 2;
        f32x2 v;
        v = *(const f32x2*)(p.in[I_CAK] + src); *(unsigned*)(KA + dst) = pk_bf16(v[0], v[1]);
        v = *(const f32x2*)(p.in[I_CAV] + src); *(unsigned*)(VA + dst) = pk_bf16(v[0], v[1]);
        v = *(const f32x2*)(p.in[I_CBK] + src); *(unsigned*)(KB + dst) = pk_bf16(v[0], v[1]);
        v = *(const f32x2*)(p.in[I_CBV] + src); *(unsigned*)(VB + dst) = pk_bf16(v[0], v[1]);
    }
}

DEVI void attn_unit(const Ctx& p, int l, int type, int idx) {
    const int t = opaque_tid(), lane = t & 63, wid = t >> 6, fr = lane & 15, fq = lane >> 4;
    bf16_t* MIX = (bf16_t*)(p.ws + OFF_MIX);
    const bf16_t* U = (const bf16_t*)(p.ws + OFF_U);
    int b, h, qtok0, qpos0, ntiles, kld, kcol, rowbase, ocol;
    const bf16_t *Qp, *Kp, *Vp;
    const bool ret_t = type >= 4;
    int plo = 0;
    if (type == 0 || type == 1 || type == 4) {
        b = idx >> 3; h = (idx >> 1) & 3; const int qh = idx & 1;
        qtok0 = b * 256 + qh * 128; qpos0 = qh * 128; ntiles = 4; rowbase = b * 256;
    } else {
        b = idx >> 5; h = (idx >> 3) & 3; const int qb = idx & 7;
        qtok0 = NCTX + b * 1024 + qb * 128; qpos0 = qb * 128;
        if (type == 2) { plo = qpos0 - 128 < 0 ? 0 : qpos0 - 128; const int phi = qpos0 + 256 > 1024 ? 1024 : qpos0 + 256; ntiles = 8 + ((phi - plo) >> 6); rowbase = NCTX + b * 1536; }
        else if (type == 3) { ntiles = 24; rowbase = NCTX + b * 1536; }
        else { ntiles = 16; rowbase = NCTX + b * 1024; }
    }
    if (type == 0 || type == 2) { Qp = (const bf16_t*)(p.ws + OFF_QA); Kp = (const bf16_t*)(p.ws + OFF_KA); Vp = (const bf16_t*)(p.ws + OFF_VA); kld = 128; kcol = (h >> 1) * 64; ocol = h * 64; }
    else if (type == 1 || type == 3) { Qp = (const bf16_t*)(p.ws + OFF_QB); Kp = (const bf16_t*)(p.ws + OFF_KB); Vp = (const bf16_t*)(p.ws + OFF_VB); kld = 128; kcol = (h >> 1) * 64; ocol = 256 + h * 64; }
    else { Qp = U; Kp = U; Vp = U; kld = INW; kcol = 1792 + h * 64; ocol = 768 + h * 64; }
    const int vucol = ((type & 1) ? 896 : 384) + (h >> 1) * 64;
    const int qld = ret_t ? INW : 256, qcol = ret_t ? 1536 + h * 64 : h * 64, vcol = ret_t ? 2048 + h * 64 : kcol;
    const bool ret = type >= 4;
    const bool dost = (type == 4);
    const int sdir = idx & 1;
    f32x4 SX[2];
#pragma unroll
    for (int i = 0; i < 2; ++i) SX[i] = (f32x4){0.f, 0.f, 0.f, 0.f};
    const int qtok = qtok0 + wid * 16 + fr, qpos = qpos0 + wid * 16 + fr;
    bf16x8 qf[2];
    {
        const bf16_t* qp = Qp + (size_t)qtok * qld + qcol + fq * 8;
        qf[0] = *(const bf16x8*)qp; qf[1] = *(const bf16x8*)(qp + 32);
    }
    float lgf = 0.f, lgb = 0.f;
    if (ret) {
        lgf = log1pf(-expf(p.in[I_DTH][(l * 2 + 0) * 4 + h])) * LOG2E;
        lgb = log1pf(-expf(p.in[I_DTH][(l * 2 + 1) * 4 + h])) * LOG2E;
    }
    float mrun = -1e30f, lrun = 0.f;
    if (type == 0 || type == 2) { mrun = p.in[I_ASINK][l * 4 + h]; lrun = (fq == 0) ? 1.f : 0.f; }
    f32x4 O[4];
#pragma unroll
    for (int i = 0; i < 4; ++i) O[i] = (f32x4){0.f, 0.f, 0.f, 0.f};

    const int skey = t >> 3, sc8 = (t & 7) * 8;
    const int ksw = skey ^ ((sc8 >> 3) << 3);
    const int ATT_BLK = 3 * 64 * 72;
    const int nstage = (ntiles + 3) >> 2;
    u32x4 kr[4], vr[4];
#define ATT_ROW(ti_) ((type == 2) ? (((ti_) < 8) ? rowbase + (ti_) * 64 : rowbase + 512 + plo + ((ti_) - 8) * 64) : rowbase + (ti_) * 64)
#define ATT_LOAD(sp_) do { _Pragma("unroll") for (int j_ = 0; j_ < 4; ++j_) { const int ti_ = (sp_) * 4 + j_; \
        if (ti_ < ntiles) { const int row_ = ATT_ROW(ti_); \
            kr[j_] = *(const u32x4*)(Kp + (size_t)(row_ + skey) * kld + kcol + sc8); \
            const bool vu_ = (type <= 1) || (type <= 3 && ti_ >= 8);       \
            const bf16_t* vp_ = vu_ ? U + (size_t)((type <= 1 ? row_ : row_ - rowbase - 512 + NCTX + b * 1024) + skey) * INW + vucol + sc8 \
                                    : Vp + (size_t)(row_ + skey) * kld + vcol + sc8; \
            vr[j_] = *(const u32x4*)vp_; } } } while (0)
    ATT_LOAD(0);
    for (int sp = 0; sp < nstage; ++sp) {
        __syncthreads();
#pragma unroll
        for (int j = 0; j < 4; ++j) {
            const int ti = sp * 4 + j;
            if (ti < ntiles) {
                bf16_t* Kd = shm + j * ATT_BLK; bf16_t* Vd = Kd + 64 * 72;
                const u32x4 kvr = kr[j], vvr = vr[j];
                *(u32x4*)(Kd + skey * 72 + sc8) = kvr;
                Vd[(sc8 + 0) * 72 + ksw] = (bf16_t)(vvr.x & 0xffffu); Vd[(sc8 + 1) * 72 + ksw] = (bf16_t)(vvr.x >> 16);
                Vd[(sc8 + 2) * 72 + ksw] = (bf16_t)(vvr.y & 0xffffu); Vd[(sc8 + 3) * 72 + ksw] = (bf16_t)(vvr.y >> 16);
                Vd[(sc8 + 4) * 72 + ksw] = (bf16_t)(vvr.z & 0xffffu); Vd[(sc8 + 5) * 72 + ksw] = (bf16_t)(vvr.z >> 16);
                Vd[(sc8 + 6) * 72 + ksw] = (bf16_t)(vvr.w & 0xffffu); Vd[(sc8 + 7) * 72 + ksw] = (bf16_t)(vvr.w >> 16);
                if (dost) {
                    bf16_t* Xd = Kd + 2 * 64 * 72; const int mpos = ti * 64 + skey;
                    const float wx = sdir == 0 ? fexp2(lgf * (float)(255 - mpos) - 3.f) : fexp2(lgb * (float)mpos - 3.f);
                    const unsigned kw[4] = {kvr.x, kvr.y, kvr.z, kvr.w};
#pragma unroll
                    for (int j2 = 0; j2 < 4; ++j2) {
                        const float klo = __builtin_bit_cast(float, kw[j2] << 16), khi = __builtin_bit_cast(float, kw[j2] & 0xffff0000u);
                        Xd[(sc8 + 2 * j2) * 72 + ksw] = to_bf16(klo * wx); Xd[(sc8 + 2 * j2 + 1) * 72 + ksw] = to_bf16(khi * wx);
                    }
                }
            }
        }
        __syncthreads();
        if (sp + 1 < nstage) ATT_LOAD(sp + 1);
        const int cnt = (ntiles - sp * 4) < 4 ? (ntiles - sp * 4) : 4;
#pragma unroll 1
        for (int j = 0; j < cnt; ++j) {
        const int ti = sp * 4 + j;
        int kpos0; bool masked = false;
        if (type == 2) { if (ti < 8) kpos0 = 0; else { kpos0 = plo + (ti - 8) * 64; masked = true; } }
        else kpos0 = ti * 64;
        const bf16_t* Ks = shm + j * ATT_BLK;
        const bf16_t* VT = Ks + 64 * 72;
        f32x4 st[4];
#pragma unroll
        for (int kt = 0; kt < 4; ++kt) {
            st[kt] = (f32x4){0.f, 0.f, 0.f, 0.f};
#pragma unroll
            for (int dh = 0; dh < 2; ++dh) {
                const bf16x8 kf = *(const bf16x8*)(Ks + (kt * 16 + fr) * 72 + dh * 32 + fq * 8);
                st[kt] = __builtin_amdgcn_mfma_f32_16x16x32_bf16(kf, qf[dh], st[kt], 0, 0, 0);
            }
        }
        float pv[4][4];
        if (!ret) {
            float mx = -1e30f;
#pragma unroll
            for (int kt = 0; kt < 4; ++kt)
#pragma unroll
                for (int r = 0; r < 4; ++r) {
                    float s_ = st[kt][r];
                    if (masked) { const int dlt = kpos0 + kt * 16 + fq * 4 + r - qpos; if (dlt > 128 || dlt < -128) s_ = -1e30f; }
                    pv[kt][r] = s_;
                    mx = fmaxf(mx, s_);
                }
            mx = fmaxf(mx, __shfl_xor(mx, 16)); mx = fmaxf(mx, __shfl_xor(mx, 32));
            const float mnew = fmaxf(mrun, mx);
            const float alpha = fexp2((mrun - mnew) * LOG2E);
            const float mb = mnew * LOG2E;
            float ps = 0.f;
#pragma unroll
            for (int kt = 0; kt < 4; ++kt)
#pragma unroll
                for (int r = 0; r < 4; ++r) {
                    const float s_ = pv[kt][r];
                    float e = fexp2(s_ * LOG2E - mb);
                    if (masked) e = (s_ <= -1e29f) ? 0.f : e;
                    pv[kt][r] = e; ps += e;
                }
            lrun = lrun * alpha + ps; mrun = mnew;
#pragma unroll
            for (int i = 0; i < 4; ++i) O[i] *= alpha;
        } else {
#pragma unroll
            for (int kt = 0; kt < 4; ++kt)
#pragma unroll
                for (int r = 0; r < 4; ++r) {
                    const int dlt = qpos - (kpos0 + kt * 16 + fq * 4 + r);
                    const float w = dlt > 0 ? fexp2(lgf * (float)dlt - 3.f) : (dlt < 0 ? fexp2(-lgb * (float)dlt - 3.f) : 0.25f);
                    pv[kt][r] = st[kt][r] * w;
                }
        }
#pragma unroll
        for (int pr = 0; pr < 2; ++pr) {
            u32x4 pw;
            pw.x = pk_bf16(pv[2 * pr][0], pv[2 * pr][1]); pw.y = pk_bf16(pv[2 * pr][2], pv[2 * pr][3]);
            pw.z = pk_bf16(pv[2 * pr + 1][0], pv[2 * pr + 1][1]); pw.w = pk_bf16(pv[2 * pr + 1][2], pv[2 * pr + 1][3]);
            const bf16x8 pf = __builtin_bit_cast(bf16x8, pw);
#pragma unroll
            for (int dt = 0; dt < 4; ++dt) {
                const int vsw = ((2 * dt + (fr >> 3)) & 7) << 3;
                const u32x2 lo = *(const u32x2*)(VT + (dt * 16 + fr) * 72 + (((2 * pr) * 16 + fq * 4) ^ vsw));
                const u32x2 hi = *(const u32x2*)(VT + (dt * 16 + fr) * 72 + (((2 * pr + 1) * 16 + fq * 4) ^ vsw));
                u32x4 vw; vw.x = lo.x; vw.y = lo.y; vw.z = hi.x; vw.w = hi.y;
                O[dt] = __builtin_amdgcn_mfma_f32_16x16x32_bf16(__builtin_bit_cast(bf16x8, vw), pf, O[dt], 0, 0, 0);
            }
        }
        if (dost) {
            const bf16_t* KX = Ks + 2 * 64 * 72;
            const int dtw = wid & 3, vt0 = (wid >> 2) * 2;
            const int dsw = ((2 * dtw + (fr >> 3)) & 7) << 3;
#pragma unroll
            for (int ms = 0; ms < 2; ++ms) {
                const bf16x8 bx_ = *(const bf16x8*)(KX + (dtw * 16 + fr) * 72 + ((ms * 32 + fq * 8) ^ dsw));
#pragma unroll
                for (int vi = 0; vi < 2; ++vi) {
                    const int vt = vt0 + vi;
                    const int vsw2 = ((2 * vt + (fr >> 3)) & 7) << 3;
                    const bf16x8 af_ = *(const bf16x8*)(VT + (vt * 16 + fr) * 72 + ((ms * 32 + fq * 8) ^ vsw2));
                    SX[vi] = __builtin_amdgcn_mfma_f32_16x16x32_bf16(af_, bx_, SX[vi], 0, 0, 0);
                }
            }
        }
        }
    }
#undef ATT_ROW
#undef ATT_LOAD
    if (dost) {
        const int dtw = wid & 3, vt0 = (wid >> 2) * 2;
#pragma unroll
        for (int vi = 0; vi < 2; ++vi) {
            const size_t o = (size_t)(dtw * 16 + fr) * 64 + (vt0 + vi) * 16 + fq * 4;
            *(f32x4*)(p.out + O_SD + ((((size_t)b * 2 + l) * 2 + sdir) * 4 + h) * 4096 + o) = SX[vi];
        }
    }
    bf16_t* op = MIX + (size_t)qtok * DM + ocol + fq * 4;
    if (!ret) {
        float ls = lrun; ls += __shfl_xor(ls, 16); ls += __shfl_xor(ls, 32);
        const float inv = 1.f / ls;
#pragma unroll
        for (int dt = 0; dt < 4; ++dt) {
            u32x2 w; w.x = pk_bf16(O[dt][0] * inv, O[dt][1] * inv); w.y = pk_bf16(O[dt][2] * inv, O[dt][3] * inv);
            *(u32x2*)(op + dt * 16) = w;
        }
    } else {
        if (type == 5) {
            __syncthreads();
            {
                bf16_t* S0T = shm;
#pragma unroll
                for (int i = 0; i < 4; ++i) {
                    const int id = i * 512 + t, dir = id >> 10, rem = id & 1023, d = rem >> 4, v4 = (rem & 15) * 4;
                    const f32x4 sv = *(const f32x4*)(p.in[I_SD] + ((((size_t)b * 2 + l) * 2 + dir) * 4 + h) * 4096 + d * 64 + v4);
                    bf16_t* dstp = S0T + dir * (64 * 72) + v4 * 72 + d;
                    dstp[0] = to_bf16(sv[0]); dstp[72] = to_bf16(sv[1]); dstp[144] = to_bf16(sv[2]); dstp[216] = to_bf16(sv[3]);
                }
            }
            __syncthreads();
#pragma unroll
            for (int dir = 0; dir < 2; ++dir) {
                const bf16_t* S0T = shm + dir * (64 * 72);
                const float wq = dir == 0 ? exp2f(lgf * (float)(qpos + 1)) : exp2f(lgb * (float)(1024 - qpos));
#pragma unroll
                for (int dt = 0; dt < 4; ++dt) {
                    f32x4 tmp = (f32x4){0.f, 0.f, 0.f, 0.f};
#pragma unroll
                    for (int dh = 0; dh < 2; ++dh) {
                        const bf16x8 sf = *(const bf16x8*)(S0T + (dt * 16 + fr) * 72 + dh * 32 + fq * 8);
                        tmp = __builtin_amdgcn_mfma_f32_16x16x32_bf16(sf, qf[dh], tmp, 0, 0, 0);
                    }
                    O[dt] += tmp * wq;
                }
            }
        }
        float ss = 0.f;
#pragma unroll
        for (int dt = 0; dt < 4; ++dt) ss += O[dt][0] * O[dt][0] + O[dt][1] * O[dt][1] + O[dt][2] * O[dt][2] + O[dt][3] * O[dt][3];
        ss += __shfl_xor(ss, 16); ss += __shfl_xor(ss, 32);
        const float rstd = rsqrtf(ss * (1.f / 64.f) + 1e-6f);
#pragma unroll
        for (int dt = 0; dt < 4; ++dt) {
            const int dcol = h * 64 + dt * 16 + fq * 4;
            const f32x4 gn = *(const f32x4*)(p.in[I_DNG] + l * 256 + dcol);
            const f32x4 dg = ldb4(U + (size_t)qtok * INW + 2304 + dcol);
            float o[4];
#pragma unroll
            for (int r = 0; r < 4; ++r) o[r] = O[dt][r] * rstd * gn[r] * siluf_(dg[r]);
            u32x2 w; w.x = pk_bf16(o[0], o[1]); w.y = pk_bf16(o[2], o[3]);
            *(u32x2*)(op + dt * 16) = w;
        }
    }
}

DEVI void scan_unit(const Ctx& p, int l, int tt) {
    const int t = opaque_tid(), ch = t & 255, dir = t >> 8;
    const float* CA = (const float*)(p.ws + OFF_CA);
    const float* CB = (const float*)(p.ws + OFF_CB);
    const float* TA = (const float*)(p.ws + OFF_TA);
    const float* TB = (const float*)(p.ws + OFF_TB);
    const bf16_t* U = (const bf16_t*)(p.ws + OFF_U);
    bf16_t* MIX = (bf16_t*)(p.ws + OFF_MIX);
    int tile0, tl, nts, sq; float h = 0.f;
    if (tt < 64) { sq = tt >> 2; tile0 = sq * 4; tl = tt & 3; nts = 4; }
    else { const int b = (tt - 64) >> 4; sq = 16 + b; tile0 = 64 + b * 16; tl = (tt - 64) & 15; nts = 16; h = p.in[I_SC][(((size_t)b * 2 + l) * 2 + dir) * 256 + ch]; }
    const int tok0 = tt * 64;
    {
        float ta[16], tb[16];
#pragma unroll
        for (int k = 0; k < 16; ++k) {
            int tk = dir == 0 ? k : nts - 1 - k;
            tk = tk < 0 ? 0 : (tk > nts - 1 ? nts - 1 : tk);
            ta[k] = TA[((size_t)dir * 96 + tile0 + tk) * 256 + ch]; tb[k] = TB[((size_t)dir * 96 + tile0 + tk) * 256 + ch];
        }
        const int npre = dir == 0 ? tl : nts - 1 - tl;
#pragma unroll
        for (int k = 0; k < 16; ++k) if (k < npre) h = ta[k] * h + tb[k];
    }
    const unsigned* abp = (const unsigned*)CA + ((size_t)dir * NTOK + tok0) * 256 + ch;
    float* hp = (float*)shm + dir * (64 * 256) + ch;
    if (dir == 0) {
#pragma unroll
        for (int t0 = 0; t0 < 64; t0 += 32) {
            float av[32], bv[32];
#pragma unroll
            for (int j = 0; j < 32; ++j) { const unsigned w_ = abp[(size_t)(t0 + j) * 256]; av[j] = 1.f - __builtin_bit_cast(float, w_ << 16); bv[j] = __builtin_bit_cast(float, w_ & 0xffff0000u); }
#pragma unroll
            for (int j = 0; j < 32; ++j) { h = av[j] * h + bv[j]; hp[(size_t)(t0 + j) * 256] = h; }
        }
    } else {
#pragma unroll
        for (int t0 = 32; t0 >= 0; t0 -= 32) {
            float av[32], bv[32];
#pragma unroll
            for (int j = 0; j < 32; ++j) { const unsigned w_ = abp[(size_t)(t0 + j) * 256]; av[j] = 1.f - __builtin_bit_cast(float, w_ << 16); bv[j] = __builtin_bit_cast(float, w_ & 0xffff0000u); }
#pragma unroll
            for (int j = 31; j >= 0; --j) { h = av[j] * h + bv[j]; hp[(size_t)(t0 + j) * 256] = h; }
        }
    }
    if (tt < 64 && ((dir == 0 && tl == 3) || (dir == 1 && tl == 0))) p.out[O_SC + (((size_t)sq * 2 + l) * 2 + dir) * 256 + ch] = h;
    __syncthreads();
    const float* H0 = (const float*)shm;
    const float* H1 = H0 + 64 * 256;
#pragma unroll
    for (int i = 0; i < 8; ++i) {
        const int idx = i * 512 + t;
        const int tk = idx >> 6, c4 = (idx & 63) * 4;
        const f32x4 a = *(const f32x4*)(H0 + (size_t)tk * 256 + c4), b = *(const f32x4*)(H1 + (size_t)tk * 256 + c4);
        const f32x4 cy = ldb4(U + (size_t)(tok0 + tk) * INW + 1280 + c4);
        float o[4];
#pragma unroll
        for (int r = 0; r < 4; ++r) {
            const float x = cy[r];
            const float z2 = 1.5957691216057308f * (x + 0.044715f * x * x * x);
            const float ge = x * __builtin_amdgcn_rcpf(1.f + __expf(-z2));
            o[r] = (a[r] + b[r]) * ge;
        }
        u32x2 w; w.x = pk_bf16(o[0], o[1]); w.y = pk_bf16(o[2], o[3]);
        *(u32x2*)(MIX + (size_t)(tok0 + tk) * DM + 512 + c4) = w;
    }
}

DEVI void mixer_phase(const Ctx& p, int l, volatile LAS int* s_unit, int slot) {
    const int NU = 672;
    const int nq = gridDim.x >= 8 ? 8 : 1, q = blockIdx.x % nq;
    unsigned* ctr = (unsigned*)(p.ws + OFF_CTRL) + 4096 + 64 * (slot * 8 + q);
    const int base = (int)gridDim.x < NU ? (int)gridDim.x : NU;
    bool first = true;
    for (;;) {
        int u;
        if (first) { u = blockIdx.x; first = false; if (u >= NU) break; }
        else {
            __syncthreads();
            if (threadIdx.x == 0) *s_unit = base + (int)atomicAdd(ctr, 1u) * nq + q;
            __syncthreads();
            u = *s_unit;
            if (u >= NU) break;
        }
#ifdef MIX_LO
        if (slot >= 2 && (u < MIX_LO || u >= MIX_HI)) continue;
#endif
        if (u < 64) attn_unit(p, l, 3, u);
        else if (u < 128) attn_unit(p, l, 5, u - 64);
        else if (u < 192) attn_unit(p, l, 2, u - 128);
        else if (u < 288) scan_unit(p, l, u - 192);
        else if (u < 416) attn_unit(p, l, 4, u - 288);
        else if (u < 544) attn_unit(p, l, 0, u - 416);
        else attn_unit(p, l, 1, u - 544);
    }
}

__global__ void __launch_bounds__(512, 2) fwd_megakernel(Params P, int ph_lo, int ph_hi) {
    __shared__ uint4 s_ctl[2];
    if (threadIdx.x == 0) {
        s_ctl[0] = make_uint4(0u, 0u, 0u, 0u); s_ctl[1] = make_uint4(0u, 0u, 0u, 0u);
        const float** tabw = (const float**)(P.ws + OFF_TAB) + (size_t)blockIdx.x * 64;
#pragma unroll
        for (int i = 0; i < N_IN; ++i) tabw[i] = P.in[i];
        __threadfence();
    }
    __syncthreads();
    if (P.never) cg::this_grid().sync();
    XcdBarrier xb;
    const bool multi = (ph_hi - ph_lo) > 1;
    if (multi) xb = xcd_barrier_post((unsigned*)(P.ws + OFF_CTRL), (volatile LAS unsigned*)&s_ctl[0]);
    volatile LAS int* s_unit = (volatile LAS int*)&s_ctl[1];
#ifndef PH_MASK
#define PH_MASK 63
#endif
#ifndef DUP_MASK
#define DUP_MASK 0
#endif
    for (int ph2 = ph_lo * 2; ph2 < ph_hi * 2; ++ph2) {
        const int ph = ph2 >> 1, rep = ph2 & 1;
        if (rep) {
            const int kk = (ph >= 1 && ph < 23) ? (ph - 1) % 11 : -1;
            const bool dup = (ph == 0) ? (DUP_MASK & 1) : (ph == 23 || kk == 0 || kk == 3 || kk == 8) ? (DUP_MASK & 2) : (kk == 5) ? (DUP_MASK & 4) : (kk == 6) ? (DUP_MASK & 8) : (kk == 1 || kk == 2 || kk == 4 || kk == 7 || kk == 9 || kk == 10) ? (DUP_MASK & 16) : false;
            if (!dup) continue;
        }
        if (ph2 > ph_lo * 2) xcd_barrier(xb);
        Ctx p;
        p.ws = P.ws; p.out = P.out; p.in = (const float* const*)(P.ws + OFF_TAB) + (size_t)blockIdx.x * 64;
        asm volatile("" : "+s"(p.ws), "+s"(p.out), "+s"(p.in) :: "memory");
        if (ph == 0) { if (PH_MASK & 1) prologue_phase(p); continue; }
        if (ph == 23) { if (PH_MASK & 2) norm_phase(p, 1, 4, rep); continue; }
        const int l = (ph - 1) / 11, k = (ph - 1) % 11;
        const unsigned char* wl = p.ws + OFF_W + (size_t)l * W_LAYER;
        if (k == 0 || k == 3 || k == 8) { if (PH_MASK & 2) norm_phase(p, l, k == 0 ? 1 : (k == 3 ? 2 : 3), rep); }
        else if (k == 5) { if (PH_MASK & 4) prep_phase(p, l); }
        else if (k == 6) { if (PH_MASK & 8) mixer_phase(p, l, s_unit, l + 2 * rep); }
        else if (PH_MASK & 16) {
            GemmDesc g;
            g.nM = NTOK / 256;
            if (k == 1 || k == 9) { g.A = (const bf16_t*)(p.ws + OFF_H); g.Bt = (const bf16_t*)(wl + (k == 1 ? WL_GU1 : WL_GU2)); g.K = 1024; g.nN = 22; g.S = 1; g.nt = 16; g.epi = EPI_GU; g.out = p.ws + OFF_ACT; }
            else if (k == 2 || k == 10) { g.A = (const bf16_t*)(p.ws + OFF_ACT); g.Bt = (const bf16_t*)(wl + (k == 2 ? WL_D1 : WL_D2)); g.K = 2816; g.nN = 4; g.S = 2; g.nt = 22; g.epi = EPI_PART; g.out = p.ws + OFF_U; }
            else if (k == 4) { g.A = (const bf16_t*)(p.ws + OFF_H); g.Bt = (const bf16_t*)(wl + WL_IN); g.K = 1024; g.nN = 10; g.S = 1; g.nt = 16; g.epi = EPI_U; g.out = p.ws + OFF_U; }
            else { g.A = (const bf16_t*)(p.ws + OFF_MIX); g.Bt = (const bf16_t*)(wl + WL_OUT); g.K = 1024; g.nN = 4; g.S = 2; g.nt = 8; g.epi = EPI_PART; g.out = p.ws + OFF_U; }
            gemm_phase(g);
            if (rep == 0 && gridDim.x == 256) {
                int lo = CONV_C0, per = 0;
                for (int q = 1; q <= ph; ++q) {
                    const int kq = (q - 1) % 11;
                    const int sup = (kq == 1 || kq == 9) ? 480 : (kq == 2 || kq == 10) ? 192 : (kq == 4) ? 32 : (kq == 7) ? 64 : 0;
                    if (q < ph) lo += sup; else per = (kq == 1 || kq == 9) ? 2 : (kq == 2 || kq == 10) ? 3 : (kq == 4) ? 2 : 1;
                }
                const int Ug = g.nM * g.nN * g.S, nfull = Ug % (int)gridDim.x;
                if (nfull != 0 && (int)blockIdx.x >= nfull && lo < NTR_UNITS) {
                    const int nidle = (int)gridDim.x - nfull;
                    int hi = lo + per * nidle; if (hi > NTR_UNITS) hi = NTR_UNITS;
                    convert_fill(p, lo, hi, (int)blockIdx.x - nfull, nidle, per);
                }
            }
        }
    }
}

extern "C" void kernel_launch(void* const* d_in, const int* in_sizes, int n_in, void* d_out, int out_size, void* d_ws, size_t ws_size, hipStream_t stream) {
    Params p{};
    for (int i = 0; i < N_IN; ++i) p.in[i] = (const float*)d_in[i];
    p.out = (float*)d_out;
    p.ws = (unsigned char*)d_ws;
    p.never = 0; p.pad = 0;
    static int grid_blocks = 0;
    if (!grid_blocks) {
        (void)hipFuncSetAttribute((const void*)fwd_megakernel, hipFuncAttributeMaxDynamicSharedMemorySize, SHM_BYTES);
        int dev = 0, cus = 0, per_cu = 0;
        (void)hipGetDevice(&dev);
        (void)hipDeviceGetAttribute(&cus, hipDeviceAttributeMultiprocessorCount, dev);
        (void)hipOccupancyMaxActiveBlocksPerMultiprocessor(&per_cu, fwd_megakernel, 512, SHM_BYTES);
        if (per_cu < 1) fprintf(stderr, "occupancy query returned %d\n", per_cu);
        grid_blocks = cus;
    }
    (void)hipMemsetAsync(d_ws, 0, CTRL_BYTES, stream);
#if MK_MULTI
    for (int ph = 0; ph < NPHASE; ++ph)
        fwd_megakernel<<<dim3(grid_blocks), dim3(512), SHM_BYTES, stream>>>(p, ph, ph + 1);
#else
    int lo = 0, hi = NPHASE;
    void* args[] = {&p, &lo, &hi};
    hipError_t e = hipLaunchCooperativeKernel((const void*)fwd_megakernel, dim3(grid_blocks), dim3(512), args, SHM_BYTES, stream);
    if (e != hipSuccess) fprintf(stderr, "cooperative launch failed: %s (grid %d)\n", hipGetErrorString(e), grid_blocks);
#endif
}
```

```cpp
#include <hip/hip_runtime.h>
#include <hip/hip_cooperative_groups.h>
#include <cstdint>
#include <cstdio>
namespace cg = cooperative_groups;

#ifndef MK_MULTI
#define MK_MULTI 0
#endif

#define DEVI __device__ __forceinline__
#define LAS __attribute__((address_space(3)))

typedef unsigned short bf16_t;
typedef short bf16x8 __attribute__((ext_vector_type(8)));
typedef float f32x4 __attribute__((ext_vector_type(4)));
typedef float f32x2 __attribute__((ext_vector_type(2)));
typedef unsigned u32x4 __attribute__((ext_vector_type(4)));
typedef unsigned u32x2 __attribute__((ext_vector_type(2)));

constexpr int NTOK = 6144, NCTX = 4096, DM = 1024, DFF = 2816, INW = 2560;
constexpr int NKROW = 7168;
constexpr float LOG2E = 1.4426950408889634f;

enum { I_XP = 0, I_XS, I_CAK, I_CAV, I_CBK, I_CBV, I_SC, I_SD, I_C, I_CCTX, I_N1, I_N2, I_N3, I_WMOD, I_BMOD,
       I_F1G, I_F1U, I_F1D, I_F2G, I_F2U, I_F2D, I_WIN, I_WOUT, I_AQN, I_AKN, I_ASINK, I_BQN, I_BKN,
       I_CCW, I_CCB, I_CWA, I_CBA, I_CWX, I_CBX, I_CLAM, I_DTH, I_DNG, N_IN };

constexpr size_t O_YP = 0, O_YS = 4194304, O_CAK = 6291456, O_CAV = 7340032, O_CBK = 8388608, O_CBV = 9437184,
                 O_SC = 10485760, O_SD = 10502144;

constexpr size_t OFF_CTRL = 0;
constexpr size_t CTRL_BYTES = 65536;
constexpr size_t OFF_TAB = CTRL_BYTES;
constexpr size_t OFF_MOD = OFF_TAB + 131072;
constexpr size_t OFF_W = OFF_MOD + 262144;
constexpr size_t W_GU = (size_t)5632 * 1024 * 2, W_D = (size_t)1024 * 2816 * 2, W_IN = (size_t)2560 * 1024 * 2, W_OUT = (size_t)1024 * 1024 * 2;
constexpr size_t WL_GU1 = 0, WL_D1 = WL_GU1 + W_GU, WL_IN = WL_D1 + W_D, WL_OUT = WL_IN + W_IN, WL_GU2 = WL_OUT + W_OUT, WL_D2 = WL_GU2 + W_GU, W_LAYER = WL_D2 + W_D;
constexpr size_t OFF_H = OFF_W + 2 * W_LAYER;
constexpr size_t OFF_ACT = OFF_H + (size_t)NTOK * 1024 * 2;
constexpr size_t OFF_U = OFF_ACT + (size_t)NTOK * 2816 * 2;
constexpr size_t OFF_MIX = OFF_U + (size_t)NTOK * 2560 * 4;
constexpr size_t OFF_QA = OFF_MIX + (size_t)NTOK * 1024 * 2;
constexpr size_t OFF_QB = OFF_QA + (size_t)NTOK * 256 * 2;
constexpr size_t OFF_KA = OFF_QB + (size_t)NTOK * 256 * 2;
constexpr size_t OFF_VA = OFF_KA + (size_t)NKROW * 128 * 2;
constexpr size_t OFF_KB = OFF_VA + (size_t)NKROW * 128 * 2;
constexpr size_t OFF_VB = OFF_KB + (size_t)NKROW * 128 * 2;
constexpr size_t OFF_DQ = OFF_VB + (size_t)NKROW * 128 * 2;
constexpr size_t OFF_DK = OFF_DQ + (size_t)NTOK * 256 * 2;
constexpr size_t OFF_DV = OFF_DK + (size_t)NTOK * 256 * 2;
constexpr size_t OFF_CA = OFF_DV + (size_t)NTOK * 256 * 2;
constexpr size_t OFF_CB = OFF_CA + (size_t)2 * NTOK * 256 * 4;
constexpr size_t OFF_HF = OFF_CB + (size_t)2 * NTOK * 256 * 4;
constexpr size_t OFF_TA = OFF_HF + (size_t)2 * NTOK * 256 * 4;
constexpr size_t OFF_TB = OFF_TA + (size_t)2 * 96 * 256 * 4;
constexpr size_t OFF_CWT = OFF_TB + (size_t)2 * 96 * 256 * 4;
constexpr size_t OFF_XB = OFF_CWT + (size_t)2 * 4 * 4 * 4096 * 2;
constexpr size_t WS_TOTAL = OFF_XB + (size_t)NTOK * 1024 * 2;
static_assert(WS_TOTAL < (size_t)300 * 1024 * 1024, "workspace too large");

constexpr int SHM_BYTES = 131072;
constexpr int NPHASE = 24;

struct Params {
    const float* in[N_IN];
    float* out;
    unsigned char* ws;
    int never;
    int pad;
};

struct Ctx { const float* const* in; float* out; unsigned char* ws; };

extern __shared__ __attribute__((aligned(16))) bf16_t shm[];

DEVI unsigned pk_bf16(float lo, float hi) { unsigned r; asm("v_cvt_pk_bf16_f32 %0, %1, %2" : "=v"(r) : "v"(lo), "v"(hi)); return r; }
DEVI bf16_t to_bf16(float x) { return (bf16_t)(pk_bf16(x, 0.f) & 0xffffu); }
DEVI f32x4 ldb4(const bf16_t* p) {
    const u32x2 w = *(const u32x2*)p; f32x4 r;
    r[0] = __builtin_bit_cast(float, w.x << 16); r[1] = __builtin_bit_cast(float, w.x & 0xffff0000u);
    r[2] = __builtin_bit_cast(float, w.y << 16); r[3] = __builtin_bit_cast(float, w.y & 0xffff0000u);
    return r;
}
DEVI float wave_sum(float v) {
#pragma unroll
    for (int o = 32; o > 0; o >>= 1) v += __shfl_xor(v, o);
    return v;
}
DEVI int opaque_tid() { int t = threadIdx.x; asm volatile("" : "+v"(t)); return t; }
DEVI float fexp2(float x) { return __builtin_amdgcn_exp2f(x); }
DEVI float sigmoidf_(float x) { return __builtin_amdgcn_rcpf(1.f + __expf(-x)); }
DEVI float siluf_(float x) { return x * sigmoidf_(x); }

#define XB_TMO      128
#define XB_XCNT(j)  (256  + 64 * (j))
#define XB_XSUB(j)  (1280 + 64 * (j))
#define XB_XGEN(j)  (2304 + 64 * (j))
#define XB_TOP      3328
#define XB_TOPGEN   3392
#define XCD_BAR_WORDS 3456
#define XB_SPIN_CAP (1u << 20)
DEVI unsigned xb_ld(unsigned* p) { return __hip_atomic_load(p, __ATOMIC_RELAXED, __HIP_MEMORY_SCOPE_AGENT); }
DEVI unsigned xb_add(unsigned* p, unsigned v) { return __hip_atomic_fetch_add(p, v, __ATOMIC_RELAXED, __HIP_MEMORY_SCOPE_AGENT); }
DEVI unsigned xb_xcc_id() { return (unsigned)__builtin_amdgcn_s_getreg((3 << 11) | 20) & 0xFu; }
#define XB_SPIN(cond, bar) do { unsigned _sp = 0; while (cond) { __builtin_amdgcn_s_sleep(1); \
    if ((++_sp & 255u) == 0u) { if (xb_ld(&(bar)[XB_TMO])) break; if (_sp > XB_SPIN_CAP) { atomicAdd(&(bar)[XB_TMO], 1u); break; } } } } while (0)
struct XcdBarrier { unsigned* bar; unsigned x; volatile LAS unsigned* st; };
DEVI XcdBarrier xcd_barrier_post(unsigned* bar, volatile LAS unsigned* st) {
    XcdBarrier b; b.bar = bar; b.x = xb_xcc_id(); b.st = st;
    if (threadIdx.x == 0) (void)xb_add(&bar[XB_XCNT(b.x)], 1u);
    return b;
}
DEVI void xcd_barrier_complete(unsigned* bar, unsigned x, unsigned& nloc, unsigned& nx) {
    const unsigned G = gridDim.x * gridDim.y * gridDim.z;
    unsigned sum, cnt, mine, sp = 0u;
    for (;;) {
        sum = 0u; cnt = 0u; mine = 0u;
#pragma unroll
        for (unsigned j = 0; j < 16; ++j) { const unsigned c = xb_ld(&bar[XB_XCNT(j)]); sum += c; cnt += (c > 0u) ? 1u : 0u; mine = (j == x) ? c : mine; }
        if (sum == G) break;
        __builtin_amdgcn_s_sleep(1);
        if ((++sp & 255u) == 0u) { if (xb_ld(&bar[XB_TMO])) break; if (sp > XB_SPIN_CAP) { atomicAdd(&bar[XB_TMO], 1u); break; } }
    }
    nloc = mine > 0u ? mine : 1u; nx = cnt > 0u ? cnt : 1u;
}
DEVI void xcd_barrier(const XcdBarrier& b) {
    asm volatile("s_waitcnt vmcnt(0)" ::: "memory");
    __syncthreads();
    if (threadIdx.x == 0) {
        unsigned* bar = b.bar;
        asm volatile("" : "+s"(bar));
        __builtin_amdgcn_s_waitcnt(0);
        unsigned nloc = b.st[0], nx = b.st[1];
        if (nloc == 0u) { xcd_barrier_complete(bar, b.x, nloc, nx); b.st[0] = nloc; b.st[1] = nx; }
        const unsigned old = xb_add(&bar[XB_XSUB(b.x)], 1u);
        const unsigned gen = old / nloc;
        if (old + 1u == (gen + 1u) * nloc) {
            __builtin_amdgcn_fence(__ATOMIC_RELEASE, "agent");
            asm volatile("s_waitcnt vmcnt(0)" ::: "memory");
            const unsigned og = xb_add(&bar[XB_TOP], 1u);
            const unsigned tg = og / nx;
            if (og + 1u == (tg + 1u) * nx) xb_add(&bar[XB_TOPGEN], 1u);
            else XB_SPIN(xb_ld(&bar[XB_TOPGEN]) == tg, bar);
            __builtin_amdgcn_fence(__ATOMIC_ACQUIRE, "agent");
            xb_add(&bar[XB_XGEN(b.x)], 1u);
            asm volatile("s_waitcnt vmcnt(0)" ::: "memory");
        } else {
            XB_SPIN(xb_ld(&bar[XB_XGEN(b.x)]) == gen, bar);
            __builtin_amdgcn_fence(__ATOMIC_ACQUIRE, "agent");
            asm volatile("s_waitcnt vmcnt(0)" ::: "memory");
        }
    }
    __syncthreads();
}

constexpr int BM = 256, BK = 64, HALF = 128, HTB = HALF * BK * 2;
DEVI int lds_byte(int r, int c) { const int st = (r >> 4) * 2 + (c >> 5), rr = r & 15, cc = c & 31, ob = rr * 64 + cc * 2; return st * 1024 + (ob ^ (((ob >> 9) & 1) << 5)); }
DEVI void stage_rc(int b, int& R, int& C) { const int st = b / 1024, sb = b % 1024, swz = sb ^ (((sb >> 9) & 1) << 5); R = (st >> 1) * 16 + swz / 64; C = (st & 1) * 32 + (swz % 64) / 2; }

enum { EPI_GU = 0, EPI_PART = 1, EPI_U = 2 };
struct GemmDesc { const bf16_t* A; const bf16_t* Bt; int K; int nM, nN, S, nt; int epi; void* out; };
struct Unit { int pm, pn, ks; };

DEVI bool gemm_next(const GemmDesc& g, int i, Unit& u) {
    const int nwg = g.nM * g.nN;
    const long L = (long)i * gridDim.x + blockIdx.x;
    if (L >= (long)nwg * g.S) return false;
    u.ks = (int)(L / nwg);
    int wgid = (int)(L % nwg);
    { const int q = nwg / 8, r = nwg % 8, xcd = wgid % 8, off = wgid / 8; wgid = (xcd < r ? xcd * (q + 1) : r * (q + 1) + (xcd - r) * q) + off; }
    const int WGM = 4;
    const int nig = WGM * g.nN, gid = wgid / nig, fm = gid * WGM, gsz = (g.nM - fm) < WGM ? (g.nM - fm) : WGM;
    u.pm = fm + ((wgid % nig) % gsz); u.pn = (wgid % nig) / gsz;
    return true;
}

DEVI void gemm_epilogue(const GemmDesc& g, const f32x4 (&acc)[2][2][4][2], const Unit& u, int wr, int wc, int fr, int fq) {
    const int brow = u.pm * BM, bcol = u.pn * BM;
    if (g.epi == EPI_GU) {
        bf16_t* act = (bf16_t*)g.out;
#pragma unroll
        for (int ai = 0; ai < 2; ++ai)
#pragma unroll
            for (int m = 0; m < 4; ++m) {
                const int row = brow + ai * HALF + wr * 64 + m * 16 + fr;
                const int hcol = u.pn * 128 + wc * 32 + fq * 8;
                u32x4 w;
                { const f32x4 gt = acc[ai][0][m][0], up = acc[ai][1][m][0];
                  w.x = pk_bf16(siluf_(gt[0]) * up[0], siluf_(gt[1]) * up[1]); w.y = pk_bf16(siluf_(gt[2]) * up[2], siluf_(gt[3]) * up[3]); }
                { const f32x4 gt = acc[ai][0][m][1], up = acc[ai][1][m][1];
                  w.z = pk_bf16(siluf_(gt[0]) * up[0], siluf_(gt[1]) * up[1]); w.w = pk_bf16(siluf_(gt[2]) * up[2], siluf_(gt[3]) * up[3]); }
                *(u32x4*)(act + (size_t)row * DFF + hcol) = w;
            }
    } else if (g.epi == EPI_PART) {
        bf16_t* o = (bf16_t*)g.out + (size_t)u.ks * NTOK * DM;
#pragma unroll
        for (int ai = 0; ai < 2; ++ai)
#pragma unroll
            for (int m = 0; m < 4; ++m) {
                const int row = brow + ai * HALF + wr * 64 + m * 16 + fr;
#pragma unroll
                for (int bj = 0; bj < 2; ++bj) {
                    const int col = bcol + bj * HALF + wc * 32 + fq * 8;
                    const f32x4 v0 = acc[ai][bj][m][0], v1 = acc[ai][bj][m][1];
                    u32x4 w; w.x = pk_bf16(v0[0], v0[1]); w.y = pk_bf16(v0[2], v0[3]); w.z = pk_bf16(v1[0], v1[1]); w.w = pk_bf16(v1[2], v1[3]);
                    *(u32x4*)(o + (size_t)row * DM + col) = w;
                }
            }
    } else {
        bf16_t* o = (bf16_t*)g.out;
#pragma unroll
        for (int ai = 0; ai < 2; ++ai)
#pragma unroll
            for (int m = 0; m < 4; ++m) {
                const int row = brow + ai * HALF + wr * 64 + m * 16 + fr;
#pragma unroll
                for (int bj = 0; bj < 2; ++bj) {
                    const int col = bcol + bj * HALF + wc * 32 + fq * 8;
                    const f32x4 v0 = acc[ai][bj][m][0], v1 = acc[ai][bj][m][1];
                    u32x4 w; w.x = pk_bf16(v0[0], v0[1]); w.y = pk_bf16(v0[2], v0[3]); w.z = pk_bf16(v1[0], v1[1]); w.w = pk_bf16(v1[2], v1[3]);
                    *(u32x4*)(o + (size_t)row * INW + col) = w;
                }
            }
    }
}

DEVI void gemm_phase(const GemmDesc g) {
    LAS unsigned char* lds = (LAS unsigned char*)shm;
    const int tid = opaque_tid(), wid = __builtin_amdgcn_readfirstlane(tid >> 6), lane = tid & 63, wr = wid >> 2, wc = wid & 3, fr = lane & 15, fq = lane >> 4;
    const int K = g.K, nt = g.nt;
    unsigned voffA[2], voffB[2];
#pragma unroll
    for (int i = 0; i < 2; ++i) { int R, C; stage_rc(tid * 16 + i * 8192, R, C); voffA[i] = (unsigned)(R * K + C) * 2u;
        const int rho = R & 31, pr = 8 * ((rho & 15) >> 2) + 4 * (rho >> 4) + (rho & 3); voffB[i] = (unsigned)(((R & ~31) + pr) * K + C) * 2u; }
    const size_t kstep = (size_t)(BK * 2);
    const size_t hstep = (size_t)HALF * K * 2;
    const size_t tstep = 2 * hstep;
    const size_t sstep = (size_t)nt * kstep;
    const unsigned ldsw = (unsigned)wid * 1024u;
    const int aoff = lds_byte(wr * 64 + fr, fq * 8), boff = lds_byte(wc * 32 + fr, fq * 8);
#define PG8_SA(b, h) (((b) * 2 + (h)) * HTB)
#define PG8_SB(b, h) ((4 + (b) * 2 + (h)) * HTB)
#define PG8_STAGE(bufoff, gbase, voff) do { _Pragma("unroll") for (int _i = 0; _i < 2; ++_i) \
        __builtin_amdgcn_global_load_lds((const unsigned*)((const char*)(gbase) + (voff)[_i]), (LAS unsigned*)(lds + (bufoff) + ldsw + _i * 8192), 16, 0, 0); } while (0)
#define PG8_LDA(dst, b, h) do { _Pragma("unroll") for (int m = 0; m < 4; ++m) _Pragma("unroll") for (int k = 0; k < 2; ++k) dst[m][k] = *(const LAS bf16x8*)(lds + PG8_SA(b, h) + aoff + m * 2048 + k * 1024); } while (0)
#define PG8_LDB(dst, b, h) do { _Pragma("unroll") for (int n = 0; n < 2; ++n) _Pragma("unroll") for (int k = 0; k < 2; ++k) dst[n][k] = *(const LAS bf16x8*)(lds + PG8_SB(b, h) + boff + n * 2048 + k * 1024); } while (0)
#define PG8_MMA(ai, bj, At, Bt) do { __builtin_amdgcn_s_setprio(1); _Pragma("unroll") for (int m = 0; m < 4; ++m) _Pragma("unroll") for (int n = 0; n < 2; ++n) _Pragma("unroll") for (int k = 0; k < 2; ++k) \
        acc[ai][bj][m][n] = __builtin_amdgcn_mfma_f32_16x16x32_bf16(Bt[n][k], At[m][k], acc[ai][bj][m][n], 0, 0, 0); __builtin_amdgcn_s_setprio(0); } while (0)
#define PG8_WAIT_V(n) asm volatile("s_waitcnt vmcnt(" #n ")" ::: "memory")
#define PG8_WAIT_L(n) asm volatile("s_waitcnt lgkmcnt(" #n ")" ::: "memory")
#define PG8_BAR __builtin_amdgcn_s_barrier()
#define PG8_SCHED __builtin_amdgcn_sched_barrier(0)
    Unit cur, nxt; int ui = 0;
    if (!gemm_next(g, 0, cur)) return;
    f32x4 acc[2][2][4][2];
#pragma unroll
    for (int a = 0; a < 2; ++a)
#pragma unroll
        for (int b = 0; b < 2; ++b)
#pragma unroll
            for (int m = 0; m < 4; ++m)
#pragma unroll
                for (int n = 0; n < 2; ++n) acc[a][b][m][n] = (f32x4){0.f, 0.f, 0.f, 0.f};
    bf16x8 At[4][2], B0[2][2], B1[2][2];
    const char* cA = (const char*)g.A + (size_t)cur.pm * tstep + (size_t)cur.ks * sstep;
    const char* cB = (const char*)g.Bt + (size_t)cur.pn * tstep + (size_t)cur.ks * sstep;
    PG8_STAGE(PG8_SB(0, 0), cB, voffB); PG8_STAGE(PG8_SB(0, 1), cB + hstep, voffB); PG8_STAGE(PG8_SA(0, 0), cA, voffA); PG8_STAGE(PG8_SA(0, 1), cA + hstep, voffA);
    if (wr == 1) PG8_BAR;
    PG8_WAIT_V(2); PG8_BAR;
    PG8_STAGE(PG8_SB(1, 0), cB + kstep, voffB); PG8_STAGE(PG8_SA(1, 0), cA + kstep, voffA); PG8_STAGE(PG8_SB(1, 1), cB + hstep + kstep, voffB);
    PG8_WAIT_V(6); PG8_BAR;
    for (;;) {
        const bool has_next = gemm_next(g, ui + 1, nxt);
        const char* nA = has_next ? (const char*)g.A + (size_t)nxt.pm * tstep + (size_t)nxt.ks * sstep : cA;
        const char* nB = has_next ? (const char*)g.Bt + (size_t)nxt.pn * tstep + (size_t)nxt.ks * sstep : cB;
        for (int t = 0; t < nt; t += 2) {
            const bool last = (t == nt - 2);
            const char* a1 = cA + (size_t)(t + 1) * kstep;
            const char* a2 = last ? nA : cA + (size_t)(t + 2) * kstep; const char* b2 = last ? nB : cB + (size_t)(t + 2) * kstep;
            const char* a3 = a2 + kstep; const char* b3 = b2 + kstep;
            PG8_LDB(B0, 0, 0); PG8_LDB(B1, 0, 1); PG8_SCHED; PG8_LDA(At, 0, 0); PG8_STAGE(PG8_SA(1, 1), a1 + hstep, voffA);
            PG8_WAIT_V(8); PG8_WAIT_L(0); PG8_BAR; PG8_MMA(0, 0, At, B0); PG8_MMA(0, 1, At, B1); PG8_BAR; PG8_SCHED;
            PG8_LDA(At, 0, 1); PG8_STAGE(PG8_SB(0, 0), b2, voffB); PG8_STAGE(PG8_SB(0, 1), b2 + hstep, voffB); PG8_STAGE(PG8_SA(0, 0), a2, voffA);
            PG8_WAIT_V(8); PG8_WAIT_L(0); PG8_BAR; PG8_MMA(1, 0, At, B0); PG8_MMA(1, 1, At, B1); PG8_BAR; PG8_SCHED;
            PG8_LDB(B0, 1, 0); PG8_LDB(B1, 1, 1); PG8_SCHED; PG8_LDA(At, 1, 0); PG8_STAGE(PG8_SA(0, 1), a2 + hstep, voffA);
            PG8_WAIT_V(8); PG8_WAIT_L(0); PG8_BAR; PG8_MMA(0, 0, At, B0); PG8_MMA(0, 1, At, B1); PG8_BAR; PG8_SCHED;
            PG8_LDA(At, 1, 1); PG8_STAGE(PG8_SB(1, 0), b3, voffB); PG8_STAGE(PG8_SB(1, 1), b3 + hstep, voffB); PG8_STAGE(PG8_SA(1, 0), a3, voffA);
            PG8_WAIT_V(8); PG8_WAIT_L(0); PG8_BAR; PG8_MMA(1, 0, At, B0); PG8_MMA(1, 1, At, B1); PG8_BAR; PG8_SCHED;
        }
        if (wr == 0) PG8_BAR;
        gemm_epilogue(g, acc, cur, wr, wc, fr, fq);
        if (!has_next) break;
#pragma unroll
        for (int a = 0; a < 2; ++a)
#pragma unroll
            for (int b = 0; b < 2; ++b)
#pragma unroll
                for (int m = 0; m < 4; ++m)
#pragma unroll
                    for (int n = 0; n < 2; ++n) acc[a][b][m][n] = (f32x4){0.f, 0.f, 0.f, 0.f};
        cur = nxt; cA = nA; cB = nB; ++ui;
        if (wr == 1) PG8_BAR;
    }
    PG8_WAIT_V(0);
    PG8_BAR;
#undef PG8_SA
#undef PG8_SB
#undef PG8_STAGE
#undef PG8_LDA
#undef PG8_LDB
#undef PG8_MMA
#undef PG8_WAIT_V
#undef PG8_WAIT_L
#undef PG8_BAR
#undef PG8_SCHED
}

constexpr int NTR_UNITS = 2560;
constexpr int CONV_C0 = 352;
DEVI void transpose_unit(const Ctx& p, int tu, int t, float* fs) {
    const int l = tu / 1280, r = tu % 1280;
    int which, loc, K, N, mode; size_t dsto;
    if (r < 176)       { which = I_F1G;  loc = r;        K = 1024; N = 2816; mode = 1; dsto = WL_GU1; }
    else if (r < 352)  { which = I_F1U;  loc = r - 176;  K = 1024; N = 2816; mode = 2; dsto = WL_GU1; }
    else if (r < 528)  { which = I_F1D;  loc = r - 352;  K = 2816; N = 1024; mode = 0; dsto = WL_D1; }
    else if (r < 688)  { which = I_WIN;  loc = r - 528;  K = 1024; N = 2560; mode = 0; dsto = WL_IN; }
    else if (r < 752)  { which = I_WOUT; loc = r - 688;  K = 1024; N = 1024; mode = 0; dsto = WL_OUT; }
    else if (r < 928)  { which = I_F2G;  loc = r - 752;  K = 1024; N = 2816; mode = 1; dsto = WL_GU2; }
    else if (r < 1104) { which = I_F2U;  loc = r - 928;  K = 1024; N = 2816; mode = 2; dsto = WL_GU2; }
    else               { which = I_F2D;  loc = r - 1104; K = 2816; N = 1024; mode = 0; dsto = WL_D2; }
    const int nnt = N / 256, kt = loc / nnt, ntile = loc % nnt;
    const float* src = p.in[which] + (size_t)l * K * N + (size_t)kt * 64 * N + ntile * 256;
    bf16_t* dst = (bf16_t*)(p.ws + OFF_W + (size_t)l * W_LAYER + dsto);
    f32x4 v[8];
#pragma unroll
    for (int i = 0; i < 8; ++i) { const int idx = i * 512 + t; v[i] = *(const f32x4*)(src + (size_t)(idx >> 6) * N + (idx & 63) * 4); }
#pragma unroll
    for (int i = 0; i < 8; ++i) { const int idx = i * 512 + t; *(f32x4*)(fs + (idx >> 6) * 260 + (idx & 63) * 4) = v[i]; }
    __syncthreads();
    const int nl = t & 255, kh = t >> 8;
    int drow;
    if (mode == 0) drow = ntile * 256 + nl;
    else drow = (2 * ntile + (nl >> 7)) * 256 + (nl & 127) + (mode == 2 ? 128 : 0);
    bf16_t* dp = dst + (size_t)drow * K + kt * 64 + kh * 32;
#pragma unroll
    for (int c = 0; c < 4; ++c) {
        u32x4 w;
        const float* f = fs + (kh * 32 + c * 8) * 260 + nl;
        w.x = pk_bf16(f[0], f[260]); w.y = pk_bf16(f[2 * 260], f[3 * 260]); w.z = pk_bf16(f[4 * 260], f[5 * 260]); w.w = pk_bf16(f[6 * 260], f[7 * 260]);
        *(u32x4*)(dp + c * 8) = w;
    }
}

DEVI void convert_fill(const Ctx& p, int lo, int hi, int rank, int nrank, int per) {
    const int t = opaque_tid();
    float* fs = (float*)shm;
    for (int i = 0; i < per; ++i) {
        const int tu = lo + rank + i * nrank;
        if (tu >= hi) break;
        __syncthreads();
        transpose_unit(p, tu, t, fs);
    }
}

DEVI void prologue_phase(const Ctx& p) {
    const int t = opaque_tid();
    float* fs = (float*)shm;
    float* mod = (float*)(p.ws + OFF_MOD);
    const int NMOD = 288, NCW = 32, NTR = (gridDim.x == 256) ? CONV_C0 : NTR_UNITS;
    if (gridDim.x == 256) {
        if (blockIdx.x >= 64)
            for (int tu = (int)blockIdx.x - 64; tu < NTR; tu += 192) { __syncthreads(); transpose_unit(p, tu, t, fs); }
    } else {
        for (int tu = blockIdx.x; tu < NTR; tu += gridDim.x) { __syncthreads(); transpose_unit(p, tu, t, fs); }
    }
    for (int u = blockIdx.x; u < NMOD + NCW; u += gridDim.x) {
        __syncthreads();
        if (u >= NMOD && u < NMOD + NCW) {
            const int mi = u - NMOD, l = mi >> 4, m = (mi >> 2) & 3, g = mi & 3, dir = m >> 1;
            const float* w = ((m & 1) ? p.in[I_CWX] : p.in[I_CWA]) + (((size_t)l * 2 + dir) * 4 + g) * 4096;
            bf16_t* wt = (bf16_t*)(p.ws + OFF_CWT) + (((size_t)l * 4 + m) * 4 + g) * 4096;
            const int d = t >> 3, c8 = (t & 7) * 8;
            u32x4 o;
            o.x = pk_bf16(w[(c8 + 0) * 64 + d], w[(c8 + 1) * 64 + d]); o.y = pk_bf16(w[(c8 + 2) * 64 + d], w[(c8 + 3) * 64 + d]);
            o.z = pk_bf16(w[(c8 + 4) * 64 + d], w[(c8 + 5) * 64 + d]); o.w = pk_bf16(w[(c8 + 6) * 64 + d], w[(c8 + 7) * 64 + d]);
            *(u32x4*)(wt + d * 64 + c8) = o;
        } else if (u < NMOD) {
            const int l = u / 144, jb = u % 144;
            for (int i = t; i < 3072; i += 512) {
                const int r = i >> 10, k = i & 1023;
                const float c = (r == 0) ? p.in[I_CCTX][k] : p.in[I_C][(r - 1) * 1024 + k];
                fs[i] = c / (1.f + __expf(-c));
            }
            __syncthreads();
            const int cgp = t & 15, kg = t >> 4;
            const float* w = p.in[I_WMOD] + ((size_t)l * 1024 + kg * 32) * 9216 + jb * 64 + cgp * 4;
            f32x4 a0 = {0, 0, 0, 0}, a1 = {0, 0, 0, 0}, a2 = {0, 0, 0, 0};
#pragma unroll 8
            for (int k = 0; k < 32; ++k) {
                const f32x4 wv = *(const f32x4*)(w + (size_t)k * 9216);
                const int kk = kg * 32 + k;
                a0 += wv * fs[kk]; a1 += wv * fs[1024 + kk]; a2 += wv * fs[2048 + kk];
            }
            float* red = fs + 3072;
            *(f32x4*)(red + kg * 192 + 0 + cgp * 4) = a0;
            *(f32x4*)(red + kg * 192 + 64 + cgp * 4) = a1;
            *(f32x4*)(red + kg * 192 + 128 + cgp * 4) = a2;
            __syncthreads();
            if (t < 192) {
                float sacc = 0.f;
#pragma unroll 8
                for (int k = 0; k < 32; ++k) sacc += red[k * 192 + t];
                const int r = t >> 6, j = t & 63;
                mod[((size_t)l * 3 + r) * 9216 + jb * 64 + j] = sacc + p.in[I_BMOD][(size_t)l * 9216 + jb * 64 + j];
            }
        } else {
            transpose_unit(p, u - NMOD - NCW, t, fs);
        }
    }
}

DEVI void norm_phase(const Ctx& p, int l, int which, int dry) {
    const int t_ = opaque_tid();
    const int lane = t_ & 63, gw = blockIdx.x * 8 + (t_ >> 6), nw = gridDim.x * 8;
    const float* mod = (const float*)(p.ws + OFF_MOD);
    const bf16_t* P0 = (const bf16_t*)(p.ws + OFF_U);
    const bf16_t* P1 = P0 + (size_t)NTOK * DM;
    bf16_t* H = (bf16_t*)(p.ws + OFF_H);
    bf16_t* XB = (bf16_t*)(p.ws + OFF_XB);
    const bool first = (l == 0 && which == 1);
    int gl, gi; float coef;
    if (which == 1) { gl = l - 1; gi = 8; coef = 0.5f; }
    else if (which == 2) { gl = l; gi = 2; coef = 0.5f; }
    else if (which == 3) { gl = l; gi = 5; coef = 1.0f; }
    else { gl = 1; gi = 8; coef = 0.5f; }
    if (dry) coef = 0.f;
    const float* gn = (which == 1) ? p.in[I_N1] : (which == 2) ? p.in[I_N2] : p.in[I_N3];
    const int shi = (which - 1) * 3, sci = shi + 1;
    for (int tok0 = gw; tok0 < NTOK; tok0 += 3 * nw) {
        f32x4 xv[3][4];
        float ss[3] = {0.f, 0.f, 0.f};
        int rr[3];
        bool ok[3];
        f32x4 g[4], sc[3][4], sh[3][4];
#pragma unroll
        for (int k = 0; k < 3; ++k) {
            const int tok = tok0 + k * nw;
            ok[k] = tok < NTOK;
            const int tk = ok[k] ? tok : tok0;
            rr[k] = tk < NCTX ? 0 : 1 + ((tk - NCTX) >> 10);
            if (which != 4) {
#pragma unroll
                for (int i = 0; i < 4; ++i) {
                    const int c = lane * 4 + i * 256;
                    if (k == 0) g[i] = *(const f32x4*)(gn + (size_t)l * DM + c);
                    sc[k][i] = *(const f32x4*)(mod + ((size_t)l * 3 + rr[k]) * 9216 + sci * 1024 + c);
                    sh[k][i] = *(const f32x4*)(mod + ((size_t)l * 3 + rr[k]) * 9216 + shi * 1024 + c);
                }
            }
            if (first) {
#pragma unroll
                for (int i = 0; i < 4; ++i) {
                    const int c = lane * 4 + i * 256;
                    xv[k][i] = (tk < NCTX) ? *(const f32x4*)(p.in[I_XP] + (size_t)tk * DM + c) : *(const f32x4*)(p.in[I_XS] + (size_t)(tk - NCTX) * DM + c);
                }
            } else {
                u32x2 pa[4], pb[4], xb[4]; f32x4 gv[4];
#pragma unroll
                for (int i = 0; i < 4; ++i) {
                    const int c = lane * 4 + i * 256;
                    xb[i] = *(const u32x2*)(XB + (size_t)tk * DM + c);
                    pa[i] = *(const u32x2*)(P0 + (size_t)tk * DM + c); pb[i] = *(const u32x2*)(P1 + (size_t)tk * DM + c);
                    gv[i] = *(const f32x4*)(mod + ((size_t)gl * 3 + rr[k]) * 9216 + gi * 1024 + c);
                }
#pragma unroll
                for (int i = 0; i < 4; ++i) {
                    f32x4 s2;
                    s2[0] = __builtin_bit_cast(float, pa[i].x << 16) + __builtin_bit_cast(float, pb[i].x << 16);
                    s2[1] = __builtin_bit_cast(float, pa[i].x & 0xffff0000u) + __builtin_bit_cast(float, pb[i].x & 0xffff0000u);
                    s2[2] = __builtin_bit_cast(float, pa[i].y << 16) + __builtin_bit_cast(float, pb[i].y << 16);
                    s2[3] = __builtin_bit_cast(float, pa[i].y & 0xffff0000u) + __builtin_bit_cast(float, pb[i].y & 0xffff0000u);
                    f32x4 x0;
                    x0[0] = __builtin_bit_cast(float, xb[i].x << 16); x0[1] = __builtin_bit_cast(float, xb[i].x & 0xffff0000u);
                    x0[2] = __builtin_bit_cast(float, xb[i].y << 16); x0[3] = __builtin_bit_cast(float, xb[i].y & 0xffff0000u);
                    xv[k][i] = x0 + coef * gv[i] * s2;
                }
            }
        }
#pragma unroll
        for (int k = 0; k < 3; ++k) {
            const int tok = tok0 + k * nw;
            if (ok[k]) {
                if (which == 4) {
#pragma unroll
                    for (int i = 0; i < 4; ++i) *(f32x4*)(p.out + (size_t)tok * DM + lane * 4 + i * 256) = xv[k][i];
                } else {
#pragma unroll
                    for (int i = 0; i < 4; ++i) { u32x2 w; w.x = pk_bf16(xv[k][i][0], xv[k][i][1]); w.y = pk_bf16(xv[k][i][2], xv[k][i][3]); *(u32x2*)(XB + (size_t)tok * DM + lane * 4 + i * 256) = w; }
                }
            }
#pragma unroll
            for (int i = 0; i < 4; ++i) ss[k] += xv[k][i][0] * xv[k][i][0] + xv[k][i][1] * xv[k][i][1] + xv[k][i][2] * xv[k][i][2] + xv[k][i][3] * xv[k][i][3];
        }
        if (which == 4) continue;
#pragma unroll
        for (int k = 0; k < 3; ++k) ss[k] = wave_sum(ss[k]);
#pragma unroll
        for (int k = 0; k < 3; ++k) {
            const int tok = tok0 + k * nw;
            const float rstd = rsqrtf(ss[k] * (1.f / 1024.f) + 1e-6f);
            if (ok[k]) {
#pragma unroll
                for (int i = 0; i < 4; ++i) {
                    const f32x4 y = xv[k][i] * rstd * g[i] * (1.f + sc[k][i]) + sh[k][i];
                    u32x2 w; w.x = pk_bf16(y[0], y[1]); w.y = pk_bf16(y[2], y[3]);
                    *(u32x2*)(H + (size_t)tok * DM + lane * 4 + i * 256) = w;
                }
            }
        }
    }
}

DEVI float rope_apply(float y, int d, int rowp, int colp) {
    const float part = __shfl_xor(y, 16);
    const int dd = d & 31, i = dd & 15;
    const float pos = (float)((d < 32) ? rowp : colp);
    const float inv = exp2f(-(float)i * (13.287712379549449f / 16.f));
    const float ang = pos * inv;
    float sn, cs;
    __sincosf(ang, &sn, &cs);
    return (dd < 16) ? (y * cs - part * sn) : (part * sn + y * cs);
}

DEVI void prep_phase(const Ctx& p, int l) {
    const int t = opaque_tid(), lane = t & 63, wid = t >> 6;
    const bf16_t* U = (const bf16_t*)(p.ws + OFF_U);
    float* fs = (float*)shm;
    float* CA = (float*)(p.ws + OFF_CA);
    float* CB = (float*)(p.ws + OFF_CB);
    for (int u = blockIdx.x; u < 384; u += gridDim.x) {
        __syncthreads();
        const int tt = u >> 2, g = u & 3, tok0 = tt * 64;
        int T, tpos0;
        if (tok0 < NCTX) { T = 256; tpos0 = tok0 & 255; } else { T = 1024; tpos0 = (tok0 - NCTX) & 1023; }
        float* xcs = fs;
        float* cmp = fs + 64 * 68;
        {
            const int tk = t >> 3, c8 = (t & 7) * 8;
            f32x4 a0 = *(const f32x4*)(p.in[I_CCB] + l * 256 + g * 64 + c8), a1 = *(const f32x4*)(p.in[I_CCB] + l * 256 + g * 64 + c8 + 4);
#pragma unroll
            for (int w = 0; w < 4; ++w) {
                const int tp = tpos0 + tk + w - 2;
                if (tp >= 0 && tp < T) {
                    const bf16_t* up = U + (size_t)(tok0 + tk + w - 2) * INW + 1024 + g * 64 + c8;
                    const float* cw = p.in[I_CCW] + ((size_t)l * 4 + w) * 256 + g * 64 + c8;
                    a0 += ldb4(up) * *(const f32x4*)cw;
                    a1 += ldb4(up + 4) * *(const f32x4*)(cw + 4);
                }
            }
            *(f32x4*)(xcs + tk * 68 + c8) = a0; *(f32x4*)(xcs + tk * 68 + c8 + 4) = a1;
        }
        __syncthreads();
        {
            const int fr = lane & 15, fq = lane >> 4, tt4 = wid & 3, dtb = (wid >> 2) * 2;
            bf16x8 af[2];
#pragma unroll
            for (int ks = 0; ks < 2; ++ks) {
                const f32x4 x0 = *(const f32x4*)(xcs + (tt4 * 16 + fr) * 68 + ks * 32 + fq * 8), x1 = *(const f32x4*)(xcs + (tt4 * 16 + fr) * 68 + ks * 32 + fq * 8 + 4);
                u32x4 w; w.x = pk_bf16(x0[0], x0[1]); w.y = pk_bf16(x0[2], x0[3]); w.z = pk_bf16(x1[0], x1[1]); w.w = pk_bf16(x1[2], x1[3]);
                af[ks] = __builtin_bit_cast(bf16x8, w);
            }
            const bf16_t* cwt = (const bf16_t*)(p.ws + OFF_CWT) + (size_t)l * 16 * 4096;
#pragma unroll
            for (int di = 0; di < 2; ++di) {
                const int dcol = (dtb + di) * 16 + fr, ch = g * 64 + dcol;
                f32x4 acc[4];
#pragma unroll
                for (int m = 0; m < 4; ++m) {
                    acc[m] = (f32x4){0.f, 0.f, 0.f, 0.f};
#pragma unroll
                    for (int ks = 0; ks < 2; ++ks) {
                        const bf16x8 bfr = *(const bf16x8*)(cwt + ((size_t)(m * 4 + g) * 64 + dcol) * 64 + ks * 32 + fq * 8);
                        acc[m] = __builtin_amdgcn_mfma_f32_16x16x32_bf16(af[ks], bfr, acc[m], 0, 0, 0);
                    }
                }
#pragma unroll
                for (int dir = 0; dir < 2; ++dir) {
                    const float ba = p.in[I_CBA][((size_t)l * 2 + dir) * 256 + ch], bx = p.in[I_CBX][((size_t)l * 2 + dir) * 256 + ch];
                    const float lam = p.in[I_CLAM][((size_t)l * 2 + dir) * 256 + ch];
                    const float sp = log1pf(expf(-lam));
                    float av[4], bv[4];
#pragma unroll
                    for (int r = 0; r < 4; ++r) {
                        const int tl = tt4 * 16 + fq * 4 + r;
                        const float rg = sigmoidf_(acc[dir * 2][r] + ba);
                        const float ig = sigmoidf_(acc[dir * 2 + 1][r] + bx);
                        const float la = -8.f * rg * sp;
                        const float a = __expf(la);
                        const float t2 = 2.f * la;
                        const float em = -t2 * (1.f + t2 * (0.5f + t2 * (0.16666667f + t2 * (0.041666668f + t2 * (0.008333334f + t2 * 0.0013888889f)))));
                        const float bb = __builtin_amdgcn_sqrtf(em) * (ig * xcs[tl * 68 + dcol]);
                        ((unsigned*)CA)[((size_t)dir * NTOK + tok0 + tl) * 256 + ch] = pk_bf16(1.f - a, bb);
                        av[r] = a; bv[r] = bb;
                    }
                    float Ac = 1.f, Bc = 0.f;
                    if (dir == 0) {
#pragma unroll
                        for (int r = 0; r < 4; ++r) { Bc = av[r] * Bc + bv[r]; Ac *= av[r]; }
                    } else {
#pragma unroll
                        for (int r = 3; r >= 0; --r) { Bc = av[r] * Bc + bv[r]; Ac *= av[r]; }
                    }
                    const int grp = tt4 * 4 + fq;
                    cmp[((dir * 16 + grp) * 2 + 0) * 64 + dcol] = Ac;
                    cmp[((dir * 16 + grp) * 2 + 1) * 64 + dcol] = Bc;
                }
            }
        }
        __syncthreads();
        if (t < 128) {
            const int dir = t >> 6, dd = t & 63;
            float Ac = 1.f, Bc = 0.f;
#pragma unroll
            for (int q = 0; q < 16; ++q) {
                const int gq = dir == 0 ? q : 15 - q;
                const float a = cmp[((dir * 16 + gq) * 2 + 0) * 64 + dd], b = cmp[((dir * 16 + gq) * 2 + 1) * 64 + dd];
                Bc = a * Bc + b; Ac *= a;
            }
            float* TA = (float*)(p.ws + OFF_TA); float* TB = (float*)(p.ws + OFF_TB);
            TA[((size_t)dir * 96 + tt) * 256 + g * 64 + dd] = Ac;
            TB[((size_t)dir * 96 + tt) * 256 + g * 64 + dd] = Bc;
        }
    }
    const int gw = blockIdx.x * 8 + wid, nw = gridDim.x * 8;
    bf16_t* QA = (bf16_t*)(p.ws + OFF_QA); bf16_t* QB = (bf16_t*)(p.ws + OFF_QB);
    bf16_t* KA = (bf16_t*)(p.ws + OFF_KA); bf16_t* VA = (bf16_t*)(p.ws + OFF_VA);
    bf16_t* KB = (bf16_t*)(p.ws + OFF_KB); bf16_t* VB = (bf16_t*)(p.ws + OFF_VB);
    bf16_t* DQ = (bf16_t*)(p.ws + OFF_DQ); bf16_t* DK = (bf16_t*)(p.ws + OFF_DK); bf16_t* DV = (bf16_t*)(p.ws + OFF_DV);
    {
        const int sub = lane >> 4, li = lane & 15;
        const f32x4 gaq = *(const f32x4*)(p.in[I_AQN] + l * 64 + li * 4), gak = *(const f32x4*)(p.in[I_AKN] + l * 64 + li * 4);
        const f32x4 gbq = *(const f32x4*)(p.in[I_BQN] + l * 64 + li * 4), gbk = *(const f32x4*)(p.in[I_BKN] + l * 64 + li * 4);
        const bool bal = gridDim.x == 256;
        const int tgw = bal ? ((int)blockIdx.x - 128) * 8 + wid : gw, tnw = bal ? 128 * 8 : nw;
        for (int tb = tgw * 4; tb < NTOK && tb >= 0; tb += tnw * 4) {
            const int tok = tb + sub;
            const bool lat = tok >= NCTX;
            int b, tp;
            if (!lat) { b = tok >> 8; tp = tok & 255; } else { b = (tok - NCTX) >> 10; tp = (tok - NCTX) & 1023; }
            const size_t krow = lat ? (size_t)(NCTX + b * 1536 + 512 + tp) : (size_t)tok;
            const bf16_t* ur = U + (size_t)tok * INW + li * 4;
            f32x4 cs = {1.f, 1.f, 1.f, 1.f}, sn = {0.f, 0.f, 0.f, 0.f};
            if (lat) {
                const float pos = (float)((li < 8) ? (tp >> 6) : (tp & 63));
#pragma unroll
                for (int e = 0; e < 4; ++e) {
                    const int fi = (li & 3) * 4 + e;
                    const float ang = pos * exp2f(-(float)fi * (13.287712379549449f / 16.f));
                    float s_, c_; __sincosf(ang, &s_, &c_);
                    cs[e] = c_; sn[e] = s_;
                }
            }
            const bool first = (li & 7) < 4;
#define PREP_NORM(v, gain) do { float ss_ = v[0] * v[0] + v[1] * v[1] + v[2] * v[2] + v[3] * v[3]; \
                ss_ += __shfl_xor(ss_, 1); ss_ += __shfl_xor(ss_, 2); ss_ += __shfl_xor(ss_, 4); ss_ += __shfl_xor(ss_, 8); \
                v = v * rsqrtf(ss_ * (1.f / 64.f) + 1e-6f) * gain; } while (0)
#define PREP_ROPE(v) do { if (lat) { f32x4 pt_; pt_[0] = __shfl_xor(v[0], 4); pt_[1] = __shfl_xor(v[1], 4); pt_[2] = __shfl_xor(v[2], 4); pt_[3] = __shfl_xor(v[3], 4); \
                v = first ? (v * cs - pt_ * sn) : (pt_ * sn + v * cs); } } while (0)
#define PREP_ST4(ptr, v) do { u32x2 w_; w_.x = pk_bf16(v[0], v[1]); w_.y = pk_bf16(v[2], v[3]); *(u32x2*)(ptr) = w_; } while (0)
#pragma unroll
            for (int mx = 0; mx < 2; ++mx) {
                const bf16_t* um = ur + mx * 512;
                bf16_t* Qo = mx ? QB : QA; bf16_t* Ko = mx ? KB : KA; bf16_t* Vo = mx ? VB : VA;
                const f32x4 gq = mx ? gbq : gaq, gk = mx ? gbk : gak;
                float* ck = p.out + (mx ? O_CBK : O_CAK); float* cv = p.out + (mx ? O_CBV : O_CAV);
#pragma unroll
                for (int hq = 0; hq < 4; ++hq) {
                    f32x4 v = ldb4(um + hq * 64);
                    PREP_NORM(v, gq);
                    PREP_ROPE(v);
                    v = v * 0.125f;
                    PREP_ST4(Qo + (size_t)tok * 256 + hq * 64 + li * 4, v);
                }
#pragma unroll
                for (int kv = 0; kv < 2; ++kv) {
                    f32x4 v = ldb4(um + 256 + kv * 64);
                    const f32x4 vv = ldb4(um + 384 + kv * 64);
                    PREP_NORM(v, gk);
                    if (!lat) {
                        const size_t co = (((size_t)b * 2 + l) * 256 + tp) * 128 + kv * 64 + li * 4;
                        *(f32x4*)(ck + co) = v; *(f32x4*)(cv + co) = vv;
                    }
                    PREP_ROPE(v);
                    PREP_ST4(Ko + krow * 128 + kv * 64 + li * 4, v);
                }
            }
#undef PREP_NORM
#undef PREP_ROPE
#undef PREP_ST4
        }
    }
    for (int it = gw; it < 1024; it += nw) {
        const int b = it >> 9, pos = it & 511;
        const size_t src = (((size_t)b * 2 + l) * 512 + pos) * 128 + lane * 2;
        const size_t dst = ((size_t)(NCTX + b * 1536 + pos)) * 128 + lane * 2;
        f32x2 v;
        v = *(const f32x2*)(p.in[I_CAK] + src); *(unsigned*)(KA + dst) = pk_bf16(v[0], v[1]);
        v = *(const f32x2*)(p.in[I_CAV] + src); *(unsigned*)(VA + dst) = pk_bf16(v[0], v[1]);
        v = *(const f32x2*)(p.in[I_CBK] + src); *(unsigned*)(KB + dst) = pk_bf16(v[0], v[1]);
        v = *(const f32x2*)(p.in[I_CBV] + src); *(unsigned*)(VB + dst) = pk_bf16(v[0], v[1]);
    }
}

DEVI void attn_unit(const Ctx& p, int l, int type, int idx) {
    const int t = opaque_tid(), lane = t & 63, wid = t >> 6, fr = lane & 15, fq = lane >> 4;
    bf16_t* MIX = (bf16_t*)(p.ws + OFF_MIX);
    const bf16_t* U = (const bf16_t*)(p.ws + OFF_U);
    int b, h, qtok0, qpos0, ntiles, kld, kcol, rowbase, ocol;
    const bf16_t *Qp, *Kp, *Vp;
    const bool ret_t = type >= 4;
    int plo = 0;
    if (type == 0 || type == 1 || type == 4) {
        b = idx >> 3; h = (idx >> 1) & 3; const int qh = idx & 1;
        qtok0 = b * 256 + qh * 128; qpos0 = qh * 128; ntiles = 4; rowbase = b * 256;
    } else {
        b = idx >> 5; h = (idx >> 3) & 3; const int qb = idx & 7;
        qtok0 = NCTX + b * 1024 + qb * 128; qpos0 = qb * 128;
        if (type == 2) { plo = qpos0 - 128 < 0 ? 0 : qpos0 - 128; const int phi = qpos0 + 256 > 1024 ? 1024 : qpos0 + 256; ntiles = 8 + ((phi - plo) >> 6); rowbase = NCTX + b * 1536; }
        else if (type == 3) { ntiles = 24; rowbase = NCTX + b * 1536; }
        else { ntiles = 16; rowbase = NCTX + b * 1024; }
    }
    if (type == 0 || type == 2) { Qp = (const bf16_t*)(p.ws + OFF_QA); Kp = (const bf16_t*)(p.ws + OFF_KA); Vp = (const bf16_t*)(p.ws + OFF_VA); kld = 128; kcol = (h >> 1) * 64; ocol = h * 64; }
    else if (type == 1 || type == 3) { Qp = (const bf16_t*)(p.ws + OFF_QB); Kp = (const bf16_t*)(p.ws + OFF_KB); Vp = (const bf16_t*)(p.ws + OFF_VB); kld = 128; kcol = (h >> 1) * 64; ocol = 256 + h * 64; }
    else { Qp = U; Kp = U; Vp = U; kld = INW; kcol = 1792 + h * 64; ocol = 768 + h * 64; }
    const int vucol = ((type & 1) ? 896 : 384) + (h >> 1) * 64;
    const int qld = ret_t ? INW : 256, qcol = ret_t ? 1536 + h * 64 : h * 64, vcol = ret_t ? 2048 + h * 64 : kcol;
    const bool ret = type >= 4;
    const bool dost = (type == 4);
    const int sdir = idx & 1;
    f32x4 SX[2];
#pragma unroll
    for (int i = 0; i < 2; ++i) SX[i] = (f32x4){0.f, 0.f, 0.f, 0.f};
    const int qtok = qtok0 + wid * 16 + fr, qpos = qpos0 + wid * 16 + fr;
    bf16x8 qf[2];
    {
        const bf16_t* qp = Qp + (size_t)qtok * qld + qcol + fq * 8;
        qf[0] = *(const bf16x8*)qp; qf[1] = *(const bf16x8*)(qp + 32);
    }
    float lgf = 0.f, lgb = 0.f;
    if (ret) {
        lgf = log1pf(-expf(p.in[I_DTH][(l * 2 + 0) * 4 + h])) * LOG2E;
        lgb = log1pf(-expf(p.in[I_DTH][(l * 2 + 1) * 4 + h])) * LOG2E;
    }
    float mrun = -1e30f, lrun = 0.f;
    if (type == 0 || type == 2) { mrun = p.in[I_ASINK][l * 4 + h]; lrun = (fq == 0) ? 1.f : 0.f; }
    f32x4 O[4];
#pragma unroll
    for (int i = 0; i < 4; ++i) O[i] = (f32x4){0.f, 0.f, 0.f, 0.f};

    const int skey = t >> 3, sc8 = (t & 7) * 8;
    const int ksw = skey ^ ((sc8 >> 3) << 3);
    const int ATT_BLK = 3 * 64 * 72;
    const int nstage = (ntiles + 3) >> 2;
    u32x4 kr[4], vr[4];
#define ATT_ROW(ti_) ((type == 2) ? (((ti_) < 8) ? rowbase + (ti_) * 64 : rowbase + 512 + plo + ((ti_) - 8) * 64) : rowbase + (ti_) * 64)
#define ATT_LOAD(sp_) do { _Pragma("unroll") for (int j_ = 0; j_ < 4; ++j_) { const int ti_ = (sp_) * 4 + j_; \
        if (ti_ < ntiles) { const int row_ = ATT_ROW(ti_); \
            kr[j_] = *(const u32x4*)(Kp + (size_t)(row_ + skey) * kld + kcol + sc8); \
            const bool vu_ = (type <= 1) || (type <= 3 && ti_ >= 8);       \
            const bf16_t* vp_ = vu_ ? U + (size_t)((type <= 1 ? row_ : row_ - rowbase - 512 + NCTX + b * 1024) + skey) * INW + vucol + sc8 \
                                    : Vp + (size_t)(row_ + skey) * kld + vcol + sc8; \
            vr[j_] = *(const u32x4*)vp_; } } } while (0)
    ATT_LOAD(0);
    for (int sp = 0; sp < nstage; ++sp) {
        __syncthreads();
#pragma unroll
        for (int j = 0; j < 4; ++j) {
            const int ti = sp * 4 + j;
            if (ti < ntiles) {
                bf16_t* Kd = shm + j * ATT_BLK; bf16_t* Vd = Kd + 64 * 72;
                const u32x4 kvr = kr[j], vvr = vr[j];
                *(u32x4*)(Kd + skey * 72 + sc8) = kvr;
                Vd[(sc8 + 0) * 72 + ksw] = (bf16_t)(vvr.x & 0xffffu); Vd[(sc8 + 1) * 72 + ksw] = (bf16_t)(vvr.x >> 16);
                Vd[(sc8 + 2) * 72 + ksw] = (bf16_t)(vvr.y & 0xffffu); Vd[(sc8 + 3) * 72 + ksw] = (bf16_t)(vvr.y >> 16);
                Vd[(sc8 + 4) * 72 + ksw] = (bf16_t)(vvr.z & 0xffffu); Vd[(sc8 + 5) * 72 + ksw] = (bf16_t)(vvr.z >> 16);
                Vd[(sc8 + 6) * 72 + ksw] = (bf16_t)(vvr.w & 0xffffu); Vd[(sc8 + 7) * 72 + ksw] = (bf16_t)(vvr.w >> 16);
                if (dost) {
                    bf16_t* Xd = Kd + 2 * 64 * 72; const int mpos = ti * 64 + skey;
                    const float wx = sdir == 0 ? fexp2(lgf * (float)(255 - mpos) - 3.f) : fexp2(lgb * (float)mpos - 3.f);
                    const unsigned kw[4] = {kvr.x, kvr.y, kvr.z, kvr.w};
#pragma unroll
                    for (int j2 = 0; j2 < 4; ++j2) {
                        const float klo = __builtin_bit_cast(float, kw[j2] << 16), khi = __builtin_bit_cast(float, kw[j2] & 0xffff0000u);
                        Xd[(sc8 + 2 * j2) * 72 + ksw] = to_bf16(klo * wx); Xd[(sc8 + 2 * j2 + 1) * 72 + ksw] = to_bf16(khi * wx);
                    }
                }
            }
        }
        __syncthreads();
        if (sp + 1 < nstage) ATT_LOAD(sp + 1);
        const int cnt = (ntiles - sp * 4) < 4 ? (ntiles - sp * 4) : 4;
#pragma unroll 1
        for (int j = 0; j < cnt; ++j) {
        const int ti = sp * 4 + j;
        int kpos0; bool masked = false;
        if (type == 2) { if (ti < 8) kpos0 = 0; else { kpos0 = plo + (ti - 8) * 64; masked = true; } }
        else kpos0 = ti * 64;
        const bf16_t* Ks = shm + j * ATT_BLK;
        const bf16_t* VT = Ks + 64 * 72;
        f32x4 st[4];
#pragma unroll
        for (int kt = 0; kt < 4; ++kt) {
            st[kt] = (f32x4){0.f, 0.f, 0.f, 0.f};
#pragma unroll
            for (int dh = 0; dh < 2; ++dh) {
                const bf16x8 kf = *(const bf16x8*)(Ks + (kt * 16 + fr) * 72 + dh * 32 + fq * 8);
                st[kt] = __builtin_amdgcn_mfma_f32_16x16x32_bf16(kf, qf[dh], st[kt], 0, 0, 0);
            }
        }
        float pv[4][4];
        if (!ret) {
            float mx = -1e30f;
#pragma unroll
            for (int kt = 0; kt < 4; ++kt)
#pragma unroll
                for (int r = 0; r < 4; ++r) {
                    float s_ = st[kt][r];
                    if (masked) { const int dlt = kpos0 + kt * 16 + fq * 4 + r - qpos; if (dlt > 128 || dlt < -128) s_ = -1e30f; }
                    pv[kt][r] = s_;
                    mx = fmaxf(mx, s_);
                }
            mx = fmaxf(mx, __shfl_xor(mx, 16)); mx = fmaxf(mx, __shfl_xor(mx, 32));
            const float mnew = fmaxf(mrun, mx);
            const float alpha = fexp2((mrun - mnew) * LOG2E);
            const float mb = mnew * LOG2E;
            float ps = 0.f;
#pragma unroll
            for (int kt = 0; kt < 4; ++kt)
#pragma unroll
                for (int r = 0; r < 4; ++r) {
                    const float s_ = pv[kt][r];
                    float e = fexp2(s_ * LOG2E - mb);
                    if (masked) e = (s_ <= -1e29f) ? 0.f : e;
                    pv[kt][r] = e; ps += e;
                }
            lrun = lrun * alpha + ps; mrun = mnew;
#pragma unroll
            for (int i = 0; i < 4; ++i) O[i] *= alpha;
        } else {
#pragma unroll
            for (int kt = 0; kt < 4; ++kt)
#pragma unroll
                for (int r = 0; r < 4; ++r) {
                    const int dlt = qpos - (kpos0 + kt * 16 + fq * 4 + r);
                    const float w = dlt > 0 ? fexp2(lgf * (float)dlt - 3.f) : (dlt < 0 ? fexp2(-lgb * (float)dlt - 3.f) : 0.25f);
                    pv[kt][r] = st[kt][r] * w;
                }
        }
#pragma unroll
        for (int pr = 0; pr < 2; ++pr) {
            u32x4 pw;
            pw.x = pk_bf16(pv[2 * pr][0], pv[2 * pr][1]); pw.y = pk_bf16(pv[2 * pr][2], pv[2 * pr][3]);
            pw.z = pk_bf16(pv[2 * pr + 1][0], pv[2 * pr + 1][1]); pw.w = pk_bf16(pv[2 * pr + 1][2], pv[2 * pr + 1][3]);
            const bf16x8 pf = __builtin_bit_cast(bf16x8, pw);
#pragma unroll
            for (int dt = 0; dt < 4; ++dt) {
                const int vsw = ((2 * dt + (fr >> 3)) & 7) << 3;
                const u32x2 lo = *(const u32x2*)(VT + (dt * 16 + fr) * 72 + (((2 * pr) * 16 + fq * 4) ^ vsw));
                const u32x2 hi = *(const u32x2*)(VT + (dt * 16 + fr) * 72 + (((2 * pr + 1) * 16 + fq * 4) ^ vsw));
                u32x4 vw; vw.x = lo.x; vw.y = lo.y; vw.z = hi.x; vw.w = hi.y;
                O[dt] = __builtin_amdgcn_mfma_f32_16x16x32_bf16(__builtin_bit_cast(bf16x8, vw), pf, O[dt], 0, 0, 0);
            }
        }
        if (dost) {
            const bf16_t* KX = Ks + 2 * 64 * 72;
            const int dtw = wid & 3, vt0 = (wid >> 2) * 2;
            const int dsw = ((2 * dtw + (fr >> 3)) & 7) << 3;
#pragma unroll
            for (int ms = 0; ms < 2; ++ms) {
                const bf16x8 bx_ = *(const bf16x8*)(KX + (dtw * 16 + fr) * 72 + ((ms * 32 + fq * 8) ^ dsw));
#pragma unroll
                for (int vi = 0; vi < 2; ++vi) {
                    const int vt = vt0 + vi;
                    const int vsw2 = ((2 * vt + (fr >> 3)) & 7) << 3;
                    const bf16x8 af_ = *(const bf16x8*)(VT + (vt * 16 + fr) * 72 + ((ms * 32 + fq * 8) ^ vsw2));
                    SX[vi] = __builtin_amdgcn_mfma_f32_16x16x32_bf16(af_, bx_, SX[vi], 0, 0, 0);
                }
            }
        }
        }
    }
#undef ATT_ROW
#undef ATT_LOAD
    if (dost) {
        const int dtw = wid & 3, vt0 = (wid >> 2) * 2;
#pragma unroll
        for (int vi = 0; vi < 2; ++vi) {
            const size_t o = (size_t)(dtw * 16 + fr) * 64 + (vt0 + vi) * 16 + fq * 4;
            *(f32x4*)(p.out + O_SD + ((((size_t)b * 2 + l) * 2 + sdir) * 4 + h) * 4096 + o) = SX[vi];
        }
    }
    bf16_t* op = MIX + (size_t)qtok * DM + ocol + fq * 4;
    if (!ret) {
        float ls = lrun; ls += __shfl_xor(ls, 16); ls += __shfl_xor(ls, 32);
        const float inv = 1.f / ls;
#pragma unroll
        for (int dt = 0; dt < 4; ++dt) {
            u32x2 w; w.x = pk_bf16(O[dt][0] * inv, O[dt][1] * inv); w.y = pk_bf16(O[dt][2] * inv, O[dt][3] * inv);
            *(u32x2*)(op + dt * 16) = w;
        }
    } else {
        if (type == 5) {
            __syncthreads();
            {
                bf16_t* S0T = shm;
#pragma unroll
                for (int i = 0; i < 4; ++i) {
                    const int id = i * 512 + t, dir = id >> 10, rem = id & 1023, d = rem >> 4, v4 = (rem & 15) * 4;
                    const f32x4 sv = *(const f32x4*)(p.in[I_SD] + ((((size_t)b * 2 + l) * 2 + dir) * 4 + h) * 4096 + d * 64 + v4);
                    bf16_t* dstp = S0T + dir * (64 * 72) + v4 * 72 + d;
                    dstp[0] = to_bf16(sv[0]); dstp[72] = to_bf16(sv[1]); dstp[144] = to_bf16(sv[2]); dstp[216] = to_bf16(sv[3]);
                }
            }
            __syncthreads();
#pragma unroll
            for (int dir = 0; dir < 2; ++dir) {
                const bf16_t* S0T = shm + dir * (64 * 72);
                const float wq = dir == 0 ? exp2f(lgf * (float)(qpos + 1)) : exp2f(lgb * (float)(1024 - qpos));
#pragma unroll
                for (int dt = 0; dt < 4; ++dt) {
                    f32x4 tmp = (f32x4){0.f, 0.f, 0.f, 0.f};
#pragma unroll
                    for (int dh = 0; dh < 2; ++dh) {
                        const bf16x8 sf = *(const bf16x8*)(S0T + (dt * 16 + fr) * 72 + dh * 32 + fq * 8);
                        tmp = __builtin_amdgcn_mfma_f32_16x16x32_bf16(sf, qf[dh], tmp, 0, 0, 0);
                    }
                    O[dt] += tmp * wq;
                }
            }
        }
        float ss = 0.f;
#pragma unroll
        for (int dt = 0; dt < 4; ++dt) ss += O[dt][0] * O[dt][0] + O[dt][1] * O[dt][1] + O[dt][2] * O[dt][2] + O[dt][3] * O[dt][3];
        ss += __shfl_xor(ss, 16); ss += __shfl_xor(ss, 32);
        const float rstd = rsqrtf(ss * (1.f / 64.f) + 1e-6f);
#pragma unroll
        for (int dt = 0; dt < 4; ++dt) {
            const int dcol = h * 64 + dt * 16 + fq * 4;
            const f32x4 gn = *(const f32x4*)(p.in[I_DNG] + l * 256 + dcol);
            const f32x4 dg = ldb4(U + (size_t)qtok * INW + 2304 + dcol);
            float o[4];
#pragma unroll
            for (int r = 0; r < 4; ++r) o[r] = O[dt][r] * rstd * gn[r] * siluf_(dg[r]);
            u32x2 w; w.x = pk_bf16(o[0], o[1]); w.y = pk_bf16(o[2], o[3]);
            *(u32x2*)(op + dt * 16) = w;
        }
    }
}

DEVI void scan_unit(const Ctx& p, int l, int tt) {
    const int t = opaque_tid(), ch = t & 255, dir = t >> 8;
    const float* CA = (const float*)(p.ws + OFF_CA);
    const float* CB = (const float*)(p.ws + OFF_CB);
    const float* TA = (const float*)(p.ws + OFF_TA);
    const float* TB = (const float*)(p.ws + OFF_TB);
    const bf16_t* U = (const bf16_t*)(p.ws + OFF_U);
    bf16_t* MIX = (bf16_t*)(p.ws + OFF_MIX);
    int tile0, tl, nts, sq; float h = 0.f;
    if (tt < 64) { sq = tt >> 2; tile0 = sq * 4; tl = tt & 3; nts = 4; }
    else { const int b = (tt - 64) >> 4; sq = 16 + b; tile0 = 64 + b * 16; tl = (tt - 64) & 15; nts = 16; h = p.in[I_SC][(((size_t)b * 2 + l) * 2 + dir) * 256 + ch]; }
    const int tok0 = tt * 64;
    {
        float ta[16], tb[16];
#pragma unroll
        for (int k = 0; k < 16; ++k) {
            int tk = dir == 0 ? k : nts - 1 - k;
            tk = tk < 0 ? 0 : (tk > nts - 1 ? nts - 1 : tk);
            ta[k] = TA[((size_t)dir * 96 + tile0 + tk) * 256 + ch]; tb[k] = TB[((size_t)dir * 96 + tile0 + tk) * 256 + ch];
        }
        const int npre = dir == 0 ? tl : nts - 1 - tl;
#pragma unroll
        for (int k = 0; k < 16; ++k) if (k < npre) h = ta[k] * h + tb[k];
    }
    const unsigned* abp = (const unsigned*)CA + ((size_t)dir * NTOK + tok0) * 256 + ch;
    float* hp = (float*)shm + dir * (64 * 256) + ch;
    unsigned wv[64];
#pragma unroll
    for (int j = 0; j < 64; ++j) wv[j] = abp[(size_t)j * 256];
    if (dir == 0) {
#pragma unroll
        for (int j = 0; j < 64; ++j) { h = (1.f - __builtin_bit_cast(float, wv[j] << 16)) * h + __builtin_bit_cast(float, wv[j] & 0xffff0000u); hp[(size_t)j * 256] = h; }
    } else {
#pragma unroll
        for (int j = 63; j >= 0; --j) { h = (1.f - __builtin_bit_cast(float, wv[j] << 16)) * h + __builtin_bit_cast(float, wv[j] & 0xffff0000u); hp[(size_t)j * 256] = h; }
    }
    if (tt < 64 && ((dir == 0 && tl == 3) || (dir == 1 && tl == 0))) p.out[O_SC + (((size_t)sq * 2 + l) * 2 + dir) * 256 + ch] = h;
    __syncthreads();
    const float* H0 = (const float*)shm;
    const float* H1 = H0 + 64 * 256;
#pragma unroll
    for (int i = 0; i < 8; ++i) {
        const int idx = i * 512 + t;
        const int tk = idx >> 6, c4 = (idx & 63) * 4;
        const f32x4 a = *(const f32x4*)(H0 + (size_t)tk * 256 + c4), b = *(const f32x4*)(H1 + (size_t)tk * 256 + c4);
        const f32x4 cy = ldb4(U + (size_t)(tok0 + tk) * INW + 1280 + c4);
        float o[4];
#pragma unroll
        for (int r = 0; r < 4; ++r) {
            const float x = cy[r];
            const float z2 = 1.5957691216057308f * (x + 0.044715f * x * x * x);
            const float ge = x * __builtin_amdgcn_rcpf(1.f + __expf(-z2));
            o[r] = (a[r] + b[r]) * ge;
        }
        u32x2 w; w.x = pk_bf16(o[0], o[1]); w.y = pk_bf16(o[2], o[3]);
        *(u32x2*)(MIX + (size_t)(tok0 + tk) * DM + 512 + c4) = w;
    }
}

DEVI void mixer_phase(const Ctx& p, int l, volatile LAS int* s_unit, int slot) {
    const int NU = 672;
    const int nq = gridDim.x >= 8 ? 8 : 1, q = blockIdx.x % nq;
    unsigned* ctr = (unsigned*)(p.ws + OFF_CTRL) + 4096 + 64 * (slot * 8 + q);
    const int base = (int)gridDim.x < NU ? (int)gridDim.x : NU;
    bool first = true;
    for (;;) {
        int u;
        if (first) { u = blockIdx.x; first = false; if (u >= NU) break; }
        else {
            __syncthreads();
            if (threadIdx.x == 0) *s_unit = base + (int)atomicAdd(ctr, 1u) * nq + q;
            __syncthreads();
            u = *s_unit;
            if (u >= NU) break;
        }
#ifdef MIX_LO
        if (slot >= 2 && (u < MIX_LO || u >= MIX_HI)) continue;
#endif
        if (u < 64) attn_unit(p, l, 3, u);
        else if (u < 128) attn_unit(p, l, 5, u - 64);
        else if (u < 192) attn_unit(p, l, 2, u - 128);
        else if (u < 288) scan_unit(p, l, u - 192);
        else if (u < 416) attn_unit(p, l, 4, u - 288);
        else if (u < 544) attn_unit(p, l, 0, u - 416);
        else attn_unit(p, l, 1, u - 544);
    }
}

__global__ void __launch_bounds__(512, 2) fwd_megakernel(Params P, int ph_lo, int ph_hi) {
    __shared__ uint4 s_ctl[2];
    if (threadIdx.x == 0) {
        s_ctl[0] = make_uint4(0u, 0u, 0u, 0u); s_ctl[1] = make_uint4(0u, 0u, 0u, 0u);
        const float** tabw = (const float**)(P.ws + OFF_TAB) + (size_t)blockIdx.x * 64;
#pragma unroll
        for (int i = 0; i < N_IN; ++i) tabw[i] = P.in[i];
        __threadfence();
    }
    __syncthreads();
    if (P.never) cg::this_grid().sync();
    XcdBarrier xb;
    const bool multi = (ph_hi - ph_lo) > 1;
    if (multi) xb = xcd_barrier_post((unsigned*)(P.ws + OFF_CTRL), (volatile LAS unsigned*)&s_ctl[0]);
    volatile LAS int* s_unit = (volatile LAS int*)&s_ctl[1];
#ifndef PH_MASK
#define PH_MASK 63
#endif
#ifndef DUP_MASK
#define DUP_MASK 0
#endif
    for (int ph2 = ph_lo * 2; ph2 < ph_hi * 2; ++ph2) {
        const int ph = ph2 >> 1, rep = ph2 & 1;
        if (rep) {
            const int kk = (ph >= 1 && ph < 23) ? (ph - 1) % 11 : -1;
            const bool dup = (ph == 0) ? (DUP_MASK & 1) : (ph == 23 || kk == 0 || kk == 3 || kk == 8) ? (DUP_MASK & 2) : (kk == 5) ? (DUP_MASK & 4) : (kk == 6) ? (DUP_MASK & 8) : (kk == 1 || kk == 2 || kk == 4 || kk == 7 || kk == 9 || kk == 10) ? (DUP_MASK & 16) : false;
            if (!dup) continue;
        }
        if (ph2 > ph_lo * 2) xcd_barrier(xb);
        Ctx p;
        p.ws = P.ws; p.out = P.out; p.in = (const float* const*)(P.ws + OFF_TAB) + (size_t)blockIdx.x * 64;
        asm volatile("" : "+s"(p.ws), "+s"(p.out), "+s"(p.in) :: "memory");
        if (ph == 0) { if (PH_MASK & 1) prologue_phase(p); continue; }
        if (ph == 23) { if (PH_MASK & 2) norm_phase(p, 1, 4, rep); continue; }
        const int l = (ph - 1) / 11, k = (ph - 1) % 11;
        const unsigned char* wl = p.ws + OFF_W + (size_t)l * W_LAYER;
        if (k == 0 || k == 3 || k == 8) { if (PH_MASK & 2) norm_phase(p, l, k == 0 ? 1 : (k == 3 ? 2 : 3), rep); }
        else if (k == 5) { if (PH_MASK & 4) prep_phase(p, l); }
        else if (k == 6) { if (PH_MASK & 8) mixer_phase(p, l, s_unit, l + 2 * rep); }
        else if (PH_MASK & 16) {
            GemmDesc g;
            g.nM = NTOK / 256;
            if (k == 1 || k == 9) { g.A = (const bf16_t*)(p.ws + OFF_H); g.Bt = (const bf16_t*)(wl + (k == 1 ? WL_GU1 : WL_GU2)); g.K = 1024; g.nN = 22; g.S = 1; g.nt = 16; g.epi = EPI_GU; g.out = p.ws + OFF_ACT; }
            else if (k == 2 || k == 10) { g.A = (const bf16_t*)(p.ws + OFF_ACT); g.Bt = (const bf16_t*)(wl + (k == 2 ? WL_D1 : WL_D2)); g.K = 2816; g.nN = 4; g.S = 2; g.nt = 22; g.epi = EPI_PART; g.out = p.ws + OFF_U; }
            else if (k == 4) { g.A = (const bf16_t*)(p.ws + OFF_H); g.Bt = (const bf16_t*)(wl + WL_IN); g.K = 1024; g.nN = 10; g.S = 1; g.nt = 16; g.epi = EPI_U; g.out = p.ws + OFF_U; }
            else { g.A = (const bf16_t*)(p.ws + OFF_MIX); g.Bt = (const bf16_t*)(wl + WL_OUT); g.K = 1024; g.nN = 4; g.S = 2; g.nt = 8; g.epi = EPI_PART; g.out = p.ws + OFF_U; }
            gemm_phase(g);
            if (rep == 0 && gridDim.x == 256) {
                int lo = CONV_C0, per = 0;
                for (int q = 1; q <= ph; ++q) {
                    const int kq = (q - 1) % 11;
                    const int sup = (kq == 1 || kq == 9) ? 480 : (kq == 2 || kq == 10) ? 192 : (kq == 4) ? 32 : (kq == 7) ? 64 : 0;
                    if (q < ph) lo += sup; else per = (kq == 1 || kq == 9) ? 2 : (kq == 2 || kq == 10) ? 3 : (kq == 4) ? 2 : 1;
                }
                const int Ug = g.nM * g.nN * g.S, nfull = Ug % (int)gridDim.x;
                if (nfull != 0 && (int)blockIdx.x >= nfull && lo < NTR_UNITS) {
                    const int nidle = (int)gridDim.x - nfull;
                    int hi = lo + per * nidle; if (hi > NTR_UNITS) hi = NTR_UNITS;
                    convert_fill(p, lo, hi, (int)blockIdx.x - nfull, nidle, per);
                }
            }
        }
    }
}

extern "C" void kernel_launch(void* const* d_in, const int* in_sizes, int n_in, void* d_out, int out_size, void* d_ws, size_t ws_size, hipStream_t stream) {
    Params p{};
    for (int i = 0; i < N_IN; ++i) p.in[i] = (const float*)d_in[i];
    p.out = (float*)d_out;
    p.ws = (unsigned char*)d_ws;
    p.never = 0; p.pad = 0;
    static int grid_blocks = 0;
    if (!grid_blocks) {
        (void)hipFuncSetAttribute((const void*)fwd_megakernel, hipFuncAttributeMaxDynamicSharedMemorySize, SHM_BYTES);
        int dev = 0, cus = 0, per_cu = 0;
        (void)hipGetDevice(&dev);
        (void)hipDeviceGetAttribute(&cus, hipDeviceAttributeMultiprocessorCount, dev);
        (void)hipOccupancyMaxActiveBlocksPerMultiprocessor(&per_cu, fwd_megakernel, 512, SHM_BYTES);
        if (per_cu < 1) fprintf(stderr, "occupancy query returned %d\n", per_cu);
        grid_blocks = cus;
    }
    (void)hipMemsetAsync(d_ws, 0, CTRL_BYTES, stream);
#if MK_MULTI
    for (int ph = 0; ph < NPHASE; ++ph)
        fwd_megakernel<<<dim3(grid_blocks), dim3(512), SHM_BYTES, stream>>>(p, ph, ph + 1);
#else
    int lo = 0, hi = NPHASE;
    void* args[] = {&p, &lo, &hi};
    hipError_t e = hipLaunchCooperativeKernel((const void*)fwd_megakernel, dim3(grid_blocks), dim3(512), args, SHM_BYTES, stream);
    if (e != hipSuccess) fprintf(stderr, "cooperative launch failed: %s (grid %d)\n", hipGetErrorString(e), grid_blocks);
#endif
}
```

```cpp
#include <hip/hip_runtime.h>
#include <hip/hip_cooperative_groups.h>
#include <cstdint>
#include <cstdio>
namespace cg = cooperative_groups;

#ifndef MK_MULTI
#define MK_MULTI 0
#endif

#define DEVI __device__ __forceinline__
#define LAS __attribute__((address_space(3)))

typedef unsigned short bf16_t;
typedef short bf16x8 __attribute__((ext_vector_type(8)));
typedef float f32x4 __attribute__((ext_vector_type(4)));
typedef float f32x2 __attribute__((ext_vector_type(2)));
typedef unsigned u32x4 __attribute__((ext_vector_type(4)));
typedef unsigned u32x2 __attribute__((ext_vector_type(2)));

constexpr int NTOK = 6144, NCTX = 4096, DM = 1024, DFF = 2816, INW = 2560;
constexpr int NKROW = 7168;
constexpr float LOG2E = 1.4426950408889634f;

enum { I_XP = 0, I_XS, I_CAK, I_CAV, I_CBK, I_CBV, I_SC, I_SD, I_C, I_CCTX, I_N1, I_N2, I_N3, I_WMOD, I_BMOD,
       I_F1G, I_F1U, I_F1D, I_F2G, I_F2U, I_F2D, I_WIN, I_WOUT, I_AQN, I_AKN, I_ASINK, I_BQN, I_BKN,
       I_CCW, I_CCB, I_CWA, I_CBA, I_CWX, I_CBX, I_CLAM, I_DTH, I_DNG, N_IN };

constexpr size_t O_YP = 0, O_YS = 4194304, O_CAK = 6291456, O_CAV = 7340032, O_CBK = 8388608, O_CBV = 9437184,
                 O_SC = 10485760, O_SD = 10502144;

constexpr size_t OFF_CTRL = 0;
constexpr size_t CTRL_BYTES = 65536;
constexpr size_t OFF_TAB = CTRL_BYTES;
constexpr size_t OFF_MOD = OFF_TAB + 131072;
constexpr size_t OFF_W = OFF_MOD + 262144;
constexpr size_t W_GU = (size_t)5632 * 1024 * 2, W_D = (size_t)1024 * 2816 * 2, W_IN = (size_t)2560 * 1024 * 2, W_OUT = (size_t)1024 * 1024 * 2;
constexpr size_t WL_GU1 = 0, WL_D1 = WL_GU1 + W_GU, WL_IN = WL_D1 + W_D, WL_OUT = WL_IN + W_IN, WL_GU2 = WL_OUT + W_OUT, WL_D2 = WL_GU2 + W_GU, W_LAYER = WL_D2 + W_D;
constexpr size_t OFF_H = OFF_W + 2 * W_LAYER;
constexpr size_t OFF_ACT = OFF_H + (size_t)NTOK * 1024 * 2;
constexpr size_t OFF_U = OFF_ACT + (size_t)NTOK * 2816 * 2;
constexpr size_t OFF_MIX = OFF_U + (size_t)NTOK * 2560 * 4;
constexpr size_t OFF_QA = OFF_MIX + (size_t)NTOK * 1024 * 2;
constexpr size_t OFF_QB = OFF_QA + (size_t)NTOK * 256 * 2;
constexpr size_t OFF_KA = OFF_QB + (size_t)NTOK * 256 * 2;
constexpr size_t OFF_VA = OFF_KA + (size_t)NKROW * 128 * 2;
constexpr size_t OFF_KB = OFF_VA + (size_t)NKROW * 128 * 2;
constexpr size_t OFF_VB = OFF_KB + (size_t)NKROW * 128 * 2;
constexpr size_t OFF_DQ = OFF_VB + (size_t)NKROW * 128 * 2;
constexpr size_t OFF_DK = OFF_DQ + (size_t)NTOK * 256 * 2;
constexpr size_t OFF_DV = OFF_DK + (size_t)NTOK * 256 * 2;
constexpr size_t OFF_CA = OFF_DV + (size_t)NTOK * 256 * 2;
constexpr size_t OFF_CB = OFF_CA + (size_t)2 * NTOK * 256 * 4;
constexpr size_t OFF_HF = OFF_CB + (size_t)2 * NTOK * 256 * 4;
constexpr size_t OFF_TA = OFF_HF + (size_t)2 * NTOK * 256 * 4;
constexpr size_t OFF_TB = OFF_TA + (size_t)2 * 96 * 256 * 4;
constexpr size_t OFF_CWT = OFF_TB + (size_t)2 * 96 * 256 * 4;
constexpr size_t OFF_XB = OFF_CWT + (size_t)2 * 4 * 4 * 4096 * 2;
constexpr size_t WS_TOTAL = OFF_XB + (size_t)NTOK * 1024 * 2;
static_assert(WS_TOTAL < (size_t)300 * 1024 * 1024, "workspace too large");

constexpr int SHM_BYTES = 131072;
constexpr int NPHASE = 24;

struct Params {
    const float* in[N_IN];
    float* out;
    unsigned char* ws;
    int never;
    int pad;
};

struct Ctx { const float* const* in; float* out; unsigned char* ws; };

extern __shared__ __attribute__((aligned(16))) bf16_t shm[];

DEVI unsigned pk_bf16(float lo, float hi) { unsigned r; asm("v_cvt_pk_bf16_f32 %0, %1, %2" : "=v"(r) : "v"(lo), "v"(hi)); return r; }
DEVI bf16_t to_bf16(float x) { return (bf16_t)(pk_bf16(x, 0.f) & 0xffffu); }
DEVI f32x4 ldb4(const bf16_t* p) {
    const u32x2 w = *(const u32x2*)p; f32x4 r;
    r[0] = __builtin_bit_cast(float, w.x << 16); r[1] = __builtin_bit_cast(float, w.x & 0xffff0000u);
    r[2] = __builtin_bit_cast(float, w.y << 16); r[3] = __builtin_bit_cast(float, w.y & 0xffff0000u);
    return r;
}
DEVI float wave_sum(float v) {
#pragma unroll
    for (int o = 32; o > 0; o >>= 1) v += __shfl_xor(v, o);
    return v;
}
DEVI int opaque_tid() { int t = threadIdx.x; asm volatile("" : "+v"(t)); return t; }
DEVI float fexp2(float x) { return __builtin_amdgcn_exp2f(x); }
DEVI float sigmoidf_(float x) { return __builtin_amdgcn_rcpf(1.f + __expf(-x)); }
DEVI float siluf_(float x) { return x * sigmoidf_(x); }

#define XB_TMO      128
#define XB_XCNT(j)  (256  + 64 * (j))
#define XB_XSUB(j)  (1280 + 64 * (j))
#define XB_XGEN(j)  (2304 + 64 * (j))
#define XB_TOP      3328
#define XB_TOPGEN   3392
#define XCD_BAR_WORDS 3456
#define XB_SPIN_CAP (1u << 20)
DEVI unsigned xb_ld(unsigned* p) { return __hip_atomic_load(p, __ATOMIC_RELAXED, __HIP_MEMORY_SCOPE_AGENT); }
DEVI unsigned xb_add(unsigned* p, unsigned v) { return __hip_atomic_fetch_add(p, v, __ATOMIC_RELAXED, __HIP_MEMORY_SCOPE_AGENT); }
DEVI unsigned xb_xcc_id() { return (unsigned)__builtin_amdgcn_s_getreg((3 << 11) | 20) & 0xFu; }
#define XB_SPIN(cond, bar) do { unsigned _sp = 0; while (cond) { __builtin_amdgcn_s_sleep(1); \
    if ((++_sp & 255u) == 0u) { if (xb_ld(&(bar)[XB_TMO])) break; if (_sp > XB_SPIN_CAP) { atomicAdd(&(bar)[XB_TMO], 1u); break; } } } } while (0)
struct XcdBarrier { unsigned* bar; unsigned x; volatile LAS unsigned* st; };
DEVI XcdBarrier xcd_barrier_post(unsigned* bar, volatile LAS unsigned* st) {
    XcdBarrier b; b.bar = bar; b.x = xb_xcc_id(); b.st = st;
    if (threadIdx.x == 0) (void)xb_add(&bar[XB_XCNT(b.x)], 1u);
    return b;
}
DEVI void xcd_barrier_complete(unsigned* bar, unsigned x, unsigned& nloc, unsigned& nx) {
    const unsigned G = gridDim.x * gridDim.y * gridDim.z;
    unsigned sum, cnt, mine, sp = 0u;
    for (;;) {
        sum = 0u; cnt = 0u; mine = 0u;
#pragma unroll
        for (unsigned j = 0; j < 16; ++j) { const unsigned c = xb_ld(&bar[XB_XCNT(j)]); sum += c; cnt += (c > 0u) ? 1u : 0u; mine = (j == x) ? c : mine; }
        if (sum == G) break;
        __builtin_amdgcn_s_sleep(1);
        if ((++sp & 255u) == 0u) { if (xb_ld(&bar[XB_TMO])) break; if (sp > XB_SPIN_CAP) { atomicAdd(&bar[XB_TMO], 1u); break; } }
    }
    nloc = mine > 0u ? mine : 1u; nx = cnt > 0u ? cnt : 1u;
}
DEVI void xcd_barrier(const XcdBarrier& b) {
    asm volatile("s_waitcnt vmcnt(0)" ::: "memory");
    __syncthreads();
    if (threadIdx.x == 0) {
        unsigned* bar = b.bar;
        asm volatile("" : "+s"(bar));
        __builtin_amdgcn_s_waitcnt(0);
        unsigned nloc = b.st[0], nx = b.st[1];
        if (nloc == 0u) { xcd_barrier_complete(bar, b.x, nloc, nx); b.st[0] = nloc; b.st[1] = nx; }
        const unsigned old = xb_add(&bar[XB_XSUB(b.x)], 1u);
        const unsigned gen = old / nloc;
        if (old + 1u == (gen + 1u) * nloc) {
            __builtin_amdgcn_fence(__ATOMIC_RELEASE, "agent");
            asm volatile("s_waitcnt vmcnt(0)" ::: "memory");
            const unsigned og = xb_add(&bar[XB_TOP], 1u);
            const unsigned tg = og / nx;
            if (og + 1u == (tg + 1u) * nx) xb_add(&bar[XB_TOPGEN], 1u);
            else XB_SPIN(xb_ld(&bar[XB_TOPGEN]) == tg, bar);
            __builtin_amdgcn_fence(__ATOMIC_ACQUIRE, "agent");
            xb_add(&bar[XB_XGEN(b.x)], 1u);
            asm volatile("s_waitcnt vmcnt(0)" ::: "memory");
        } else {
            XB_SPIN(xb_ld(&bar[XB_XGEN(b.x)]) == gen, bar);
            __builtin_amdgcn_fence(__ATOMIC_ACQUIRE, "agent");
            asm volatile("s_waitcnt vmcnt(0)" ::: "memory");
        }
    }
    __syncthreads();
}

constexpr int BM = 256, BK = 64, HALF = 128, HTB = HALF * BK * 2;
DEVI int lds_byte(int r, int c) { const int st = (r >> 4) * 2 + (c >> 5), rr = r & 15, cc = c & 31, ob = rr * 64 + cc * 2; return st * 1024 + (ob ^ (((ob >> 9) & 1) << 5)); }
DEVI void stage_rc(int b, int& R, int& C) { const int st = b / 1024, sb = b % 1024, swz = sb ^ (((sb >> 9) & 1) << 5); R = (st >> 1) * 16 + swz / 64; C = (st & 1) * 32 + (swz % 64) / 2; }

enum { EPI_GU = 0, EPI_PART = 1, EPI_U = 2 };
struct GemmDesc { const bf16_t* A; const bf16_t* Bt; int K; int nM, nN, S, nt; int epi; void* out; };
struct Unit { int pm, pn, ks; };

DEVI bool gemm_next(const GemmDesc& g, int i, Unit& u) {
    const int nwg = g.nM * g.nN;
    const long L = (long)i * gridDim.x + blockIdx.x;
    if (L >= (long)nwg * g.S) return false;
    u.ks = (int)(L / nwg);
    int wgid = (int)(L % nwg);
    { const int q = nwg / 8, r = nwg % 8, xcd = wgid % 8, off = wgid / 8; wgid = (xcd < r ? xcd * (q + 1) : r * (q + 1) + (xcd - r) * q) + off; }
    const int WGM = 4;
    const int nig = WGM * g.nN, gid = wgid / nig, fm = gid * WGM, gsz = (g.nM - fm) < WGM ? (g.nM - fm) : WGM;
    u.pm = fm + ((wgid % nig) % gsz); u.pn = (wgid % nig) / gsz;
    return true;
}

DEVI void gemm_epilogue(const GemmDesc& g, const f32x4 (&acc)[2][2][4][2], const Unit& u, int wr, int wc, int fr, int fq) {
    const int brow = u.pm * BM, bcol = u.pn * BM;
    if (g.epi == EPI_GU) {
        bf16_t* act = (bf16_t*)g.out;
#pragma unroll
        for (int ai = 0; ai < 2; ++ai)
#pragma unroll
            for (int m = 0; m < 4; ++m) {
                const int row = brow + ai * HALF + wr * 64 + m * 16 + fr;
                const int hcol = u.pn * 128 + wc * 32 + fq * 8;
                u32x4 w;
                { const f32x4 gt = acc[ai][0][m][0], up = acc[ai][1][m][0];
                  w.x = pk_bf16(siluf_(gt[0]) * up[0], siluf_(gt[1]) * up[1]); w.y = pk_bf16(siluf_(gt[2]) * up[2], siluf_(gt[3]) * up[3]); }
                { const f32x4 gt = acc[ai][0][m][1], up = acc[ai][1][m][1];
                  w.z = pk_bf16(siluf_(gt[0]) * up[0], siluf_(gt[1]) * up[1]); w.w = pk_bf16(siluf_(gt[2]) * up[2], siluf_(gt[3]) * up[3]); }
                *(u32x4*)(act + (size_t)row * DFF + hcol) = w;
            }
    } else if (g.epi == EPI_PART) {
        bf16_t* o = (bf16_t*)g.out + (size_t)u.ks * NTOK * DM;
#pragma unroll
        for (int ai = 0; ai < 2; ++ai)
#pragma unroll
            for (int m = 0; m < 4; ++m) {
                const int row = brow + ai * HALF + wr * 64 + m * 16 + fr;
#pragma unroll
                for (int bj = 0; bj < 2; ++bj) {
                    const int col = bcol + bj * HALF + wc * 32 + fq * 8;
                    const f32x4 v0 = acc[ai][bj][m][0], v1 = acc[ai][bj][m][1];
                    u32x4 w; w.x = pk_bf16(v0[0], v0[1]); w.y = pk_bf16(v0[2], v0[3]); w.z = pk_bf16(v1[0], v1[1]); w.w = pk_bf16(v1[2], v1[3]);
                    *(u32x4*)(o + (size_t)row * DM + col) = w;
                }
            }
    } else {
        bf16_t* o = (bf16_t*)g.out;
#pragma unroll
        for (int ai = 0; ai < 2; ++ai)
#pragma unroll
            for (int m = 0; m < 4; ++m) {
                const int row = brow + ai * HALF + wr * 64 + m * 16 + fr;
#pragma unroll
                for (int bj = 0; bj < 2; ++bj) {
                    const int col = bcol + bj * HALF + wc * 32 + fq * 8;
                    const f32x4 v0 = acc[ai][bj][m][0], v1 = acc[ai][bj][m][1];
                    u32x4 w; w.x = pk_bf16(v0[0], v0[1]); w.y = pk_bf16(v0[2], v0[3]); w.z = pk_bf16(v1[0], v1[1]); w.w = pk_bf16(v1[2], v1[3]);
                    *(u32x4*)(o + (size_t)row * INW + col) = w;
                }
            }
    }
}

DEVI void gemm_phase(const GemmDesc g) {
    LAS unsigned char* lds = (LAS unsigned char*)shm;
    const int tid = opaque_tid(), wid = __builtin_amdgcn_readfirstlane(tid >> 6), lane = tid & 63, wr = wid >> 2, wc = wid & 3, fr = lane & 15, fq = lane >> 4;
    const int K = g.K, nt = g.nt;
    unsigned voffA[2], voffB[2];
#pragma unroll
    for (int i = 0; i < 2; ++i) { int R, C; stage_rc(tid * 16 + i * 8192, R, C); voffA[i] = (unsigned)(R * K + C) * 2u;
        const int rho = R & 31, pr = 8 * ((rho & 15) >> 2) + 4 * (rho >> 4) + (rho & 3); voffB[i] = (unsigned)(((R & ~31) + pr) * K + C) * 2u; }
    const size_t kstep = (size_t)(BK * 2);
    const size_t hstep = (size_t)HALF * K * 2;
    const size_t tstep = 2 * hstep;
    const size_t sstep = (size_t)nt * kstep;
    const unsigned ldsw = (unsigned)wid * 1024u;
    const int aoff = lds_byte(wr * 64 + fr, fq * 8), boff = lds_byte(wc * 32 + fr, fq * 8);
#define PG8_SA(b, h) (((b) * 2 + (h)) * HTB)
#define PG8_SB(b, h) ((4 + (b) * 2 + (h)) * HTB)
#define PG8_STAGE(bufoff, gbase, voff) do { _Pragma("unroll") for (int _i = 0; _i < 2; ++_i) \
        __builtin_amdgcn_global_load_lds((const unsigned*)((const char*)(gbase) + (voff)[_i]), (LAS unsigned*)(lds + (bufoff) + ldsw + _i * 8192), 16, 0, 0); } while (0)
#define PG8_LDA(dst, b, h) do { _Pragma("unroll") for (int m = 0; m < 4; ++m) _Pragma("unroll") for (int k = 0; k < 2; ++k) dst[m][k] = *(const LAS bf16x8*)(lds + PG8_SA(b, h) + aoff + m * 2048 + k * 1024); } while (0)
#define PG8_LDB(dst, b, h) do { _Pragma("unroll") for (int n = 0; n < 2; ++n) _Pragma("unroll") for (int k = 0; k < 2; ++k) dst[n][k] = *(const LAS bf16x8*)(lds + PG8_SB(b, h) + boff + n * 2048 + k * 1024); } while (0)
#define PG8_MMA(ai, bj, At, Bt) do { __builtin_amdgcn_s_setprio(1); _Pragma("unroll") for (int m = 0; m < 4; ++m) _Pragma("unroll") for (int n = 0; n < 2; ++n) _Pragma("unroll") for (int k = 0; k < 2; ++k) \
        acc[ai][bj][m][n] = __builtin_amdgcn_mfma_f32_16x16x32_bf16(Bt[n][k], At[m][k], acc[ai][bj][m][n], 0, 0, 0); __builtin_amdgcn_s_setprio(0); } while (0)
#define PG8_WAIT_V(n) asm volatile("s_waitcnt vmcnt(" #n ")" ::: "memory")
#define PG8_WAIT_L(n) asm volatile("s_waitcnt lgkmcnt(" #n ")" ::: "memory")
#define PG8_BAR __builtin_amdgcn_s_barrier()
#define PG8_SCHED __builtin_amdgcn_sched_barrier(0)
    Unit cur, nxt; int ui = 0;
    if (!gemm_next(g, 0, cur)) return;
    f32x4 acc[2][2][4][2];
#pragma unroll
    for (int a = 0; a < 2; ++a)
#pragma unroll
        for (int b = 0; b < 2; ++b)
#pragma unroll
            for (int m = 0; m < 4; ++m)
#pragma unroll
                for (int n = 0; n < 2; ++n) acc[a][b][m][n] = (f32x4){0.f, 0.f, 0.f, 0.f};
    bf16x8 At[4][2], B0[2][2], B1[2][2];
    const char* cA = (const char*)g.A + (size_t)cur.pm * tstep + (size_t)cur.ks * sstep;
    const char* cB = (const char*)g.Bt + (size_t)cur.pn * tstep + (size_t)cur.ks * sstep;
    PG8_STAGE(PG8_SB(0, 0), cB, voffB); PG8_STAGE(PG8_SB(0, 1), cB + hstep, voffB); PG8_STAGE(PG8_SA(0, 0), cA, voffA); PG8_STAGE(PG8_SA(0, 1), cA + hstep, voffA);
    if (wr == 1) PG8_BAR;
    PG8_WAIT_V(2); PG8_BAR;
    PG8_STAGE(PG8_SB(1, 0), cB + kstep, voffB); PG8_STAGE(PG8_SA(1, 0), cA + kstep, voffA); PG8_STAGE(PG8_SB(1, 1), cB + hstep + kstep, voffB);
    PG8_WAIT_V(6); PG8_BAR;
    for (;;) {
        const bool has_next = gemm_next(g, ui + 1, nxt);
        const char* nA = has_next ? (const char*)g.A + (size_t)nxt.pm * tstep + (size_t)nxt.ks * sstep : cA;
        const char* nB = has_next ? (const char*)g.Bt + (size_t)nxt.pn * tstep + (size_t)nxt.ks * sstep : cB;
        for (int t = 0; t < nt; t += 2) {
            const bool last = (t == nt - 2);
            const char* a1 = cA + (size_t)(t + 1) * kstep;
            const char* a2 = last ? nA : cA + (size_t)(t + 2) * kstep; const char* b2 = last ? nB : cB + (size_t)(t + 2) * kstep;
            const char* a3 = a2 + kstep; const char* b3 = b2 + kstep;
            PG8_LDB(B0, 0, 0); PG8_LDB(B1, 0, 1); PG8_SCHED; PG8_LDA(At, 0, 0); PG8_STAGE(PG8_SA(1, 1), a1 + hstep, voffA);
            PG8_WAIT_V(8); PG8_WAIT_L(0); PG8_BAR; PG8_MMA(0, 0, At, B0); PG8_MMA(0, 1, At, B1); PG8_BAR; PG8_SCHED;
            PG8_LDA(At, 0, 1); PG8_STAGE(PG8_SB(0, 0), b2, voffB); PG8_STAGE(PG8_SB(0, 1), b2 + hstep, voffB); PG8_STAGE(PG8_SA(0, 0), a2, voffA);
            PG8_WAIT_V(8); PG8_WAIT_L(0); PG8_BAR; PG8_MMA(1, 0, At, B0); PG8_MMA(1, 1, At, B1); PG8_BAR; PG8_SCHED;
            PG8_LDB(B0, 1, 0); PG8_LDB(B1, 1, 1); PG8_SCHED; PG8_LDA(At, 1, 0); PG8_STAGE(PG8_SA(0, 1), a2 + hstep, voffA);
            PG8_WAIT_V(8); PG8_WAIT_L(0); PG8_BAR; PG8_MMA(0, 0, At, B0); PG8_MMA(0, 1, At, B1); PG8_BAR; PG8_SCHED;
            PG8_LDA(At, 1, 1); PG8_STAGE(PG8_SB(1, 0), b3, voffB); PG8_STAGE(PG8_SB(1, 1), b3 + hstep, voffB); PG8_STAGE(PG8_SA(1, 0), a3, voffA);
            PG8_WAIT_V(8); PG8_WAIT_L(0); PG8_BAR; PG8_MMA(1, 0, At, B0); PG8_MMA(1, 1, At, B1); PG8_BAR; PG8_SCHED;
        }
        if (wr == 0) PG8_BAR;
        gemm_epilogue(g, acc, cur, wr, wc, fr, fq);
        if (!has_next) break;
#pragma unroll
        for (int a = 0; a < 2; ++a)
#pragma unroll
            for (int b = 0; b < 2; ++b)
#pragma unroll
                for (int m = 0; m < 4; ++m)
#pragma unroll
                    for (int n = 0; n < 2; ++n) acc[a][b][m][n] = (f32x4){0.f, 0.f, 0.f, 0.f};
        cur = nxt; cA = nA; cB = nB; ++ui;
        if (wr == 1) PG8_BAR;
    }
    PG8_WAIT_V(0);
    PG8_BAR;
#undef PG8_SA
#undef PG8_SB
#undef PG8_STAGE
#undef PG8_LDA
#undef PG8_LDB
#undef PG8_MMA
#undef PG8_WAIT_V
#undef PG8_WAIT_L
#undef PG8_BAR
#undef PG8_SCHED
}

constexpr int NTR_UNITS = 2560;
constexpr int CONV_C0 = 352;
DEVI void transpose_unit(const Ctx& p, int tu, int t, float* fs) {
    const int l = tu / 1280, r = tu % 1280;
    int which, loc, K, N, mode; size_t dsto;
    if (r < 176)       { which = I_F1G;  loc = r;        K = 1024; N = 2816; mode = 1; dsto = WL_GU1; }
    else if (r < 352)  { which = I_F1U;  loc = r - 176;  K = 1024; N = 2816; mode = 2; dsto = WL_GU1; }
    else if (r < 528)  { which = I_F1D;  loc = r - 352;  K = 2816; N = 1024; mode = 0; dsto = WL_D1; }
    else if (r < 688)  { which = I_WIN;  loc = r - 528;  K = 1024; N = 2560; mode = 0; dsto = WL_IN; }
    else if (r < 752)  { which = I_WOUT; loc = r - 688;  K = 1024; N = 1024; mode = 0; dsto = WL_OUT; }
    else if (r < 928)  { which = I_F2G;  loc = r - 752;  K = 1024; N = 2816; mode = 1; dsto = WL_GU2; }
    else if (r < 1104) { which = I_F2U;  loc = r - 928;  K = 1024; N = 2816; mode = 2; dsto = WL_GU2; }
    else               { which = I_F2D;  loc = r - 1104; K = 2816; N = 1024; mode = 0; dsto = WL_D2; }
    const int nnt = N / 256, kt = loc / nnt, ntile = loc % nnt;
    const float* src = p.in[which] + (size_t)l * K * N + (size_t)kt * 64 * N + ntile * 256;
    bf16_t* dst = (bf16_t*)(p.ws + OFF_W + (size_t)l * W_LAYER + dsto);
    f32x4 v[8];
#pragma unroll
    for (int i = 0; i < 8; ++i) { const int idx = i * 512 + t; v[i] = *(const f32x4*)(src + (size_t)(idx >> 6) * N + (idx & 63) * 4); }
#pragma unroll
    for (int i = 0; i < 8; ++i) { const int idx = i * 512 + t; *(f32x4*)(fs + (idx >> 6) * 260 + (idx & 63) * 4) = v[i]; }
    __syncthreads();
    const int nl = t & 255, kh = t >> 8;
    int drow;
    if (mode == 0) drow = ntile * 256 + nl;
    else drow = (2 * ntile + (nl >> 7)) * 256 + (nl & 127) + (mode == 2 ? 128 : 0);
    bf16_t* dp = dst + (size_t)drow * K + kt * 64 + kh * 32;
#pragma unroll
    for (int c = 0; c < 4; ++c) {
        u32x4 w;
        const float* f = fs + (kh * 32 + c * 8) * 260 + nl;
        w.x = pk_bf16(f[0], f[260]); w.y = pk_bf16(f[2 * 260], f[3 * 260]); w.z = pk_bf16(f[4 * 260], f[5 * 260]); w.w = pk_bf16(f[6 * 260], f[7 * 260]);
        *(u32x4*)(dp + c * 8) = w;
    }
}

DEVI void convert_fill(const Ctx& p, int lo, int hi, int rank, int nrank, int per) {
    const int t = opaque_tid();
    float* fs = (float*)shm;
    for (int i = 0; i < per; ++i) {
        const int tu = lo + rank + i * nrank;
        if (tu >= hi) break;
        __syncthreads();
        transpose_unit(p, tu, t, fs);
    }
}

DEVI void prologue_phase(const Ctx& p) {
    const int t = opaque_tid();
    float* fs = (float*)shm;
    float* mod = (float*)(p.ws + OFF_MOD);
    const int NMOD = 288, NCW = 32, NTR = (gridDim.x == 256) ? CONV_C0 : NTR_UNITS;
    if (gridDim.x == 256) {
        if (blockIdx.x >= 64)
            for (int tu = (int)blockIdx.x - 64; tu < NTR; tu += 192) { __syncthreads(); transpose_unit(p, tu, t, fs); }
    } else {
        for (int tu = blockIdx.x; tu < NTR; tu += gridDim.x) { __syncthreads(); transpose_unit(p, tu, t, fs); }
    }
    for (int u = blockIdx.x; u < NMOD + NCW; u += gridDim.x) {
        __syncthreads();
        if (u >= NMOD && u < NMOD + NCW) {
            const int mi = u - NMOD, l = mi >> 4, m = (mi >> 2) & 3, g = mi & 3, dir = m >> 1;
            const float* w = ((m & 1) ? p.in[I_CWX] : p.in[I_CWA]) + (((size_t)l * 2 + dir) * 4 + g) * 4096;
            bf16_t* wt = (bf16_t*)(p.ws + OFF_CWT) + (((size_t)l * 4 + m) * 4 + g) * 4096;
            const int d = t >> 3, c8 = (t & 7) * 8;
            u32x4 o;
            o.x = pk_bf16(w[(c8 + 0) * 64 + d], w[(c8 + 1) * 64 + d]); o.y = pk_bf16(w[(c8 + 2) * 64 + d], w[(c8 + 3) * 64 + d]);
            o.z = pk_bf16(w[(c8 + 4) * 64 + d], w[(c8 + 5) * 64 + d]); o.w = pk_bf16(w[(c8 + 6) * 64 + d], w[(c8 + 7) * 64 + d]);
            *(u32x4*)(wt + d * 64 + c8) = o;
        } else if (u < NMOD) {
            const int l = u / 144, jb = u % 144;
            for (int i = t; i < 3072; i += 512) {
                const int r = i >> 10, k = i & 1023;
                const float c = (r == 0) ? p.in[I_CCTX][k] : p.in[I_C][(r - 1) * 1024 + k];
                fs[i] = c / (1.f + __expf(-c));
            }
            __syncthreads();
            const int cgp = t & 15, kg = t >> 4;
            const float* w = p.in[I_WMOD] + ((size_t)l * 1024 + kg * 32) * 9216 + jb * 64 + cgp * 4;
            f32x4 a0 = {0, 0, 0, 0}, a1 = {0, 0, 0, 0}, a2 = {0, 0, 0, 0};
#pragma unroll 8
            for (int k = 0; k < 32; ++k) {
                const f32x4 wv = *(const f32x4*)(w + (size_t)k * 9216);
                const int kk = kg * 32 + k;
                a0 += wv * fs[kk]; a1 += wv * fs[1024 + kk]; a2 += wv * fs[2048 + kk];
            }
            float* red = fs + 3072;
            *(f32x4*)(red + kg * 192 + 0 + cgp * 4) = a0;
            *(f32x4*)(red + kg * 192 + 64 + cgp * 4) = a1;
            *(f32x4*)(red + kg * 192 + 128 + cgp * 4) = a2;
            __syncthreads();
            if (t < 192) {
                float sacc = 0.f;
#pragma unroll 8
                for (int k = 0; k < 32; ++k) sacc += red[k * 192 + t];
                const int r = t >> 6, j = t & 63;
                mod[((size_t)l * 3 + r) * 9216 + jb * 64 + j] = sacc + p.in[I_BMOD][(size_t)l * 9216 + jb * 64 + j];
            }
        } else {
            transpose_unit(p, u - NMOD - NCW, t, fs);
        }
    }
}

DEVI void norm_phase(const Ctx& p, int l, int which, int dry) {
    const int t_ = opaque_tid();
    const int lane = t_ & 63, gw = blockIdx.x * 8 + (t_ >> 6), nw = gridDim.x * 8;
    const float* mod = (const float*)(p.ws + OFF_MOD);
    const bf16_t* P0 = (const bf16_t*)(p.ws + OFF_U);
    const bf16_t* P1 = P0 + (size_t)NTOK * DM;
    bf16_t* H = (bf16_t*)(p.ws + OFF_H);
    bf16_t* XB = (bf16_t*)(p.ws + OFF_XB);
    const bool first = (l == 0 && which == 1);
    int gl, gi; float coef;
    if (which == 1) { gl = l - 1; gi = 8; coef = 0.5f; }
    else if (which == 2) { gl = l; gi = 2; coef = 0.5f; }
    else if (which == 3) { gl = l; gi = 5; coef = 1.0f; }
    else { gl = 1; gi = 8; coef = 0.5f; }
    if (dry) coef = 0.f;
    const float* gn = (which == 1) ? p.in[I_N1] : (which == 2) ? p.in[I_N2] : p.in[I_N3];
    const int shi = (which - 1) * 3, sci = shi + 1;
    for (int tok0 = gw; tok0 < NTOK; tok0 += 3 * nw) {
        f32x4 xv[3][4];
        float ss[3] = {0.f, 0.f, 0.f};
        int rr[3];
        bool ok[3];
        f32x4 g[4], sc[3][4], sh[3][4];
#pragma unroll
        for (int k = 0; k < 3; ++k) {
            const int tok = tok0 + k * nw;
            ok[k] = tok < NTOK;
            const int tk = ok[k] ? tok : tok0;
            rr[k] = tk < NCTX ? 0 : 1 + ((tk - NCTX) >> 10);
            if (which != 4) {
#pragma unroll
                for (int i = 0; i < 4; ++i) {
                    const int c = lane * 4 + i * 256;
                    if (k == 0) g[i] = *(const f32x4*)(gn + (size_t)l * DM + c);
                    sc[k][i] = *(const f32x4*)(mod + ((size_t)l * 3 + rr[k]) * 9216 + sci * 1024 + c);
                    sh[k][i] = *(const f32x4*)(mod + ((size_t)l * 3 + rr[k]) * 9216 + shi * 1024 + c);
                }
            }
            if (first) {
#pragma unroll
                for (int i = 0; i < 4; ++i) {
                    const int c = lane * 4 + i * 256;
                    xv[k][i] = (tk < NCTX) ? *(const f32x4*)(p.in[I_XP] + (size_t)tk * DM + c) : *(const f32x4*)(p.in[I_XS] + (size_t)(tk - NCTX) * DM + c);
                }
            } else {
                u32x2 pa[4], pb[4], xb[4]; f32x4 gv[4];
#pragma unroll
                for (int i = 0; i < 4; ++i) {
                    const int c = lane * 4 + i * 256;
                    xb[i] = *(const u32x2*)(XB + (size_t)tk * DM + c);
                    pa[i] = *(const u32x2*)(P0 + (size_t)tk * DM + c); pb[i] = *(const u32x2*)(P1 + (size_t)tk * DM + c);
                    gv[i] = *(const f32x4*)(mod + ((size_t)gl * 3 + rr[k]) * 9216 + gi * 1024 + c);
                }
#pragma unroll
                for (int i = 0; i < 4; ++i) {
                    f32x4 s2;
                    s2[0] = __builtin_bit_cast(float, pa[i].x << 16) + __builtin_bit_cast(float, pb[i].x << 16);
                    s2[1] = __builtin_bit_cast(float, pa[i].x & 0xffff0000u) + __builtin_bit_cast(float, pb[i].x & 0xffff0000u);
                    s2[2] = __builtin_bit_cast(float, pa[i].y << 16) + __builtin_bit_cast(float, pb[i].y << 16);
                    s2[3] = __builtin_bit_cast(float, pa[i].y & 0xffff0000u) + __builtin_bit_cast(float, pb[i].y & 0xffff0000u);
                    f32x4 x0;
                    x0[0] = __builtin_bit_cast(float, xb[i].x << 16); x0[1] = __builtin_bit_cast(float, xb[i].x & 0xffff0000u);
                    x0[2] = __builtin_bit_cast(float, xb[i].y << 16); x0[3] = __builtin_bit_cast(float, xb[i].y & 0xffff0000u);
                    xv[k][i] = x0 + coef * gv[i] * s2;
                }
            }
        }
#pragma unroll
        for (int k = 0; k < 3; ++k) {
            const int tok = tok0 + k * nw;
            if (ok[k]) {
                if (which == 4) {
#pragma unroll
                    for (int i = 0; i < 4; ++i) *(f32x4*)(p.out + (size_t)tok * DM + lane * 4 + i * 256) = xv[k][i];
                } else {
#pragma unroll
                    for (int i = 0; i < 4; ++i) { u32x2 w; w.x = pk_bf16(xv[k][i][0], xv[k][i][1]); w.y = pk_bf16(xv[k][i][2], xv[k][i][3]); *(u32x2*)(XB + (size_t)tok * DM + lane * 4 + i * 256) = w; }
                }
            }
#pragma unroll
            for (int i = 0; i < 4; ++i) ss[k] += xv[k][i][0] * xv[k][i][0] + xv[k][i][1] * xv[k][i][1] + xv[k][i][2] * xv[k][i][2] + xv[k][i][3] * xv[k][i][3];
        }
        if (which == 4) continue;
#pragma unroll
        for (int k = 0; k < 3; ++k) ss[k] = wave_sum(ss[k]);
#pragma unroll
        for (int k = 0; k < 3; ++k) {
            const int tok = tok0 + k * nw;
            const float rstd = rsqrtf(ss[k] * (1.f / 1024.f) + 1e-6f);
            if (ok[k]) {
#pragma unroll
                for (int i = 0; i < 4; ++i) {
                    const f32x4 y = xv[k][i] * rstd * g[i] * (1.f + sc[k][i]) + sh[k][i];
                    u32x2 w; w.x = pk_bf16(y[0], y[1]); w.y = pk_bf16(y[2], y[3]);
                    *(u32x2*)(H + (size_t)tok * DM + lane * 4 + i * 256) = w;
                }
            }
        }
    }
}

DEVI float rope_apply(float y, int d, int rowp, int colp) {
    const float part = __shfl_xor(y, 16);
    const int dd = d & 31, i = dd & 15;
    const float pos = (float)((d < 32) ? rowp : colp);
    const float inv = exp2f(-(float)i * (13.287712379549449f / 16.f));
    const float ang = pos * inv;
    float sn, cs;
    __sincosf(ang, &sn, &cs);
    return (dd < 16) ? (y * cs - part * sn) : (part * sn + y * cs);
}

DEVI void prep_phase(const Ctx& p, int l) {
    const int t = opaque_tid(), lane = t & 63, wid = t >> 6;
    const bf16_t* U = (const bf16_t*)(p.ws + OFF_U);
    float* fs = (float*)shm;
    float* CA = (float*)(p.ws + OFF_CA);
    float* CB = (float*)(p.ws + OFF_CB);
    for (int u = blockIdx.x; u < 384; u += gridDim.x) {
        __syncthreads();
        const int tt = u >> 2, g = u & 3, tok0 = tt * 64;
        int T, tpos0;
        if (tok0 < NCTX) { T = 256; tpos0 = tok0 & 255; } else { T = 1024; tpos0 = (tok0 - NCTX) & 1023; }
        float* xcs = fs;
        float* cmp = fs + 64 * 68;
        {
            const int tk = t >> 3, c8 = (t & 7) * 8;
            f32x4 a0 = *(const f32x4*)(p.in[I_CCB] + l * 256 + g * 64 + c8), a1 = *(const f32x4*)(p.in[I_CCB] + l * 256 + g * 64 + c8 + 4);
#pragma unroll
            for (int w = 0; w < 4; ++w) {
                const int tp = tpos0 + tk + w - 2;
                if (tp >= 0 && tp < T) {
                    const bf16_t* up = U + (size_t)(tok0 + tk + w - 2) * INW + 1024 + g * 64 + c8;
                    const float* cw = p.in[I_CCW] + ((size_t)l * 4 + w) * 256 + g * 64 + c8;
                    a0 += ldb4(up) * *(const f32x4*)cw;
                    a1 += ldb4(up + 4) * *(const f32x4*)(cw + 4);
                }
            }
            *(f32x4*)(xcs + tk * 68 + c8) = a0; *(f32x4*)(xcs + tk * 68 + c8 + 4) = a1;
        }
        __syncthreads();
        {
            const int fr = lane & 15, fq = lane >> 4, tt4 = wid & 3, dtb = (wid >> 2) * 2;
            bf16x8 af[2];
#pragma unroll
            for (int ks = 0; ks < 2; ++ks) {
                const f32x4 x0 = *(const f32x4*)(xcs + (tt4 * 16 + fr) * 68 + ks * 32 + fq * 8), x1 = *(const f32x4*)(xcs + (tt4 * 16 + fr) * 68 + ks * 32 + fq * 8 + 4);
                u32x4 w; w.x = pk_bf16(x0[0], x0[1]); w.y = pk_bf16(x0[2], x0[3]); w.z = pk_bf16(x1[0], x1[1]); w.w = pk_bf16(x1[2], x1[3]);
                af[ks] = __builtin_bit_cast(bf16x8, w);
            }
            const bf16_t* cwt = (const bf16_t*)(p.ws + OFF_CWT) + (size_t)l * 16 * 4096;
#pragma unroll
            for (int di = 0; di < 2; ++di) {
                const int dcol = (dtb + di) * 16 + fr, ch = g * 64 + dcol;
                f32x4 acc[4];
#pragma unroll
                for (int m = 0; m < 4; ++m) {
                    acc[m] = (f32x4){0.f, 0.f, 0.f, 0.f};
#pragma unroll
                    for (int ks = 0; ks < 2; ++ks) {
                        const bf16x8 bfr = *(const bf16x8*)(cwt + ((size_t)(m * 4 + g) * 64 + dcol) * 64 + ks * 32 + fq * 8);
                        acc[m] = __builtin_amdgcn_mfma_f32_16x16x32_bf16(af[ks], bfr, acc[m], 0, 0, 0);
                    }
                }
#pragma unroll
                for (int dir = 0; dir < 2; ++dir) {
                    const float ba = p.in[I_CBA][((size_t)l * 2 + dir) * 256 + ch], bx = p.in[I_CBX][((size_t)l * 2 + dir) * 256 + ch];
                    const float lam = p.in[I_CLAM][((size_t)l * 2 + dir) * 256 + ch];
                    const float sp = log1pf(expf(-lam));
                    float av[4], bv[4];
#pragma unroll
                    for (int r = 0; r < 4; ++r) {
                        const int tl = tt4 * 16 + fq * 4 + r;
                        const float rg = sigmoidf_(acc[dir * 2][r] + ba);
                        const float ig = sigmoidf_(acc[dir * 2 + 1][r] + bx);
                        const float la = -8.f * rg * sp;
                        const float a = __expf(la);
                        const float t2 = 2.f * la;
                        const float em = -t2 * (1.f + t2 * (0.5f + t2 * (0.16666667f + t2 * (0.041666668f + t2 * (0.008333334f + t2 * 0.0013888889f)))));
                        const float bb = __builtin_amdgcn_sqrtf(em) * (ig * xcs[tl * 68 + dcol]);
                        ((unsigned*)CA)[((size_t)dir * NTOK + tok0 + tl) * 256 + ch] = pk_bf16(1.f - a, bb);
                        av[r] = a; bv[r] = bb;
                    }
                    float Ac = 1.f, Bc = 0.f;
                    if (dir == 0) {
#pragma unroll
                        for (int r = 0; r < 4; ++r) { Bc = av[r] * Bc + bv[r]; Ac *= av[r]; }
                    } else {
#pragma unroll
                        for (int r = 3; r >= 0; --r) { Bc = av[r] * Bc + bv[r]; Ac *= av[r]; }
                    }
                    const int grp = tt4 * 4 + fq;
                    cmp[((dir * 16 + grp) * 2 + 0) * 64 + dcol] = Ac;
                    cmp[((dir * 16 + grp) * 2 + 1) * 64 + dcol] = Bc;
                }
            }
        }
        __syncthreads();
        if (t < 128) {
            const int dir = t >> 6, dd = t & 63;
            float Ac = 1.f, Bc = 0.f;
#pragma unroll
            for (int q = 0; q < 16; ++q) {
                const int gq = dir == 0 ? q : 15 - q;
                const float a = cmp[((dir * 16 + gq) * 2 + 0) * 64 + dd], b = cmp[((dir * 16 + gq) * 2 + 1) * 64 + dd];
                Bc = a * Bc + b; Ac *= a;
            }
            float* TA = (float*)(p.ws + OFF_TA); float* TB = (float*)(p.ws + OFF_TB);
            TA[((size_t)dir * 96 + tt) * 256 + g * 64 + dd] = Ac;
            TB[((size_t)dir * 96 + tt) * 256 + g * 64 + dd] = Bc;
        }
    }
    const int gw = blockIdx.x * 8 + wid, nw = gridDim.x * 8;
    bf16_t* QA = (bf16_t*)(p.ws + OFF_QA); bf16_t* QB = (bf16_t*)(p.ws + OFF_QB);
    bf16_t* KA = (bf16_t*)(p.ws + OFF_KA); bf16_t* VA = (bf16_t*)(p.ws + OFF_VA);
    bf16_t* KB = (bf16_t*)(p.ws + OFF_KB); bf16_t* VB = (bf16_t*)(p.ws + OFF_VB);
    bf16_t* DQ = (bf16_t*)(p.ws + OFF_DQ); bf16_t* DK = (bf16_t*)(p.ws + OFF_DK); bf16_t* DV = (bf16_t*)(p.ws + OFF_DV);
    {
        const int sub = lane >> 4, li = lane & 15;
        const f32x4 gaq = *(const f32x4*)(p.in[I_AQN] + l * 64 + li * 4), gak = *(const f32x4*)(p.in[I_AKN] + l * 64 + li * 4);
        const f32x4 gbq = *(const f32x4*)(p.in[I_BQN] + l * 64 + li * 4), gbk = *(const f32x4*)(p.in[I_BKN] + l * 64 + li * 4);
        const bool bal = gridDim.x == 256;
        const int tgw = bal ? ((int)blockIdx.x - 128) * 8 + wid : gw, tnw = bal ? 128 * 8 : nw;
        for (int tb = tgw * 4; tb < NTOK && tb >= 0; tb += tnw * 4) {
            const int tok = tb + sub;
            const bool lat = tok >= NCTX;
            int b, tp;
            if (!lat) { b = tok >> 8; tp = tok & 255; } else { b = (tok - NCTX) >> 10; tp = (tok - NCTX) & 1023; }
            const size_t krow = lat ? (size_t)(NCTX + b * 1536 + 512 + tp) : (size_t)tok;
            const bf16_t* ur = U + (size_t)tok * INW + li * 4;
            f32x4 cs = {1.f, 1.f, 1.f, 1.f}, sn = {0.f, 0.f, 0.f, 0.f};
            if (lat) {
                const float pos = (float)((li < 8) ? (tp >> 6) : (tp & 63));
#pragma unroll
                for (int e = 0; e < 4; ++e) {
                    const int fi = (li & 3) * 4 + e;
                    const float ang = pos * exp2f(-(float)fi * (13.287712379549449f / 16.f));
                    float s_, c_; __sincosf(ang, &s_, &c_);
                    cs[e] = c_; sn[e] = s_;
                }
            }
            const bool first = (li & 7) < 4;
#define PREP_NORM(v, gain) do { float ss_ = v[0] * v[0] + v[1] * v[1] + v[2] * v[2] + v[3] * v[3]; \
                ss_ += __shfl_xor(ss_, 1); ss_ += __shfl_xor(ss_, 2); ss_ += __shfl_xor(ss_, 4); ss_ += __shfl_xor(ss_, 8); \
                v = v * rsqrtf(ss_ * (1.f / 64.f) + 1e-6f) * gain; } while (0)
#define PREP_ROPE(v) do { if (lat) { f32x4 pt_; pt_[0] = __shfl_xor(v[0], 4); pt_[1] = __shfl_xor(v[1], 4); pt_[2] = __shfl_xor(v[2], 4); pt_[3] = __shfl_xor(v[3], 4); \
                v = first ? (v * cs - pt_ * sn) : (pt_ * sn + v * cs); } } while (0)
#define PREP_ST4(ptr, v) do { u32x2 w_; w_.x = pk_bf16(v[0], v[1]); w_.y = pk_bf16(v[2], v[3]); *(u32x2*)(ptr) = w_; } while (0)
#pragma unroll
            for (int mx = 0; mx < 2; ++mx) {
                const bf16_t* um = ur + mx * 512;
                bf16_t* Qo = mx ? QB : QA; bf16_t* Ko = mx ? KB : KA; bf16_t* Vo = mx ? VB : VA;
                const f32x4 gq = mx ? gbq : gaq, gk = mx ? gbk : gak;
                float* ck = p.out + (mx ? O_CBK : O_CAK); float* cv = p.out + (mx ? O_CBV : O_CAV);
#pragma unroll
                for (int hq = 0; hq < 4; ++hq) {
                    f32x4 v = ldb4(um + hq * 64);
                    PREP_NORM(v, gq);
                    PREP_ROPE(v);
                    v = v * 0.125f;
                    PREP_ST4(Qo + (size_t)tok * 256 + hq * 64 + li * 4, v);
                }
#pragma unroll
                for (int kv = 0; kv < 2; ++kv) {
                    f32x4 v = ldb4(um + 256 + kv * 64);
                    const f32x4 vv = ldb4(um + 384 + kv * 64);
                    PREP_NORM(v, gk);
                    if (!lat) {
                        const size_t co = (((size_t)b * 2 + l) * 256 + tp) * 128 + kv * 64 + li * 4;
                        *(f32x4*)(ck + co) = v; *(f32x4*)(cv + co) = vv;
                    }
                    PREP_ROPE(v);
                    PREP_ST4(Ko + krow * 128 + kv * 64 + li * 4, v);
                }
            }
#undef PREP_NORM
#undef PREP_ROPE
#undef PREP_ST4
        }
    }
    for (int it = gw; it < 1024; it += nw) {
        const int b = it >> 9, pos = it & 511;
        const size_t src = (((size_t)b * 2 + l) * 512 + pos) * 128 + lane * 2;
        const size_t dst = ((size_t)(NCTX + b * 1536 + pos)) * 128 + lane * 2;
        f32x2 v;
        v = *(const f32x2*)(p.in[I_CAK] + src); *(unsigned*)(KA + dst) = pk_bf16(v[0], v[1]);
        v = *(const f32x2*)(p.in[I_CAV] + src); *(unsigned*)(VA + dst) = pk_bf16(v[0], v[1]);
        v = *(const f32x2*)(p.in[I_CBK] + src); *(unsigned*)(KB + dst) = pk_bf16(v[0], v[1]);
        v = *(const f32x2*)(p.in[I_CBV] + src); *(unsigned*)(VB + dst) = pk_bf16(v[0], v[1]);
    }
}

DEVI void attn_unit(const Ctx& p, int l, int type, int idx) {
    const int t = opaque_tid(), lane = t & 63, wid = t >> 6, fr = lane & 15, fq = lane >> 4;
    bf16_t* MIX = (bf16_t*)(p.ws + OFF_MIX);
    const bf16_t* U = (const bf16_t*)(p.ws + OFF_U);
    int b, h, qtok0, qpos0, ntiles, kld, kcol, rowbase, ocol;
    const bf16_t *Qp, *Kp, *Vp;
    const bool ret_t = type >= 4;
    int plo = 0;
    if (type == 0 || type == 1 || type == 4) {
        b = idx >> 3; h = (idx >> 1) & 3; const int qh = idx & 1;
        qtok0 = b * 256 + qh * 128; qpos0 = qh * 128; ntiles = 4; rowbase = b * 256;
    } else {
        b = idx >> 5; h = (idx >> 3) & 3; const int qb = idx & 7;
        qtok0 = NCTX + b * 1024 + qb * 128; qpos0 = qb * 128;
        if (type == 2) { plo = qpos0 - 128 < 0 ? 0 : qpos0 - 128; const int phi = qpos0 + 256 > 1024 ? 1024 : qpos0 + 256; ntiles = 8 + ((phi - plo) >> 6); rowbase = NCTX + b * 1536; }
        else if (type == 3) { ntiles = 24; rowbase = NCTX + b * 1536; }
        else { ntiles = 16; rowbase = NCTX + b * 1024; }
    }
    if (type == 0 || type == 2) { Qp = (const bf16_t*)(p.ws + OFF_QA); Kp = (const bf16_t*)(p.ws + OFF_KA); Vp = (const bf16_t*)(p.ws + OFF_VA); kld = 128; kcol = (h >> 1) * 64; ocol = h * 64; }
    else if (type == 1 || type == 3) { Qp = (const bf16_t*)(p.ws + OFF_QB); Kp = (const bf16_t*)(p.ws + OFF_KB); Vp = (const bf16_t*)(p.ws + OFF_VB); kld = 128; kcol = (h >> 1) * 64; ocol = 256 + h * 64; }
    else { Qp = U; Kp = U; Vp = U; kld = INW; kcol = 1792 + h * 64; ocol = 768 + h * 64; }
    const int vucol = ((type & 1) ? 896 : 384) + (h >> 1) * 64;
    const int qld = ret_t ? INW : 256, qcol = ret_t ? 1536 + h * 64 : h * 64, vcol = ret_t ? 2048 + h * 64 : kcol;
    const bool ret = type >= 4;
    const bool dost = (type == 4);
    const int sdir = idx & 1;
    f32x4 SX[2];
#pragma unroll
    for (int i = 0; i < 2; ++i) SX[i] = (f32x4){0.f, 0.f, 0.f, 0.f};
    const int qtok = qtok0 + wid * 16 + fr, qpos = qpos0 + wid * 16 + fr;
    bf16x8 qf[2];
    {
        const bf16_t* qp = Qp + (size_t)qtok * qld + qcol + fq * 8;
        qf[0] = *(const bf16x8*)qp; qf[1] = *(const bf16x8*)(qp + 32);
    }
    f32x4 gnp[4], gtp[4];
#pragma unroll
    for (int dt = 0; dt < 4; ++dt) { gnp[dt] = (f32x4){0.f, 0.f, 0.f, 0.f}; gtp[dt] = gnp[dt]; }
    if (ret) {
#pragma unroll
        for (int dt = 0; dt < 4; ++dt) {
            const int dcol = h * 64 + dt * 16 + fq * 4;
            gnp[dt] = *(const f32x4*)(p.in[I_DNG] + l * 256 + dcol);
            const f32x4 dgv = ldb4(U + (size_t)qtok * INW + 2304 + dcol);
#pragma unroll
            for (int r = 0; r < 4; ++r) gtp[dt][r] = siluf_(dgv[r]);
        }
    }
    float lgf = 0.f, lgb = 0.f;
    if (ret) {
        lgf = log1pf(-expf(p.in[I_DTH][(l * 2 + 0) * 4 + h])) * LOG2E;
        lgb = log1pf(-expf(p.in[I_DTH][(l * 2 + 1) * 4 + h])) * LOG2E;
    }
    float mrun = -1e30f, lrun = 0.f;
    if (type == 0 || type == 2) { mrun = p.in[I_ASINK][l * 4 + h]; lrun = (fq == 0) ? 1.f : 0.f; }
    f32x4 O[4];
#pragma unroll
    for (int i = 0; i < 4; ++i) O[i] = (f32x4){0.f, 0.f, 0.f, 0.f};

    const int skey = t >> 3, sc8 = (t & 7) * 8;
    const int ksw = skey ^ ((sc8 >> 3) << 3);
    const int ATT_BLK = 3 * 64 * 72;
    const int nstage = (ntiles + 3) >> 2;
    u32x4 kr[4], vr[4];
#define ATT_ROW(ti_) ((type == 2) ? (((ti_) < 8) ? rowbase + (ti_) * 64 : rowbase + 512 + plo + ((ti_) - 8) * 64) : rowbase + (ti_) * 64)
#define ATT_LOAD(sp_) do { _Pragma("unroll") for (int j_ = 0; j_ < 4; ++j_) { const int ti_ = (sp_) * 4 + j_; \
        if (ti_ < ntiles) { const int row_ = ATT_ROW(ti_); \
            kr[j_] = *(const u32x4*)(Kp + (size_t)(row_ + skey) * kld + kcol + sc8); \
            const bool vu_ = (type <= 1) || (type <= 3 && ti_ >= 8);       \
            const bf16_t* vp_ = vu_ ? U + (size_t)((type <= 1 ? row_ : row_ - rowbase - 512 + NCTX + b * 1024) + skey) * INW + vucol + sc8 \
                                    : Vp + (size_t)(row_ + skey) * kld + vcol + sc8; \
            vr[j_] = *(const u32x4*)vp_; } } } while (0)
    ATT_LOAD(0);
    for (int sp = 0; sp < nstage; ++sp) {
        __syncthreads();
#pragma unroll
        for (int j = 0; j < 4; ++j) {
            const int ti = sp * 4 + j;
            if (ti < ntiles) {
                bf16_t* Kd = shm + j * ATT_BLK; bf16_t* Vd = Kd + 64 * 72;
                const u32x4 kvr = kr[j], vvr = vr[j];
                *(u32x4*)(Kd + skey * 72 + sc8) = kvr;
                Vd[(sc8 + 0) * 72 + ksw] = (bf16_t)(vvr.x & 0xffffu); Vd[(sc8 + 1) * 72 + ksw] = (bf16_t)(vvr.x >> 16);
                Vd[(sc8 + 2) * 72 + ksw] = (bf16_t)(vvr.y & 0xffffu); Vd[(sc8 + 3) * 72 + ksw] = (bf16_t)(vvr.y >> 16);
                Vd[(sc8 + 4) * 72 + ksw] = (bf16_t)(vvr.z & 0xffffu); Vd[(sc8 + 5) * 72 + ksw] = (bf16_t)(vvr.z >> 16);
                Vd[(sc8 + 6) * 72 + ksw] = (bf16_t)(vvr.w & 0xffffu); Vd[(sc8 + 7) * 72 + ksw] = (bf16_t)(vvr.w >> 16);
                if (dost) {
                    bf16_t* Xd = Kd + 2 * 64 * 72; const int mpos = ti * 64 + skey;
                    const float wx = sdir == 0 ? fexp2(lgf * (float)(255 - mpos) - 3.f) : fexp2(lgb * (float)mpos - 3.f);
                    const unsigned kw[4] = {kvr.x, kvr.y, kvr.z, kvr.w};
#pragma unroll
                    for (int j2 = 0; j2 < 4; ++j2) {
                        const float klo = __builtin_bit_cast(float, kw[j2] << 16), khi = __builtin_bit_cast(float, kw[j2] & 0xffff0000u);
                        Xd[(sc8 + 2 * j2) * 72 + ksw] = to_bf16(klo * wx); Xd[(sc8 + 2 * j2 + 1) * 72 + ksw] = to_bf16(khi * wx);
                    }
                }
            }
        }
        __syncthreads();
        if (sp + 1 < nstage) ATT_LOAD(sp + 1);
        const int cnt = (ntiles - sp * 4) < 4 ? (ntiles - sp * 4) : 4;
#pragma unroll 1
        for (int j = 0; j < cnt; ++j) {
        const int ti = sp * 4 + j;
        int kpos0; bool masked = false;
        if (type == 2) { if (ti < 8) kpos0 = 0; else { kpos0 = plo + (ti - 8) * 64; masked = true; } }
        else kpos0 = ti * 64;
        const bf16_t* Ks = shm + j * ATT_BLK;
        const bf16_t* VT = Ks + 64 * 72;
        f32x4 st[4];
#pragma unroll
        for (int kt = 0; kt < 4; ++kt) {
            st[kt] = (f32x4){0.f, 0.f, 0.f, 0.f};
#pragma unroll
            for (int dh = 0; dh < 2; ++dh) {
                const bf16x8 kf = *(const bf16x8*)(Ks + (kt * 16 + fr) * 72 + dh * 32 + fq * 8);
                st[kt] = __builtin_amdgcn_mfma_f32_16x16x32_bf16(kf, qf[dh], st[kt], 0, 0, 0);
            }
        }
        float pv[4][4];
        if (!ret) {
            float mx = -1e30f;
#pragma unroll
            for (int kt = 0; kt < 4; ++kt)
#pragma unroll
                for (int r = 0; r < 4; ++r) {
                    float s_ = st[kt][r];
                    if (masked) { const int dlt = kpos0 + kt * 16 + fq * 4 + r - qpos; if (dlt > 128 || dlt < -128) s_ = -1e30f; }
                    pv[kt][r] = s_;
                    mx = fmaxf(mx, s_);
                }
            mx = fmaxf(mx, __shfl_xor(mx, 16)); mx = fmaxf(mx, __shfl_xor(mx, 32));
            const float mnew = fmaxf(mrun, mx);
            const float alpha = fexp2((mrun - mnew) * LOG2E);
            const float mb = mnew * LOG2E;
            float ps = 0.f;
#pragma unroll
            for (int kt = 0; kt < 4; ++kt)
#pragma unroll
                for (int r = 0; r < 4; ++r) {
                    const float s_ = pv[kt][r];
                    float e = fexp2(s_ * LOG2E - mb);
                    if (masked) e = (s_ <= -1e29f) ? 0.f : e;
                    pv[kt][r] = e; ps += e;
                }
            lrun = lrun * alpha + ps; mrun = mnew;
#pragma unroll
            for (int i = 0; i < 4; ++i) O[i] *= alpha;
        } else {
#pragma unroll
            for (int kt = 0; kt < 4; ++kt)
#pragma unroll
                for (int r = 0; r < 4; ++r) {
                    const int dlt = qpos - (kpos0 + kt * 16 + fq * 4 + r);
                    const float w = dlt > 0 ? fexp2(lgf * (float)dlt - 3.f) : (dlt < 0 ? fexp2(-lgb * (float)dlt - 3.f) : 0.25f);
                    pv[kt][r] = st[kt][r] * w;
                }
        }
#pragma unroll
        for (int pr = 0; pr < 2; ++pr) {
            u32x4 pw;
            pw.x = pk_bf16(pv[2 * pr][0], pv[2 * pr][1]); pw.y = pk_bf16(pv[2 * pr][2], pv[2 * pr][3]);
            pw.z = pk_bf16(pv[2 * pr + 1][0], pv[2 * pr + 1][1]); pw.w = pk_bf16(pv[2 * pr + 1][2], pv[2 * pr + 1][3]);
            const bf16x8 pf = __builtin_bit_cast(bf16x8, pw);
#pragma unroll
            for (int dt = 0; dt < 4; ++dt) {
                const int vsw = ((2 * dt + (fr >> 3)) & 7) << 3;
                const u32x2 lo = *(const u32x2*)(VT + (dt * 16 + fr) * 72 + (((2 * pr) * 16 + fq * 4) ^ vsw));
                const u32x2 hi = *(const u32x2*)(VT + (dt * 16 + fr) * 72 + (((2 * pr + 1) * 16 + fq * 4) ^ vsw));
                u32x4 vw; vw.x = lo.x; vw.y = lo.y; vw.z = hi.x; vw.w = hi.y;
                O[dt] = __builtin_amdgcn_mfma_f32_16x16x32_bf16(__builtin_bit_cast(bf16x8, vw), pf, O[dt], 0, 0, 0);
            }
        }
        if (dost) {
            const bf16_t* KX = Ks + 2 * 64 * 72;
            const int dtw = wid & 3, vt0 = (wid >> 2) * 2;
            const int dsw = ((2 * dtw + (fr >> 3)) & 7) << 3;
#pragma unroll
            for (int ms = 0; ms < 2; ++ms) {
                const bf16x8 bx_ = *(const bf16x8*)(KX + (dtw * 16 + fr) * 72 + ((ms * 32 + fq * 8) ^ dsw));
#pragma unroll
                for (int vi = 0; vi < 2; ++vi) {
                    const int vt = vt0 + vi;
                    const int vsw2 = ((2 * vt + (fr >> 3)) & 7) << 3;
                    const bf16x8 af_ = *(const bf16x8*)(VT + (vt * 16 + fr) * 72 + ((ms * 32 + fq * 8) ^ vsw2));
                    SX[vi] = __builtin_amdgcn_mfma_f32_16x16x32_bf16(af_, bx_, SX[vi], 0, 0, 0);
                }
            }
        }
        }
    }
#undef ATT_ROW
#undef ATT_LOAD
    if (dost) {
        const int dtw = wid & 3, vt0 = (wid >> 2) * 2;
#pragma unroll
        for (int vi = 0; vi < 2; ++vi) {
            const size_t o = (size_t)(dtw * 16 + fr) * 64 + (vt0 + vi) * 16 + fq * 4;
            *(f32x4*)(p.out + O_SD + ((((size_t)b * 2 + l) * 2 + sdir) * 4 + h) * 4096 + o) = SX[vi];
        }
    }
    bf16_t* op = MIX + (size_t)qtok * DM + ocol + fq * 4;
    if (!ret) {
        float ls = lrun; ls += __shfl_xor(ls, 16); ls += __shfl_xor(ls, 32);
        const float inv = 1.f / ls;
#pragma unroll
        for (int dt = 0; dt < 4; ++dt) {
            u32x2 w; w.x = pk_bf16(O[dt][0] * inv, O[dt][1] * inv); w.y = pk_bf16(O[dt][2] * inv, O[dt][3] * inv);
            *(u32x2*)(op + dt * 16) = w;
        }
    } else {
        if (type == 5) {
            __syncthreads();
            {
                bf16_t* S0T = shm;
#pragma unroll
                for (int i = 0; i < 4; ++i) {
                    const int id = i * 512 + t, dir = id >> 10, rem = id & 1023, d = rem >> 4, v4 = (rem & 15) * 4;
                    const f32x4 sv = *(const f32x4*)(p.in[I_SD] + ((((size_t)b * 2 + l) * 2 + dir) * 4 + h) * 4096 + d * 64 + v4);
                    bf16_t* dstp = S0T + dir * (64 * 72) + v4 * 72 + d;
                    dstp[0] = to_bf16(sv[0]); dstp[72] = to_bf16(sv[1]); dstp[144] = to_bf16(sv[2]); dstp[216] = to_bf16(sv[3]);
                }
            }
            __syncthreads();
#pragma unroll
            for (int dir = 0; dir < 2; ++dir) {
                const bf16_t* S0T = shm + dir * (64 * 72);
                const float wq = dir == 0 ? fexp2(lgf * (float)(qpos + 1)) : fexp2(lgb * (float)(1024 - qpos));
#pragma unroll
                for (int dt = 0; dt < 4; ++dt) {
                    f32x4 tmp = (f32x4){0.f, 0.f, 0.f, 0.f};
#pragma unroll
                    for (int dh = 0; dh < 2; ++dh) {
                        const bf16x8 sf = *(const bf16x8*)(S0T + (dt * 16 + fr) * 72 + dh * 32 + fq * 8);
                        tmp = __builtin_amdgcn_mfma_f32_16x16x32_bf16(sf, qf[dh], tmp, 0, 0, 0);
                    }
                    O[dt] += tmp * wq;
                }
            }
        }
        float ss = 0.f;
#pragma unroll
        for (int dt = 0; dt < 4; ++dt) ss += O[dt][0] * O[dt][0] + O[dt][1] * O[dt][1] + O[dt][2] * O[dt][2] + O[dt][3] * O[dt][3];
        ss += __shfl_xor(ss, 16); ss += __shfl_xor(ss, 32);
        const float rstd = rsqrtf(ss * (1.f / 64.f) + 1e-6f);
#pragma unroll
        for (int dt = 0; dt < 4; ++dt) {
            const int dcol = h * 64 + dt * 16 + fq * 4;
            float o[4];
#pragma unroll
            for (int r = 0; r < 4; ++r) o[r] = O[dt][r] * rstd * gnp[dt][r] * gtp[dt][r];
            u32x2 w; w.x = pk_bf16(o[0], o[1]); w.y = pk_bf16(o[2], o[3]);
            *(u32x2*)(op + dt * 16) = w;
        }
    }
}

DEVI void scan_unit(const Ctx& p, int l, int tt) {
    const int t = opaque_tid(), ch = t & 255, dir = t >> 8;
    const float* CA = (const float*)(p.ws + OFF_CA);
    const float* CB = (const float*)(p.ws + OFF_CB);
    const float* TA = (const float*)(p.ws + OFF_TA);
    const float* TB = (const float*)(p.ws + OFF_TB);
    const bf16_t* U = (const bf16_t*)(p.ws + OFF_U);
    bf16_t* MIX = (bf16_t*)(p.ws + OFF_MIX);
    int tile0, tl, nts, sq; float h = 0.f;
    if (tt < 64) { sq = tt >> 2; tile0 = sq * 4; tl = tt & 3; nts = 4; }
    else { const int b = (tt - 64) >> 4; sq = 16 + b; tile0 = 64 + b * 16; tl = (tt - 64) & 15; nts = 16; h = p.in[I_SC][(((size_t)b * 2 + l) * 2 + dir) * 256 + ch]; }
    const int tok0 = tt * 64;
    {
        float ta[16], tb[16];
#pragma unroll
        for (int k = 0; k < 16; ++k) {
            int tk = dir == 0 ? k : nts - 1 - k;
            tk = tk < 0 ? 0 : (tk > nts - 1 ? nts - 1 : tk);
            ta[k] = TA[((size_t)dir * 96 + tile0 + tk) * 256 + ch]; tb[k] = TB[((size_t)dir * 96 + tile0 + tk) * 256 + ch];
        }
        const int npre = dir == 0 ? tl : nts - 1 - tl;
#pragma unroll
        for (int k = 0; k < 16; ++k) if (k < npre) h = ta[k] * h + tb[k];
    }
    const unsigned* abp = (const unsigned*)CA + ((size_t)dir * NTOK + tok0) * 256 + ch;
    float* hp = (float*)shm + dir * (64 * 256) + ch;
    unsigned wv[64];
#pragma unroll
    for (int j = 0; j < 64; ++j) wv[j] = abp[(size_t)j * 256];
    if (dir == 0) {
#pragma unroll
        for (int j = 0; j < 64; ++j) { h = (1.f - __builtin_bit_cast(float, wv[j] << 16)) * h + __builtin_bit_cast(float, wv[j] & 0xffff0000u); hp[(size_t)j * 256] = h; }
    } else {
#pragma unroll
        for (int j = 63; j >= 0; --j) { h = (1.f - __builtin_bit_cast(float, wv[j] << 16)) * h + __builtin_bit_cast(float, wv[j] & 0xffff0000u); hp[(size_t)j * 256] = h; }
    }
    if (tt < 64 && ((dir == 0 && tl == 3) || (dir == 1 && tl == 0))) p.out[O_SC + (((size_t)sq * 2 + l) * 2 + dir) * 256 + ch] = h;
    __syncthreads();
    const float* H0 = (const float*)shm;
    const float* H1 = H0 + 64 * 256;
#pragma unroll
    for (int i = 0; i < 8; ++i) {
        const int idx = i * 512 + t;
        const int tk = idx >> 6, c4 = (idx & 63) * 4;
        const f32x4 a = *(const f32x4*)(H0 + (size_t)tk * 256 + c4), b = *(const f32x4*)(H1 + (size_t)tk * 256 + c4);
        const f32x4 cy = ldb4(U + (size_t)(tok0 + tk) * INW + 1280 + c4);
        float o[4];
#pragma unroll
        for (int r = 0; r < 4; ++r) {
            const float x = cy[r];
            const float z2 = 1.5957691216057308f * (x + 0.044715f * x * x * x);
            const float ge = x * __builtin_amdgcn_rcpf(1.f + __expf(-z2));
            o[r] = (a[r] + b[r]) * ge;
        }
        u32x2 w; w.x = pk_bf16(o[0], o[1]); w.y = pk_bf16(o[2], o[3]);
        *(u32x2*)(MIX + (size_t)(tok0 + tk) * DM + 512 + c4) = w;
    }
}

DEVI void mixer_phase(const Ctx& p, int l, volatile LAS int* s_unit, int slot) {
    const int NU = 672;
    const int nq = gridDim.x >= 8 ? 8 : 1, q = blockIdx.x % nq;
    unsigned* ctr = (unsigned*)(p.ws + OFF_CTRL) + 4096 + 64 * (slot * 8 + q);
    const int base = (int)gridDim.x < NU ? (int)gridDim.x : NU;
    bool first = true;
    for (;;) {
        int u;
        if (first) { u = blockIdx.x; first = false; if (u >= NU) break; }
        else {
            __syncthreads();
            if (threadIdx.x == 0) *s_unit = base + (int)atomicAdd(ctr, 1u) * nq + q;
            __syncthreads();
            u = *s_unit;
            if (u >= NU) break;
        }
#ifdef MIX_LO
        if (slot >= 2 && (u < MIX_LO || u >= MIX_HI)) continue;
#endif
        if (u < 64) attn_unit(p, l, 3, u);
        else if (u < 128) attn_unit(p, l, 5, u - 64);
        else if (u < 192) attn_unit(p, l, 2, u - 128);
        else if (u < 288) scan_unit(p, l, u - 192);
        else if (u < 416) attn_unit(p, l, 4, u - 288);
        else if (u < 544) attn_unit(p, l, 0, u - 416);
        else attn_unit(p, l, 1, u - 544);
    }
}

__global__ void __launch_bounds__(512, 2) fwd_megakernel(Params P, int ph_lo, int ph_hi) {
    __shared__ uint4 s_ctl[2];
    if (threadIdx.x == 0) {
        s_ctl[0] = make_uint4(0u, 0u, 0u, 0u); s_ctl[1] = make_uint4(0u, 0u, 0u, 0u);
        const float** tabw = (const float**)(P.ws + OFF_TAB) + (size_t)blockIdx.x * 64;
#pragma unroll
        for (int i = 0; i < N_IN; ++i) tabw[i] = P.in[i];
        __threadfence();
    }
    __syncthreads();
    if (P.never) cg::this_grid().sync();
    XcdBarrier xb;
    const bool multi = (ph_hi - ph_lo) > 1;
    if (multi) xb = xcd_barrier_post((unsigned*)(P.ws + OFF_CTRL), (volatile LAS unsigned*)&s_ctl[0]);
    volatile LAS int* s_unit = (volatile LAS int*)&s_ctl[1];
#ifndef PH_MASK
#define PH_MASK 63
#endif
#ifndef DUP_MASK
#define DUP_MASK 0
#endif
    for (int ph2 = ph_lo * 2; ph2 < ph_hi * 2; ++ph2) {
        const int ph = ph2 >> 1, rep = ph2 & 1;
        if (rep) {
            const int kk = (ph >= 1 && ph < 23) ? (ph - 1) % 11 : -1;
            const bool dup = (ph == 0) ? (DUP_MASK & 1) : (ph == 23 || kk == 0 || kk == 3 || kk == 8) ? (DUP_MASK & 2) : (kk == 5) ? (DUP_MASK & 4) : (kk == 6) ? (DUP_MASK & 8) : (kk == 1 || kk == 2 || kk == 4 || kk == 7 || kk == 9 || kk == 10) ? (DUP_MASK & 16) : false;
            if (!dup) continue;
        }
        if (ph2 > ph_lo * 2) xcd_barrier(xb);
        Ctx p;
        p.ws = P.ws; p.out = P.out; p.in = (const float* const*)(P.ws + OFF_TAB) + (size_t)blockIdx.x * 64;
        asm volatile("" : "+s"(p.ws), "+s"(p.out), "+s"(p.in) :: "memory");
        if (ph == 0) { if (PH_MASK & 1) prologue_phase(p); continue; }
        if (ph == 23) { if (PH_MASK & 2) norm_phase(p, 1, 4, rep); continue; }
        const int l = (ph - 1) / 11, k = (ph - 1) % 11;
        const unsigned char* wl = p.ws + OFF_W + (size_t)l * W_LAYER;
        if (k == 0 || k == 3 || k == 8) { if (PH_MASK & 2) norm_phase(p, l, k == 0 ? 1 : (k == 3 ? 2 : 3), rep); }
        else if (k == 5) { if (PH_MASK & 4) prep_phase(p, l); }
        else if (k == 6) { if (PH_MASK & 8) mixer_phase(p, l, s_unit, l + 2 * rep); }
        else if (PH_MASK & 16) {
            GemmDesc g;
            g.nM = NTOK / 256;
            if (k == 1 || k == 9) { g.A = (const bf16_t*)(p.ws + OFF_H); g.Bt = (const bf16_t*)(wl + (k == 1 ? WL_GU1 : WL_GU2)); g.K = 1024; g.nN = 22; g.S = 1; g.nt = 16; g.epi = EPI_GU; g.out = p.ws + OFF_ACT; }
            else if (k == 2 || k == 10) { g.A = (const bf16_t*)(p.ws + OFF_ACT); g.Bt = (const bf16_t*)(wl + (k == 2 ? WL_D1 : WL_D2)); g.K = 2816; g.nN = 4; g.S = 2; g.nt = 22; g.epi = EPI_PART; g.out = p.ws + OFF_U; }
            else if (k == 4) { g.A = (const bf16_t*)(p.ws + OFF_H); g.Bt = (const bf16_t*)(wl + WL_IN); g.K = 1024; g.nN = 10; g.S = 1; g.nt = 16; g.epi = EPI_U; g.out = p.ws + OFF_U; }
            else { g.A = (const bf16_t*)(p.ws + OFF_MIX); g.Bt = (const bf16_t*)(wl + WL_OUT); g.K = 1024; g.nN = 4; g.S = 2; g.nt = 8; g.epi = EPI_PART; g.out = p.ws + OFF_U; }
            gemm_phase(g);
            if (rep == 0 && gridDim.x == 256) {
                int lo = CONV_C0, per = 0;
                for (int q = 1; q <= ph; ++q) {
                    const int kq = (q - 1) % 11;
                    const int sup = (kq == 1 || kq == 9) ? 480 : (kq == 2 || kq == 10) ? 192 : (kq == 4) ? 32 : (kq == 7) ? 64 : 0;
                    if (q < ph) lo += sup; else per = (kq == 1 || kq == 9) ? 2 : (kq == 2 || kq == 10) ? 3 : (kq == 4) ? 2 : 1;
                }
                const int Ug = g.nM * g.nN * g.S, nfull = Ug % (int)gridDim.x;
                if (nfull != 0 && (int)blockIdx.x >= nfull && lo < NTR_UNITS) {
                    const int nidle = (int)gridDim.x - nfull;
                    int hi = lo + per * nidle; if (hi > NTR_UNITS) hi = NTR_UNITS;
                    convert_fill(p, lo, hi, (int)blockIdx.x - nfull, nidle, per);
                }
            }
        }
    }
}

extern "C" void kernel_launch(void* const* d_in, const int* in_sizes, int n_in, void* d_out, int out_size, void* d_ws, size_t ws_size, hipStream_t stream) {
    Params p{};
    for (int i = 0; i < N_IN; ++i) p.in[i] = (const float*)d_in[i];
    p.out = (float*)d_out;
    p.ws = (unsigned char*)d_ws;
    p.never = 0; p.pad = 0;
    static int grid_blocks = 0;
    if (!grid_blocks) {
        (void)hipFuncSetAttribute((const void*)fwd_megakernel, hipFuncAttributeMaxDynamicSharedMemorySize, SHM_BYTES);
        int dev = 0, cus = 0, per_cu = 0;
        (void)hipGetDevice(&dev);
        (void)hipDeviceGetAttribute(&cus, hipDeviceAttributeMultiprocessorCount, dev);
        (void)hipOccupancyMaxActiveBlocksPerMultiprocessor(&per_cu, fwd_megakernel, 512, SHM_BYTES);
        if (per_cu < 1) fprintf(stderr, "occupancy query returned %d\n", per_cu);
        grid_blocks = cus;
    }
    (void)hipMemsetAsync(d_ws, 0, CTRL_BYTES, stream);
#if MK_MULTI
    for (int ph = 0; ph < NPHASE; ++ph)
        fwd_megakernel<<<dim3(grid_blocks), dim3(512), SHM_BYTES, stream>>>(p, ph, ph + 1);
#else
    int lo = 0, hi = NPHASE;
    void* args[] = {&p, &lo, &hi};
    hipError_t e = hipLaunchCooperativeKernel((const void*)fwd_megakernel, dim3(grid_blocks), dim3(512), args, SHM_BYTES, stream);
    if (e != hipSuccess) fprintf(stderr, "cooperative launch failed: %s (grid %d)\n", hipGetErrorString(e), grid_blocks);
#endif
}
```
